# Optimizing an MI355X kernel written in HIP

```python
import math
import jax, jax.numpy as jnp
from jax import lax
import numpy as np

D_MODEL = 1024
BATCH = 2
SEQ = 16384
DEPTH = 2

HG_HEADS = 4
HG_KEY_DIM = 128
HG_VAL_DIM = 64
HG_KEY_WIDTH = HG_HEADS * HG_KEY_DIM
HG_WIDTH = HG_HEADS * HG_VAL_DIM
HG_CHUNK = 64
MIN_FORGET = 1e-20

MLA_HEADS = 4
MLA_Q_RANK = 256
MLA_KV_RANK = 128
MLA_NOPE = 128
MLA_ROPE = 64
MLA_V = 128
MLA_WIDTH = MLA_HEADS * MLA_V
ROPE_THETA = 10000.0
ATTN_BLOCK = 128
MASK_VALUE = -1e30

POOL_GROUPS = 4
POOL_WINDOWS = (2, 4, 8, 16)
POOL_WIDTH = 256
POOL_GROUP_DIM = POOL_WIDTH // POOL_GROUPS

D_MIX = HG_WIDTH + MLA_WIDTH + POOL_WIDTH

IN_SIZES = (HG_KEY_WIDTH, HG_KEY_WIDTH, HG_WIDTH, HG_WIDTH,
            MLA_Q_RANK, MLA_KV_RANK, MLA_ROPE, POOL_WIDTH)
D_IN = sum(IN_SIZES)
IN_SPLITS = tuple(int(v) for v in np.cumsum(IN_SIZES)[:-1])

D_FF = 2560
N_EXPERTS = 8
TOP_K = 2
D_FF_EXPERT = 3584
N_DENSE = (DEPTH + 1) // 2
N_MOE = DEPTH // 2
EPS = 1e-6

kernel_name = "hybrid_hgrn2_mla_pool_moe"


def rms_norm(x, g):
    xf = x.astype(jnp.float32)
    y = xf * lax.rsqrt(jnp.mean(xf * xf, axis=-1, keepdims=True) + EPS)
    return (y * g.astype(jnp.float32)).astype(x.dtype)


def swiglu(x, wg, wu, wd):
    return (jax.nn.silu(x @ wg) * (x @ wu)) @ wd


def rope_tables(seq, dim):
    pos = jnp.arange(seq, dtype=jnp.float32)
    inv_freq = 1.0 / (ROPE_THETA ** (jnp.arange(0, dim, 2, dtype=jnp.float32) / dim))
    ang = pos[:, None] * inv_freq[None, :]
    return jnp.cos(ang), jnp.sin(ang)


def apply_rope(x, cos, sin):
    xf = x.astype(jnp.float32)
    x1, x2 = jnp.split(xf, 2, axis=-1)
    out = jnp.concatenate([x1 * cos - x2 * sin, x1 * sin + x2 * cos], axis=-1)
    return out.astype(x.dtype)


def hgrn2_mixer(q, f, i, g, lb, out_norm):
    B, S, _ = q.shape
    dt = q.dtype
    nc = S // HG_CHUNK
    lbf = lb.astype(jnp.float32)
    z = f.astype(jnp.float32)
    forget = lbf + (1.0 - lbf) * jax.nn.sigmoid(z)
    log_f = jnp.log(jnp.maximum(forget, MIN_FORGET))
    k = (1.0 - lbf) * jax.nn.sigmoid(-z)
    qf = jax.nn.silu(q.astype(jnp.float32))
    vf = i.astype(jnp.float32)

    def to_chunks(t, d):
        return t.reshape(B, nc, HG_CHUNK, HG_HEADS, d).transpose(1, 0, 3, 2, 4)

    qc = to_chunks(qf, HG_KEY_DIM)
    kc = to_chunks(k, HG_KEY_DIM)
    gc = to_chunks(log_f, HG_KEY_DIM)
    vc = to_chunks(vf, HG_VAL_DIM)
    tri = jnp.tril(jnp.ones((HG_CHUNK, HG_CHUNK), dtype=bool))

    def step(state, inp):
        qq, kk, vv, lg = inp
        b = jnp.cumsum(lg, axis=2)
        o_inter = jnp.einsum('bhtk,bhkv->bhtv', qq * jnp.exp(b), state)
        diff = b[:, :, :, None, :] - b[:, :, None, :, :]
        decay = jnp.exp(jnp.where(tri[:, :, None], diff, MASK_VALUE))
        attn = jnp.einsum('bhtk,bhsk,bhtsk->bhts', qq, kk, decay)
        o_intra = jnp.einsum('bhts,bhsv->bhtv', attn, vv)
        b_last = b[:, :, -1:, :]
        new_state = (jnp.exp(b_last[:, :, 0, :])[..., None] * state
                     + jnp.einsum('bhsk,bhsv->bhkv', kk * jnp.exp(b_last - b), vv))
        return new_state, o_inter + o_intra

    s0 = jnp.zeros((B, HG_HEADS, HG_KEY_DIM, HG_VAL_DIM), jnp.float32)
    _, o = lax.scan(step, s0, (qc, kc, vc, gc))
    o = o.transpose(1, 0, 3, 2, 4).reshape(B, S, HG_HEADS, HG_VAL_DIM)
    o = rms_norm(o, out_norm.reshape(HG_HEADS, HG_VAL_DIM))
    o = o.reshape(B, S, HG_WIDTH) * jax.nn.silu(g.astype(jnp.float32))
    return o.astype(dt)


def mla_mixer(c_q, c_kv, k_pe, q_norm, w_uq, kv_norm, w_ukv, cos, sin):
    B, S, _ = c_q.shape
    q = (rms_norm(c_q, q_norm) @ w_uq).reshape(B, S, MLA_HEADS, MLA_NOPE + MLA_ROPE)
    q_nope, q_pe = q[..., :MLA_NOPE], q[..., MLA_NOPE:]
    q_pe = apply_rope(q_pe, cos[:, None, :], sin[:, None, :])
    kv = (rms_norm(c_kv, kv_norm) @ w_ukv).reshape(B, S, MLA_HEADS, MLA_NOPE + MLA_V)
    k_nope, v = kv[..., :MLA_NOPE], kv[..., MLA_NOPE:]
    k_pe = apply_rope(k_pe, cos, sin)
    scale = (MLA_NOPE + MLA_ROPE) ** -0.5
    nb = S // ATTN_BLOCK
    qn_b = q_nope.reshape(B, nb, ATTN_BLOCK, MLA_HEADS, MLA_NOPE).transpose(1, 0, 2, 3, 4)
    qp_b = q_pe.reshape(B, nb, ATTN_BLOCK, MLA_HEADS, MLA_ROPE).transpose(1, 0, 2, 3, 4)
    kpos = jnp.arange(S)

    def attend(args):
        qn, qp, blk = args
        s = (jnp.einsum('bqhd,bkhd->bhqk', qn, k_nope)
             + jnp.einsum('bqhd,bkd->bhqk', qp, k_pe)).astype(jnp.float32) * scale
        qpos = blk * ATTN_BLOCK + jnp.arange(ATTN_BLOCK)
        s = jnp.where(qpos[:, None] >= kpos[None, :], s, MASK_VALUE)
        p = jax.nn.softmax(s, axis=-1).astype(v.dtype)
        return jnp.einsum('bhqk,bkhd->bqhd', p, v)

    out = lax.map(attend, (qn_b, qp_b, jnp.arange(nb)))
    return out.transpose(1, 0, 2, 3, 4).reshape(B, S, MLA_WIDTH)


def pool_mixer(xp, w_pool, scale):
    B, S, _ = xp.shape
    xf = xp.astype(jnp.float32)
    cs = jnp.cumsum(xf, axis=1)
    t = jnp.arange(S)
    outs = []
    for gi, w in enumerate(POOL_WINDOWS):
        c = cs[..., gi * POOL_GROUP_DIM:(gi + 1) * POOL_GROUP_DIM]
        lag = jnp.pad(c, ((0, 0), (w, 0), (0, 0)))[:, :S]
        cnt = jnp.minimum(t + 1, w).astype(jnp.float32)[None, :, None]
        outs.append((c - lag) / cnt)
    pooled = (jnp.concatenate(outs, axis=-1) - xf).astype(xp.dtype)
    y = jnp.einsum('bsgc,gcd->bsgd', pooled.reshape(B, S, POOL_GROUPS, POOL_GROUP_DIM), w_pool)
    return y.reshape(B, S, POOL_WIDTH) * scale


def moe_ffn(h, router, wg, wu, wd):
    B, S, D = h.shape
    tok = h.reshape(B * S, D)
    logits = (tok @ router).astype(jnp.float32)
    top_v, top_i = lax.top_k(logits, TOP_K)
    gates = jax.nn.softmax(top_v, axis=-1)
    combine = jnp.sum(jax.nn.one_hot(top_i, N_EXPERTS, dtype=jnp.float32) * gates[..., None], axis=1)
    out = jnp.zeros((B * S, D), jnp.float32)
    for e in range(N_EXPERTS):
        y = swiglu(tok, wg[e], wu[e], wd[e]).astype(jnp.float32)
        out = out + combine[:, e:e + 1] * y
    return out.reshape(B, S, D).astype(h.dtype)


def setup_inputs(seed: int = 0) -> dict:
    key = jax.random.key(seed)
    ks = jax.random.split(key, 24)
    f32 = jnp.float32

    def nrm(k, shape, fan_in):
        return jax.random.normal(k, shape, f32) * (fan_in ** -0.5)

    def gain(k, shape):
        return 1.0 + 0.1 * jax.random.normal(k, shape, f32)

    return {
        "x": jax.random.normal(ks[0], (BATCH, SEQ, D_MODEL), f32),
        "attn_norm": gain(ks[1], (DEPTH, D_MODEL)),
        "w_in": nrm(ks[2], (DEPTH, D_MODEL, D_IN), D_MODEL),
        "hgrn_lower_bounds": jax.random.normal(ks[3], (DEPTH, HG_KEY_WIDTH), f32),
        "hgrn_out_norm": gain(ks[4], (DEPTH, HG_WIDTH)),
        "mla_q_norm": gain(ks[5], (DEPTH, MLA_Q_RANK)),
        "mla_w_uq": nrm(ks[6], (DEPTH, MLA_Q_RANK, MLA_HEADS * (MLA_NOPE + MLA_ROPE)), MLA_Q_RANK),
        "mla_kv_norm": gain(ks[7], (DEPTH, MLA_KV_RANK)),
        "mla_w_ukv": nrm(ks[8], (DEPTH, MLA_KV_RANK, MLA_HEADS * (MLA_NOPE + MLA_V)), MLA_KV_RANK),
        "pool_w": nrm(ks[9], (DEPTH, POOL_GROUPS, POOL_GROUP_DIM, POOL_GROUP_DIM), POOL_GROUP_DIM),
        "pool_scale": gain(ks[10], (DEPTH, POOL_WIDTH)),
        "w_o": nrm(ks[11], (DEPTH, D_MIX, D_MODEL), D_MIX),
        "ffn_norm": gain(ks[12], (DEPTH, D_MODEL)),
        "dense_w_gate": nrm(ks[13], (N_DENSE, D_MODEL, D_FF), D_MODEL),
        "dense_w_up": nrm(ks[14], (N_DENSE, D_MODEL, D_FF), D_MODEL),
        "dense_w_down": nrm(ks[15], (N_DENSE, D_FF, D_MODEL), D_FF),
        "moe_router": nrm(ks[16], (N_MOE, D_MODEL, N_EXPERTS), D_MODEL),
        "moe_w_gate": nrm(ks[17], (N_MOE, N_EXPERTS, D_MODEL, D_FF_EXPERT), D_MODEL),
        "moe_w_up": nrm(ks[18], (N_MOE, N_EXPERTS, D_MODEL, D_FF_EXPERT), D_MODEL),
        "moe_w_down": nrm(ks[19], (N_MOE, N_EXPERTS, D_FF_EXPERT, D_MODEL), D_FF_EXPERT),
        "final_norm": gain(ks[20], (D_MODEL,)),
    }


def reference(x, attn_norm, w_in, hgrn_lower_bounds, hgrn_out_norm, mla_q_norm, mla_w_uq,
              mla_kv_norm, mla_w_ukv, pool_w, pool_scale, w_o, ffn_norm, dense_w_gate,
              dense_w_up, dense_w_down, moe_router, moe_w_gate, moe_w_up, moe_w_down,
              final_norm):
    S = x.shape[1]
    cos, sin = rope_tables(S, MLA_ROPE)
    p_lb = jax.nn.softmax(hgrn_lower_bounds.astype(jnp.float32), axis=0)
    lbs = jnp.cumsum(p_lb, axis=0) - p_lb[0:1]

    for l in range(DEPTH):
        h = rms_norm(x, attn_norm[l])
        proj = h @ w_in[l]
        hq, hf, hi, hg, c_q, c_kv, k_pe, xp = jnp.split(proj, IN_SPLITS, axis=-1)
        o_a = hgrn2_mixer(hq, hf, hi, hg, lbs[l], hgrn_out_norm[l])
        o_b = mla_mixer(c_q, c_kv, k_pe, mla_q_norm[l], mla_w_uq[l], mla_kv_norm[l],
                        mla_w_ukv[l], cos, sin)
        o_c = pool_mixer(xp, pool_w[l], pool_scale[l])
        x = x + jnp.concatenate([o_a, o_b, o_c], axis=-1) @ w_o[l]
        h = rms_norm(x, ffn_norm[l])
        if l % 2 == 0:
            j = l // 2
            x = x + swiglu(h, dense_w_gate[j], dense_w_up[j], dense_w_down[j])
        else:
            j = l // 2
            x = x + moe_ffn(h, moe_router[j], moe_w_gate[j], moe_w_up[j], moe_w_down[j])
    return rms_norm(x, final_norm)
```

```cpp
#include <hip/hip_runtime.h>
#include <cstdio>
#include <cstdint>

#ifndef MK_ONE_LAUNCH
#define MK_ONE_LAUNCH 1
#endif

#define LAS __attribute__((address_space(3)))
#define GAS __attribute__((address_space(1)))
typedef unsigned short bf16_t;
typedef short bf16x8 __attribute__((ext_vector_type(8)));
typedef short s16x4 __attribute__((ext_vector_type(4)));
typedef float f32x2 __attribute__((ext_vector_type(2)));
typedef float f32x4 __attribute__((ext_vector_type(4)));
typedef float f32x16 __attribute__((ext_vector_type(16)));
typedef unsigned u32x2 __attribute__((ext_vector_type(2)));
typedef unsigned u32x4 __attribute__((ext_vector_type(4)));

constexpr int BATCH = 2, SEQ = 16384, T = BATCH * SEQ, DM = 1024, DIN = 2240, DINP = 2304;
constexpr int HG_H = 4, HG_DK = 128, HG_DV = 64, HG_C = 64, NCHUNK = SEQ / HG_C, NUNIT = BATCH * HG_H * NCHUNK;
constexpr int COL_HQ = 0, COL_HF = 512, COL_HI = 1024, COL_HG = 1280, COL_CQ = 1536, COL_CKV = 1792, COL_KPE = 1920, COL_XP = 1984;
constexpr int QW = 768;
constexpr int DFF = 2560, NE = 8, DFFE = 3584;
constexpr float EPS = 1e-6f;
constexpr int MOE_ROWS = T + NE * 256;
constexpr int MOE_MAXT = MOE_ROWS / 256;

constexpr size_t MiB = 1u << 20;
constexpr size_t WS_CTL = 0, CTL_ZERO_BYTES = 1 * MiB;
constexpr size_t WS_LBS = 1 * MiB;
constexpr size_t WS_RSTDQ = WS_LBS + 64 * 1024;
constexpr size_t WS_DVEC = WS_RSTDQ + (size_t)T * 4;
constexpr size_t WS_COS = WS_DVEC + (size_t)NUNIT * 128 * 4;
constexpr size_t WS_SIN = WS_COS + (size_t)SEQ * 32 * 4;
constexpr size_t WS_TOKE = WS_SIN + (size_t)SEQ * 32 * 4;
constexpr size_t WS_TOKG = WS_TOKE + (size_t)T * 2 * 4;
constexpr size_t WS_CNT = WS_TOKG + (size_t)T * 2 * 4;
constexpr size_t WS_SLOTTOK = WS_CNT + 256 * 16 * 4;
constexpr size_t WS_SLOTG = WS_SLOTTOK + (size_t)2 * MOE_ROWS * 4;
constexpr size_t WS_TILEE = WS_SLOTG + (size_t)2 * MOE_ROWS * 4;
constexpr size_t WS_WIN = 8 * MiB;
constexpr size_t WS_WQ = WS_WIN + (size_t)2 * DINP * DM * 2;
constexpr size_t WS_WO = WS_WQ + (size_t)2 * QW * 256 * 2;
constexpr size_t WS_WGU = WS_WO + (size_t)2 * DM * DM * 2;
constexpr size_t WS_WD = WS_WGU + (size_t)2 * DFF * DM * 2;
constexpr size_t WS_SMALL_END = WS_WD + (size_t)DM * DFF * 2;
constexpr size_t WS_ACT0 = 40 * MiB;
static_assert(WS_TILEE + 2 * 256 * 4 <= WS_WIN && WS_SMALL_END <= WS_ACT0, "small region");
constexpr size_t WS_HN = WS_ACT0;
constexpr size_t WS_Q = WS_ACT0;
constexpr size_t WS_KLAT = WS_ACT0 + 48 * MiB;
constexpr size_t WS_KROPE = WS_ACT0 + 56 * MiB;
constexpr size_t WS_PROJ = WS_ACT0 + 64 * MiB;
constexpr size_t WS_UBUF = WS_PROJ + 144 * MiB;
constexpr size_t WS_OCAT = WS_UBUF + 32 * MiB;
constexpr size_t WS_MIX_END = WS_OCAT + 64 * MiB;
constexpr size_t WS_ACTD = WS_PROJ;
constexpr size_t WS_MOEW = WS_MIX_END;
constexpr size_t MOEW_E = (size_t)(2 * DFFE * DM + DM * DFFE);
constexpr size_t WS_ACTM = WS_PROJ;
constexpr size_t WS_END = WS_MOEW + (size_t)NE * MOEW_E * 2;
static_assert(WS_END <= 512 * MiB && WS_ACTM + (size_t)MOE_ROWS * DFFE * 2 <= WS_MOEW, "workspace");

constexpr int CW_TMO = 0, CW_BAR = 4096; constexpr size_t CW_FUSE_BYTES = 576 * 1024;
constexpr size_t CW_SPLIT_BYTES = 512 * 1024;

__device__ __forceinline__ float bf2f(bf16_t v) { return __uint_as_float((unsigned)v << 16); }
typedef __bf16 bf16n2 __attribute__((ext_vector_type(2)));
typedef float f32n2 __attribute__((ext_vector_type(2)));
__device__ __forceinline__ unsigned cvt_pk_bf16(float lo, float hi) { const f32n2 v = {lo, hi}; return __builtin_bit_cast(unsigned, __builtin_convertvector(v, bf16n2)); }
__device__ __forceinline__ bf16_t f2bf(float f) { return __builtin_bit_cast(unsigned short, (__bf16)f); }
template <int CTRL> __device__ __forceinline__ float dppf(float v) { return __int_as_float(__builtin_amdgcn_update_dpp(0, __float_as_int(v), CTRL, 0xf, 0xf, true)); }
__device__ __forceinline__ float xlane1(float v) { return dppf<0xB1>(v); }
__device__ __forceinline__ float sum8(float v) { v += dppf<0xB1>(v); v += dppf<0x4E>(v); v += dppf<0x141>(v); return v; }
__device__ __forceinline__ float wave_sum(float v) {
    v = sum8(v); v += dppf<0x140>(v);
    const float r0 = __int_as_float(__builtin_amdgcn_readlane(__float_as_int(v), 0)), r1 = __int_as_float(__builtin_amdgcn_readlane(__float_as_int(v), 16));
    const float r2 = __int_as_float(__builtin_amdgcn_readlane(__float_as_int(v), 32)), r3 = __int_as_float(__builtin_amdgcn_readlane(__float_as_int(v), 48));
    return (r0 + r1) + (r2 + r3);
}
__device__ __forceinline__ float fast_exp(float x) { return __builtin_amdgcn_exp2f(x * 1.4426950408889634f); }
__device__ __forceinline__ float sigmoidf_(float x) { return __builtin_amdgcn_rcpf(1.f + fast_exp(-x)); }
#define LDS_WAIT() asm volatile("s_waitcnt lgkmcnt(0)" ::: "memory")
#define VM_WAIT() asm volatile("s_waitcnt vmcnt(0)" ::: "memory")

namespace pg8 {
constexpr int BM = 256, BK = 64, HALF = 128, HTB = HALF * BK * 2, STAGE_BYTES = 8 * HTB, NXCD = 8, WGM = 8;
__host__ __device__ __forceinline__ int lds_byte(int r, int c) { const int st = (r >> 4) * 2 + (c >> 5), rr = r & 15, cc = c & 31, ob = rr * 64 + cc * 2; return st * 1024 + (ob ^ (((ob >> 9) & 1) << 5)); }
__host__ __device__ __forceinline__ void stage_rc(int b, int& R, int& C) { const int st = b / 1024, sb = b % 1024, swz = sb ^ (((sb >> 9) & 1) << 5); R = (st >> 1) * 16 + swz / 64; C = (st & 1) * 32 + (swz % 64) / 2; }
__host__ __device__ __forceinline__ int perm32(int rho) { const int n = rho >> 4, i = rho & 15; return 8 * (i >> 2) + 4 * n + (i & 3); }

struct Unit { int pm, pn; int k0, nt, role, aux; };

struct OrderBase {
    int nM, nN, nwg, G, c;
    __device__ __forceinline__ void init_order(int nM_, int nN_, int G_, int c_) { nM = nM_; nN = nN_; nwg = nM * nN; G = G_; c = c_; }
    __device__ __forceinline__ void map(int L, Unit& u) const {
        int wgid = L; { const int q = nwg / NXCD, r = nwg % NXCD, xcd = wgid % NXCD, off = wgid / NXCD; wgid = (xcd < r ? xcd * (q + 1) : r * (q + 1) + (xcd - r) * q) + off; }
        const int nig = WGM * nN, gid = wgid / nig, fm = gid * WGM, gsz = (nM - fm) < WGM ? (nM - fm) : WGM;
        u.pm = fm + ((wgid % nig) % gsz); u.pn = (wgid % nig) / gsz;
    }
    __device__ __forceinline__ bool next(int i, Unit& u) const {
        const long L = (long)i * G + c; if (L >= nwg) return false;
        map((int)L, u); return true;
    }
};
struct DenseSched : OrderBase {
    static constexpr bool GATHER = false, SPLITK = false;
    const bf16_t* Bt; int K;
    __device__ __forceinline__ void init(int M, int N, int K_, const bf16_t* Bt_, int G_, int c_) { init_order(M / BM, N / BM, G_, c_); Bt = Bt_; K = K_; }
    __device__ __forceinline__ int arow(const Unit& u, int r) const { return u.pm * BM + r; }
    __device__ __forceinline__ const char* bptr(const Unit& u) const { return (const char*)Bt + (size_t)u.pn * BM * K * 2; }
};
struct SliceSched : OrderBase {
    static constexpr bool GATHER = false, SPLITK = false;
    const bf16_t* Bt; int K, slice;
    __device__ __forceinline__ void init(int M, int N, int K_, const bf16_t* Bt_, int G_, int c_, int slice_) { init_order(M / BM, N / BM, G_, c_); Bt = Bt_; K = K_; slice = slice_; }
    __device__ __forceinline__ bool next(int i, Unit& u) const { const long L = (long)slice * G + c; if (i != 0 || L >= nwg) return false; map((int)L, u); return true; }
    __device__ __forceinline__ int arow(const Unit& u, int r) const { return u.pm * BM + r; }
    __device__ __forceinline__ const char* bptr(const Unit& u) const { return (const char*)Bt + (size_t)u.pn * BM * K * 2; }
};
template <bool GATHER_> struct MoeSched : OrderBase {
    static constexpr bool GATHER = GATHER_, SPLITK = false;
    const bf16_t* W; size_t wstride; int K; const int* tile_e; const int* slot_tok;
    __device__ __forceinline__ void init(int N, int K_, const bf16_t* W_, size_t wstride_, const int* tile_e_, const int* slot_tok_, int G_, int c_) {
        tile_e = tile_e_; slot_tok = slot_tok_; W = W_; wstride = wstride_; K = K_; init_order(tile_e_[0], N / BM, G_, c_); }
    __device__ __forceinline__ int arow(const Unit& u, int r) const { if (GATHER) { const int t = slot_tok[u.pm * BM + r]; return t < 0 ? 0 : t; } return u.pm * BM + r; }
    __device__ __forceinline__ const char* bptr(const Unit& u) const { return (const char*)(W + (size_t)tile_e[1 + u.pm] * wstride) + (size_t)u.pn * BM * K * 2; }
};

constexpr int KCH = 7;
struct MoeDownSched : OrderBase {
    static constexpr bool GATHER = false, SPLITK = true;
    const bf16_t* W; size_t wstride; int K; const int* tile_e; int nfullu, nleft, nchunk;
    __device__ __forceinline__ void init(int N, int K_, const bf16_t* W_, size_t wstride_, const int* tile_e_, int G_, int c_) {
        tile_e = tile_e_; W = W_; wstride = wstride_; K = K_; init_order(tile_e_[0], N / BM, G_, c_);
        nfullu = (nwg / G) * G; nleft = nwg - nfullu; nchunk = nleft * KCH;
        if (nchunk > G) { nfullu = nwg; nleft = 0; nchunk = 0; } }
    __device__ __forceinline__ bool next(int i, Unit& u) const {
        const long L = (long)i * G + c;
        if (L < nfullu) { map((int)L, u); u.k0 = 0; u.nt = K / BK; u.role = 0; u.aux = 0; return true; }
        if (i == nfullu / G && c < nchunk) { const int lu = c / KCH, kc = c - lu * KCH; map(nfullu + lu, u); u.k0 = kc * (K / KCH); u.nt = (K / KCH) / BK; u.role = 1; u.aux = c; return true; }
        return false; }
    __device__ __forceinline__ int arow(const Unit& u, int r) const { return u.pm * BM + r; }
    __device__ __forceinline__ const char* bptr(const Unit& u) const { return (const char*)(W + (size_t)tile_e[1 + u.pm] * wstride) + (size_t)u.pn * BM * K * 2; }
};

struct EpiBf16 {
    static constexpr bool PERM = true;
    bf16_t* O; int ldc;
    __device__ __forceinline__ void operator()(const f32x4 (&acc)[2][2][4][2], const Unit& u, int wr, int wc, int fr, int fq) const {
        const int row0 = u.pm * BM + wr * 64 + fr, col0 = u.pn * BM + wc * 32 + 8 * fq;
#pragma unroll
        for (int ai = 0; ai < 2; ++ai)
#pragma unroll
            for (int m = 0; m < 4; ++m) { bf16_t* rowp = O + (size_t)(row0 + ai * HALF + m * 16) * ldc + col0;
#pragma unroll
                for (int bj = 0; bj < 2; ++bj) { const f32x4 v0 = acc[ai][bj][m][0], v1 = acc[ai][bj][m][1];
                    u32x4 w; w.x = cvt_pk_bf16(v0[0], v0[1]); w.y = cvt_pk_bf16(v0[2], v0[3]); w.z = cvt_pk_bf16(v1[0], v1[1]); w.w = cvt_pk_bf16(v1[2], v1[3]);
                    *(u32x4*)(rowp + bj * HALF) = w; } }
    }
};
template <bool XF32>
struct EpiRmsRes {
    static constexpr bool PERM = true;
    const void* xs; bf16_t* xd; bf16_t* hn; const float* g; float* slots; unsigned* cnt; LAS unsigned char* tab;
    __device__ __forceinline__ void operator()(const f32x4 (&acc)[2][2][4][2], const Unit& u, int wr, int wc, int fr, int fq) const {
        LAS float* P = (LAS float*)tab;
        LAS float* S = (LAS float*)(tab + 16384);
        const int col0 = u.pn * BM + wc * 32 + 8 * fq, rl0 = wr * 64 + fr, lane = fq * 16 + fr, wid = wr * 4 + wc, tid = wid * 64 + lane;
        f32x4 gv[2][2];
#pragma unroll
        for (int bj = 0; bj < 2; ++bj) { gv[bj][0] = *(const f32x4*)(g + col0 + bj * HALF); gv[bj][1] = *(const f32x4*)(g + col0 + bj * HALF + 4); }
        f32x4 v[2][2][4][2];
#pragma unroll
        for (int ai = 0; ai < 2; ++ai) {
            u32x4 rr[4][2]; f32x4 rf[XF32 ? 4 : 1][2][2];
#pragma unroll
            for (int m = 0; m < 4; ++m) { const size_t off = (size_t)(u.pm * BM + ai * HALF + rl0 + m * 16) * DM + col0;
                if constexpr (XF32) { const float* xp = (const float*)xs + off;
#pragma unroll
                    for (int bj = 0; bj < 2; ++bj) { rf[m][bj][0] = *(const f32x4*)(xp + bj * HALF); rf[m][bj][1] = *(const f32x4*)(xp + bj * HALF + 4); } }
                else { rr[m][0] = *(const u32x4*)((const bf16_t*)xs + off); rr[m][1] = *(const u32x4*)((const bf16_t*)xs + off + HALF); } }
#pragma unroll
            for (int m = 0; m < 4; ++m) { float sq = 0.f;
#pragma unroll
                for (int bj = 0; bj < 2; ++bj) { f32x4 a0 = acc[ai][bj][m][0], a1 = acc[ai][bj][m][1];
                    if constexpr (XF32) { a0 += rf[m][bj][0]; a1 += rf[m][bj][1]; }
                    else { const u32x4 r = rr[m][bj];
                        a0[0] += __uint_as_float(r.x << 16); a0[1] += __uint_as_float(r.x & 0xffff0000u); a0[2] += __uint_as_float(r.y << 16); a0[3] += __uint_as_float(r.y & 0xffff0000u);
                        a1[0] += __uint_as_float(r.z << 16); a1[1] += __uint_as_float(r.z & 0xffff0000u); a1[2] += __uint_as_float(r.w << 16); a1[3] += __uint_as_float(r.w & 0xffff0000u); }
                    v[ai][bj][m][0] = a0; v[ai][bj][m][1] = a1;
                    sq += ((a0[0] * a0[0] + a0[1] * a0[1]) + (a0[2] * a0[2] + a0[3] * a0[3])) + ((a1[0] * a1[0] + a1[1] * a1[1]) + (a1[2] * a1[2] + a1[3] * a1[3])); }
                P[(ai * HALF + rl0 + m * 16) * 16 + wc * 4 + fq] = sq; } }
        asm volatile("s_waitcnt lgkmcnt(0)" ::: "memory"); __builtin_amdgcn_s_barrier(); asm volatile("" ::: "memory");
        if (tid < 256) { const LAS f32x4* pp = (const LAS f32x4*)(P + tid * 16); const f32x4 p0 = pp[0], p1 = pp[1], p2 = pp[2], p3 = pp[3];
            const float tot = (((p0[0] + p0[1]) + (p0[2] + p0[3])) + ((p1[0] + p1[1]) + (p1[2] + p1[3]))) + (((p2[0] + p2[1]) + (p2[2] + p2[3])) + ((p3[0] + p3[1]) + (p3[2] + p3[3])));
            __hip_atomic_store(slots + ((size_t)(u.pm * BM + tid) * 4 + u.pn), tot, __ATOMIC_RELAXED, __HIP_MEMORY_SCOPE_AGENT); }
        asm volatile("s_waitcnt vmcnt(0)" ::: "memory");
        if (lane == 0) (void)__hip_atomic_fetch_add(cnt + 64 * u.pm, 1u, __ATOMIC_RELAXED, __HIP_MEMORY_SCOPE_AGENT);
        if (wid == 0) { unsigned sp = 0;
            while ((unsigned)__builtin_amdgcn_readfirstlane(__hip_atomic_load(cnt + 64 * u.pm, __ATOMIC_RELAXED, __HIP_MEMORY_SCOPE_AGENT)) < 32u) { __builtin_amdgcn_s_sleep(2); if (++sp > (1u << 22)) break; } }
        asm volatile("s_waitcnt vmcnt(0) lgkmcnt(0)" ::: "memory"); __builtin_amdgcn_s_barrier(); asm volatile("" ::: "memory");
        if (tid < 256) { const float* sl = slots + (size_t)(u.pm * BM + tid) * 4;
            const float s0 = __hip_atomic_load(sl + 0, __ATOMIC_RELAXED, __HIP_MEMORY_SCOPE_AGENT), s1 = __hip_atomic_load(sl + 1, __ATOMIC_RELAXED, __HIP_MEMORY_SCOPE_AGENT);
            const float s2 = __hip_atomic_load(sl + 2, __ATOMIC_RELAXED, __HIP_MEMORY_SCOPE_AGENT), s3 = __hip_atomic_load(sl + 3, __ATOMIC_RELAXED, __HIP_MEMORY_SCOPE_AGENT);
            S[tid] = 1.0f / sqrtf(((s0 + s1) + (s2 + s3)) * (1.f / DM) + EPS); }
        asm volatile("s_waitcnt vmcnt(0) lgkmcnt(0)" ::: "memory"); __builtin_amdgcn_s_barrier(); asm volatile("" ::: "memory");
#pragma unroll
        for (int ai = 0; ai < 2; ++ai)
#pragma unroll
            for (int m = 0; m < 4; ++m) { const int rl = ai * HALF + rl0 + m * 16; const float rs = S[rl]; const size_t off = (size_t)(u.pm * BM + rl) * DM + col0;
#pragma unroll
                for (int bj = 0; bj < 2; ++bj) { const f32x4 a0 = v[ai][bj][m][0], a1 = v[ai][bj][m][1]; const f32x4 o0 = a0 * rs * gv[bj][0], o1 = a1 * rs * gv[bj][1];
                    u32x4 wx; wx.x = cvt_pk_bf16(a0[0], a0[1]); wx.y = cvt_pk_bf16(a0[2], a0[3]); wx.z = cvt_pk_bf16(a1[0], a1[1]); wx.w = cvt_pk_bf16(a1[2], a1[3]);
                    u32x4 wh; wh.x = cvt_pk_bf16(o0[0], o0[1]); wh.y = cvt_pk_bf16(o0[2], o0[3]); wh.z = cvt_pk_bf16(o1[0], o1[1]); wh.w = cvt_pk_bf16(o1[2], o1[3]);
                    *(u32x4*)(xd + off + bj * HALF) = wx; *(u32x4*)(hn + off + bj * HALF) = wh; } }
    }
};
struct EpiQ {
    static constexpr bool PERM = true;
    bf16_t* Q; const float* rstd; const float* cosT; const float* sinT;
    __device__ __forceinline__ void operator()(const f32x4 (&acc)[2][2][4][2], const Unit& u, int wr, int wc, int fr, int fq) const {
        const int row0 = u.pm * BM + wr * 64 + fr;
        float rsv[2][4];
#pragma unroll
        for (int ai = 0; ai < 2; ++ai)
#pragma unroll
            for (int m = 0; m < 4; ++m) rsv[ai][m] = rstd[row0 + ai * HALF + m * 16];
#pragma unroll
        for (int bj = 0; bj < 2; ++bj) {
            const int col0 = u.pn * BM + bj * HALF + wc * 32 + 8 * fq, within = col0 % 192; const bool rope = within >= 128; const int i0 = (within - 128) >> 1;
#pragma unroll
            for (int ai = 0; ai < 2; ++ai) {
                f32x4 cv[4], sv[4];
                if (rope) {
#pragma unroll
                    for (int m = 0; m < 4; ++m) { const int pos = (row0 + ai * HALF + m * 16) & (SEQ - 1); cv[m] = *(const f32x4*)(cosT + pos * 32 + i0); sv[m] = *(const f32x4*)(sinT + pos * 32 + i0); } }
#pragma unroll
                for (int m = 0; m < 4; ++m) { const int row = row0 + ai * HALF + m * 16; const float rs = rsv[ai][m];
                    f32x4 v0 = acc[ai][bj][m][0] * rs, v1 = acc[ai][bj][m][1] * rs;
                    if (rope) { const f32x4 c4 = cv[m], s4 = sv[m];
                        const f32x4 a = v0, b = v1;
                        v0[0] = a[0] * c4[0] - a[1] * s4[0]; v0[1] = a[0] * s4[0] + a[1] * c4[0]; v0[2] = a[2] * c4[1] - a[3] * s4[1]; v0[3] = a[2] * s4[1] + a[3] * c4[1];
                        v1[0] = b[0] * c4[2] - b[1] * s4[2]; v1[1] = b[0] * s4[2] + b[1] * c4[2]; v1[2] = b[2] * c4[3] - b[3] * s4[3]; v1[3] = b[2] * s4[3] + b[3] * c4[3]; }
                    u32x4 w; w.x = cvt_pk_bf16(v0[0], v0[1]); w.y = cvt_pk_bf16(v0[2], v0[3]); w.z = cvt_pk_bf16(v1[0], v1[1]); w.w = cvt_pk_bf16(v1[2], v1[3]);
                    *(u32x4*)(Q + (size_t)row * QW + col0) = w; asm volatile("" ::: "memory"); } } }
    }
};
struct EpiResid {
    static constexpr bool PERM = false;
    const float* res; float* out;
    __device__ __forceinline__ void operator()(const f32x4 (&acc)[2][2][4][2], const Unit& u, int wr, int wc, int fr, int fq) const {
        const int row0 = u.pm * BM + wr * 64 + fr, col0 = u.pn * BM + wc * 32 + 4 * fq;
#pragma unroll
        for (int ai = 0; ai < 2; ++ai)
#pragma unroll
            for (int m = 0; m < 4; ++m) { const size_t off = (size_t)(row0 + ai * HALF + m * 16) * DM + col0;
#pragma unroll
                for (int bj = 0; bj < 2; ++bj)
#pragma unroll
                    for (int n = 0; n < 2; ++n) { const f32x4 r = *(const f32x4*)(res + off + bj * HALF + n * 16); *(f32x4*)(out + off + bj * HALF + n * 16) = r + acc[ai][bj][m][n]; } }
    }
};
struct EpiSwiGLU {
    static constexpr bool PERM = true;
    bf16_t* O; int ldc;
    __device__ __forceinline__ void operator()(const f32x4 (&acc)[2][2][4][2], const Unit& u, int wr, int wc, int fr, int fq) const {
        const int row0 = u.pm * BM + wr * 64 + fr, col0 = u.pn * HALF + wc * 32 + 8 * fq;
#pragma unroll
        for (int ai = 0; ai < 2; ++ai)
#pragma unroll
            for (int m = 0; m < 4; ++m) { f32x4 h[2];
#pragma unroll
                for (int n = 0; n < 2; ++n) { const f32x4 g = acc[ai][0][m][n], up = acc[ai][1][m][n];
#pragma unroll
                    for (int e = 0; e < 4; ++e) h[n][e] = g[e] * sigmoidf_(g[e]) * up[e]; }
                u32x4 w; w.x = cvt_pk_bf16(h[0][0], h[0][1]); w.y = cvt_pk_bf16(h[0][2], h[0][3]); w.z = cvt_pk_bf16(h[1][0], h[1][1]); w.w = cvt_pk_bf16(h[1][2], h[1][3]);
                *(u32x4*)(O + (size_t)(row0 + ai * HALF + m * 16) * ldc + col0) = w; asm volatile("" ::: "memory"); }
    }
};
struct EpiMoeDown {
    static constexpr bool PERM = false;
    float* x; const int* slot_tok; const float* slot_g;
    __device__ __forceinline__ void operator()(const f32x4 (&acc)[2][2][4][2], const Unit& u, int wr, int wc, int fr, int fq) const {
        const int row0 = u.pm * BM + wr * 64 + fr, col0 = u.pn * BM + wc * 32 + 4 * fq;
#pragma unroll
        for (int ai = 0; ai < 2; ++ai)
#pragma unroll
            for (int m = 0; m < 4; ++m) { const int slot = row0 + ai * HALF + m * 16; const int tok = slot_tok[slot]; const float g = slot_g[slot];
                if (tok >= 0) { const size_t off = (size_t)tok * DM + col0;
#pragma unroll
                    for (int bj = 0; bj < 2; ++bj)
#pragma unroll
                        for (int n = 0; n < 2; ++n) { const f32x4 r = *(const f32x4*)(x + off + bj * HALF + n * 16); *(f32x4*)(x + off + bj * HALF + n * 16) = r + acc[ai][bj][m][n] * g; } } }
    }
};

struct EpiMoeDownB {
    static constexpr bool PERM = true;
    const bf16_t* xs; bf16_t* xd; const int* slot_tok; const float* slot_g; f32x4* part; unsigned* cnt;
    __device__ __forceinline__ void operator()(const f32x4 (&acc)[2][2][4][2], const Unit& u, int wr, int wc, int fr, int fq) const {
        if (u.role == 1) {
            u32x4* p = (u32x4*)part + (size_t)u.aux * (16 * 512) + (wr * 4 + wc) * 64 + fq * 16 + fr;
#pragma unroll
            for (int ai = 0; ai < 2; ++ai)
#pragma unroll
                for (int bj = 0; bj < 2; ++bj)
#pragma unroll
                    for (int m = 0; m < 4; ++m) { const f32x4 v0 = acc[ai][bj][m][0], v1 = acc[ai][bj][m][1];
                        u32x4 w; w.x = cvt_pk_bf16(v0[0], v0[1]); w.y = cvt_pk_bf16(v0[2], v0[3]); w.z = cvt_pk_bf16(v1[0], v1[1]); w.w = cvt_pk_bf16(v1[2], v1[3]);
                        p[(size_t)((ai * 2 + bj) * 4 + m) * 512] = w; }
            return; }
        const int row0 = u.pm * BM + wr * 64 + fr, col0 = u.pn * BM + wc * 32 + 8 * fq;
        int tk[2][4]; float gg[2][4];
#pragma unroll
        for (int ai = 0; ai < 2; ++ai)
#pragma unroll
            for (int m = 0; m < 4; ++m) { tk[ai][m] = slot_tok[row0 + ai * HALF + m * 16]; gg[ai][m] = slot_g[row0 + ai * HALF + m * 16]; }
#pragma unroll
        for (int ai = 0; ai < 2; ++ai)
#pragma unroll
            for (int m = 0; m < 4; ++m) if (tk[ai][m] >= 0) { const size_t off = (size_t)tk[ai][m] * DM + col0; const float g = gg[ai][m];
                const u32x4 r0 = *(const u32x4*)(xs + off), r1 = *(const u32x4*)(xs + off + HALF);
#pragma unroll
                for (int bj = 0; bj < 2; ++bj) { const u32x4 r = bj ? r1 : r0; const f32x4 v0 = acc[ai][bj][m][0] * g, v1 = acc[ai][bj][m][1] * g;
                    u32x4 w; w.x = cvt_pk_bf16(__uint_as_float(r.x << 16) + v0[0], __uint_as_float(r.x & 0xffff0000u) + v0[1]); w.y = cvt_pk_bf16(__uint_as_float(r.y << 16) + v0[2], __uint_as_float(r.y & 0xffff0000u) + v0[3]);
                    w.z = cvt_pk_bf16(__uint_as_float(r.z << 16) + v1[0], __uint_as_float(r.z & 0xffff0000u) + v1[1]); w.w = cvt_pk_bf16(__uint_as_float(r.w << 16) + v1[2], __uint_as_float(r.w & 0xffff0000u) + v1[3]);
                    *(u32x4*)(xd + off + bj * HALF) = w; } }
    }
};
struct EpiMoeDelta {
    static constexpr bool PERM = true;
    bf16_t* d1; const int* slot_tok; const float* slot_g;
    __device__ __forceinline__ void operator()(const f32x4 (&acc)[2][2][4][2], const Unit& u, int wr, int wc, int fr, int fq) const {
        const int row0 = u.pm * BM + wr * 64 + fr, col0 = u.pn * BM + wc * 32 + 8 * fq;
        int tk[2][4]; float gg[2][4];
#pragma unroll
        for (int ai = 0; ai < 2; ++ai)
#pragma unroll
            for (int m = 0; m < 4; ++m) { tk[ai][m] = slot_tok[row0 + ai * HALF + m * 16]; gg[ai][m] = slot_g[row0 + ai * HALF + m * 16]; }
#pragma unroll
        for (int ai = 0; ai < 2; ++ai)
#pragma unroll
            for (int m = 0; m < 4; ++m) if (tk[ai][m] >= 0) { bf16_t* rowp = d1 + (size_t)tk[ai][m] * DM + col0; const float g = gg[ai][m];
#pragma unroll
                for (int bj = 0; bj < 2; ++bj) { const f32x4 v0 = acc[ai][bj][m][0] * g, v1 = acc[ai][bj][m][1] * g;
                    u32x4 w; w.x = cvt_pk_bf16(v0[0], v0[1]); w.y = cvt_pk_bf16(v0[2], v0[3]); w.z = cvt_pk_bf16(v1[0], v1[1]); w.w = cvt_pk_bf16(v1[2], v1[3]);
                    *(u32x4*)(rowp + bj * HALF) = w; } }
    }
};
__device__ __forceinline__ void glds16_s(const void* sbase, unsigned voff, unsigned lds_dst) { unsigned keep;
    asm volatile("s_mov_b32 %0, m0\n\ts_mov_b32 m0, %3\n\ts_nop 0\n\tglobal_load_lds_dwordx4 %2, %1\n\ts_mov_b32 m0, %0" : "=&s"(keep) : "s"(sbase), "v"(voff), "s"(lds_dst) : "memory"); }
template <class Epi, class Sched, bool ALIGN_EPI>
__device__ __forceinline__ void gemm_phase(LAS unsigned char* lds, const bf16_t* Aptr, const int lda, const int K, const Sched& S, const Epi& E, int tid) {
    asm volatile("" : "+v"(tid));
    const int wid = __builtin_amdgcn_readfirstlane(tid >> 6), lane = tid & 63, wr = wid >> 2, wc = wid & 3, fr = lane & 15, fq = lane >> 4;
    const int nt = K / BK;
    int RA[2]; unsigned CA2[2], voffB[2];
#pragma unroll
    for (int i = 0; i < 2; ++i) { int R, C; stage_rc(tid * 16 + i * 8192, R, C); const int Rb = Epi::PERM ? ((R & ~31) + perm32(R & 31)) : R;
        RA[i] = R; CA2[i] = (unsigned)C * 2u; voffB[i] = (unsigned)(Rb * K + C) * 2u; }
    const size_t kstep = (size_t)(BK * 2);
    const size_t hstep = (size_t)HALF * K * 2;
    const unsigned ldsb = (unsigned)(uintptr_t)lds + (unsigned)wid * 1024u;
    const int aoff = lds_byte(wr * 64 + fr, fq * 8), boff = lds_byte(wc * 32 + fr, fq * 8);
#define PG8_SA(b, h) (((b) * 2 + (h)) * HTB)
#define PG8_SB(b, h) ((4 + (b) * 2 + (h)) * HTB)
#define PG8_STAGE(bufoff, gbase, voff) do { _Pragma("unroll") for (int _i = 0; _i < 2; ++_i) \
        glds16_s((const void*)(gbase), (voff)[_i], ldsb + (unsigned)((bufoff) + _i * 8192)); } while (0)
#define PG8_LDA(dst, b, h) do { _Pragma("unroll") for (int m = 0; m < 4; ++m) _Pragma("unroll") for (int k = 0; k < 2; ++k) dst[m][k] = *(const LAS bf16x8*)(lds + PG8_SA(b, h) + aoff + m * 2048 + k * 1024); } while (0)
#define PG8_LDB(dst, b, h) do { _Pragma("unroll") for (int n = 0; n < 2; ++n) _Pragma("unroll") for (int k = 0; k < 2; ++k) dst[n][k] = *(const LAS bf16x8*)(lds + PG8_SB(b, h) + boff + n * 2048 + k * 1024); } while (0)
#define PG8_MMA(ai, bj, At, Bt) do { __builtin_amdgcn_s_setprio(1); _Pragma("unroll") for (int m = 0; m < 4; ++m) _Pragma("unroll") for (int n = 0; n < 2; ++n) _Pragma("unroll") for (int k = 0; k < 2; ++k) \
        acc[ai][bj][m][n] = __builtin_amdgcn_mfma_f32_16x16x32_bf16(Bt[n][k], At[m][k], acc[ai][bj][m][n], 0, 0, 0); __builtin_amdgcn_s_setprio(0); } while (0)
#define PG8_WAIT_V(n) asm volatile("s_waitcnt vmcnt(" #n ")" ::: "memory")
#define PG8_WAIT_L(n) asm volatile("s_waitcnt lgkmcnt(" #n ")" ::: "memory")
#define PG8_BAR __builtin_amdgcn_s_barrier()
#define PG8_SCHED __builtin_amdgcn_sched_barrier(0)
#define PG8_MKOFF(dst, u) do { _Pragma("unroll") for (int _h = 0; _h < 2; ++_h) _Pragma("unroll") for (int _i = 0; _i < 2; ++_i) \
        dst[_h][_i] = (unsigned)S.arow(u, _h * HALF + RA[_i]) * (unsigned)(lda * 2) + CA2[_i]; } while (0)
    Unit cur, nxt; int ui = 0;
    if (!S.next(0, cur)) return;
    constexpr bool SK = Sched::SPLITK;
    f32x4 acc[2][2][4][2];
#pragma unroll
    for (int a = 0; a < 2; ++a)
#pragma unroll
        for (int b = 0; b < 2; ++b)
#pragma unroll
            for (int m = 0; m < 4; ++m)
#pragma unroll
                for (int n = 0; n < 2; ++n) acc[a][b][m][n] = (f32x4){0.f, 0.f, 0.f, 0.f};
    bf16x8 At[4][2], B0[2][2], B1[2][2];
    constexpr bool GA = Sched::GATHER;
    unsigned ca[2][2], na[2][2];
    const char* const Ab = (const char*)Aptr;
    const size_t tstepA = (size_t)BM * lda * 2;
    const char* cAp = Ab;
    if constexpr (GA) { PG8_MKOFF(ca, cur); }
    else { cAp = Ab + (size_t)cur.pm * tstepA + (SK ? (size_t)cur.k0 * 2 : (size_t)0);
#pragma unroll
        for (int h = 0; h < 2; ++h)
#pragma unroll
            for (int i = 0; i < 2; ++i) { ca[h][i] = (unsigned)((h * HALF + RA[i]) * lda) * 2u + CA2[i]; na[h][i] = ca[h][i]; } }
    const char* cB = S.bptr(cur) + (SK ? (size_t)cur.k0 * 2 : (size_t)0);
    PG8_STAGE(PG8_SB(0, 0), cB, voffB); PG8_STAGE(PG8_SB(0, 1), cB + hstep, voffB); PG8_STAGE(PG8_SA(0, 0), cAp, ca[0]); PG8_STAGE(PG8_SA(0, 1), cAp, ca[1]);
    if (wr == 1) PG8_BAR;
    PG8_WAIT_V(2); PG8_BAR;
    PG8_STAGE(PG8_SB(1, 0), cB + kstep, voffB); PG8_STAGE(PG8_SA(1, 0), cAp + kstep, ca[0]); PG8_STAGE(PG8_SB(1, 1), cB + hstep + kstep, voffB);
    PG8_WAIT_V(6); PG8_BAR;
    for (;;) {
        const bool has_next = S.next(ui + 1, nxt);
        const char* nB = cB; const char* nAp = cAp;
        if (has_next) { nB = S.bptr(nxt) + (SK ? (size_t)nxt.k0 * 2 : (size_t)0); if constexpr (GA) { PG8_MKOFF(na, nxt); } else nAp = Ab + (size_t)nxt.pm * tstepA + (SK ? (size_t)nxt.k0 * 2 : (size_t)0); }
        else if constexpr (GA) {
#pragma unroll
            for (int h = 0; h < 2; ++h)
#pragma unroll
                for (int i = 0; i < 2; ++i) na[h][i] = ca[h][i]; }
        const int cnt_t = SK ? __builtin_amdgcn_readfirstlane(cur.nt) : nt;
        const int cnt_l = has_next ? cnt_t : cnt_t - 2;
        for (int t = 0; t < cnt_l; t += 2) {
            const bool last = (t == cnt_t - 2);
            const char* a1 = cAp + (size_t)(t + 1) * kstep;
            const char* a2 = last ? nAp : cAp + (size_t)(t + 2) * kstep; const char* b2 = last ? nB : cB + (size_t)(t + 2) * kstep;
            const char* a3 = a2 + kstep; const char* b3 = b2 + kstep;
            unsigned o2[2][2];
#pragma unroll
            for (int h = 0; h < 2; ++h)
#pragma unroll
                for (int i = 0; i < 2; ++i) o2[h][i] = (GA && last) ? na[h][i] : ca[h][i];
            PG8_LDB(B0, 0, 0); PG8_LDB(B1, 0, 1); PG8_SCHED; PG8_LDA(At, 0, 0); PG8_STAGE(PG8_SA(1, 1), a1, ca[1]);
            PG8_WAIT_V(8); PG8_WAIT_L(0); PG8_BAR; PG8_MMA(0, 0, At, B0); PG8_MMA(0, 1, At, B1); PG8_BAR; PG8_SCHED;
            PG8_LDA(At, 0, 1); PG8_STAGE(PG8_SB(0, 0), b2, voffB); PG8_STAGE(PG8_SB(0, 1), b2 + hstep, voffB); PG8_STAGE(PG8_SA(0, 0), a2, o2[0]);
            PG8_WAIT_V(8); PG8_WAIT_L(0); PG8_BAR; PG8_MMA(1, 0, At, B0); PG8_MMA(1, 1, At, B1); PG8_BAR; PG8_SCHED;
            PG8_LDB(B0, 1, 0); PG8_LDB(B1, 1, 1); PG8_SCHED; PG8_LDA(At, 1, 0); PG8_STAGE(PG8_SA(0, 1), a2, o2[1]);
            PG8_WAIT_V(8); PG8_WAIT_L(0); PG8_BAR; PG8_MMA(0, 0, At, B0); PG8_MMA(0, 1, At, B1); PG8_BAR; PG8_SCHED;
            PG8_LDA(At, 1, 1); PG8_STAGE(PG8_SB(1, 0), b3, voffB); PG8_STAGE(PG8_SB(1, 1), b3 + hstep, voffB); PG8_STAGE(PG8_SA(1, 0), a3, o2[0]);
            PG8_WAIT_V(8); PG8_WAIT_L(0); PG8_BAR; PG8_MMA(1, 0, At, B0); PG8_MMA(1, 1, At, B1); PG8_BAR; PG8_SCHED;
        }
        if (!has_next) {
            const char* a1 = cAp + (size_t)(cnt_t - 1) * kstep;
            PG8_LDB(B0, 0, 0); PG8_LDB(B1, 0, 1); PG8_SCHED; PG8_LDA(At, 0, 0); PG8_STAGE(PG8_SA(1, 1), a1, ca[1]);
            PG8_WAIT_V(8); PG8_WAIT_L(0); PG8_BAR; PG8_MMA(0, 0, At, B0); PG8_MMA(0, 1, At, B1); PG8_BAR; PG8_SCHED;
            PG8_LDA(At, 0, 1);
            PG8_WAIT_V(2); PG8_WAIT_L(0); PG8_BAR; PG8_MMA(1, 0, At, B0); PG8_MMA(1, 1, At, B1); PG8_BAR; PG8_SCHED;
            PG8_LDB(B0, 1, 0); PG8_LDB(B1, 1, 1); PG8_SCHED; PG8_LDA(At, 1, 0);
            PG8_WAIT_V(0); PG8_WAIT_L(0); PG8_BAR; PG8_MMA(0, 0, At, B0); PG8_MMA(0, 1, At, B1); PG8_BAR; PG8_SCHED;
            PG8_LDA(At, 1, 1);
            PG8_WAIT_L(0); PG8_BAR; PG8_MMA(1, 0, At, B0); PG8_MMA(1, 1, At, B1); PG8_BAR; PG8_SCHED;
        }
        if constexpr (ALIGN_EPI) { if (wr == 0) PG8_BAR; }
        E(acc, cur, wr, wc, fr, fq);
        if (!has_next) break;
#pragma unroll
        for (int a = 0; a < 2; ++a)
#pragma unroll
            for (int b = 0; b < 2; ++b)
#pragma unroll
                for (int m = 0; m < 4; ++m)
#pragma unroll
                    for (int n = 0; n < 2; ++n) acc[a][b][m][n] = (f32x4){0.f, 0.f, 0.f, 0.f};
        cur = nxt; cB = nB; cAp = nAp; ++ui;
        if constexpr (GA) {
#pragma unroll
            for (int h = 0; h < 2; ++h)
#pragma unroll
                for (int i = 0; i < 2; ++i) ca[h][i] = na[h][i]; }
        if constexpr (ALIGN_EPI) { if (wr == 1) PG8_BAR; }
    }
    PG8_WAIT_V(0);
    if constexpr (!ALIGN_EPI) { if (wr == 0) PG8_BAR; }
    PG8_BAR;
#undef PG8_SA
#undef PG8_SB
#undef PG8_STAGE
#undef PG8_LDA
#undef PG8_LDB
#undef PG8_MMA
#undef PG8_WAIT_V
#undef PG8_WAIT_L
#undef PG8_BAR
#undef PG8_SCHED
#undef PG8_MKOFF
}
}

__device__ __forceinline__ void moe_down_fixup(const pg8::MoeDownSched& S, const pg8::EpiMoeDownB& E, int tid) {
    if (S.c >= S.nchunk) return;
    const int lu = S.c / pg8::KCH, kc = S.c - lu * pg8::KCH;
    if (tid == 0) {
        __builtin_amdgcn_fence(__ATOMIC_RELEASE, "agent"); asm volatile("s_waitcnt vmcnt(0)" ::: "memory");
        (void)__hip_atomic_fetch_add(E.cnt + lu, 1u, __ATOMIC_RELAXED, __HIP_MEMORY_SCOPE_AGENT);
        unsigned sp = 0;
        while (__hip_atomic_load(E.cnt + lu, __ATOMIC_RELAXED, __HIP_MEMORY_SCOPE_AGENT) < (unsigned)pg8::KCH) { __builtin_amdgcn_s_sleep(1); if (++sp > (1u << 22)) break; }
        __builtin_amdgcn_fence(__ATOMIC_ACQUIRE, "agent"); asm volatile("s_waitcnt vmcnt(0)" ::: "memory"); }
    __syncthreads();
    const int wid = tid >> 6, lane = tid & 63, wr = wid >> 2, wc = wid & 3, fr = lane & 15, fq = lane >> 4;
    const u32x4* p = (const u32x4*)E.part + (size_t)(lu * pg8::KCH) * (16 * 512) + tid;
    pg8::Unit u; S.map(S.nfullu + lu, u);
    const int row0 = u.pm * pg8::BM + wr * 64 + fr, col0 = u.pn * pg8::BM + wc * 32 + 8 * fq;
#pragma unroll 1
    for (int am = kc; am < 8; am += pg8::KCH) { const int ai = am >> 2, m = am & 3; f32x4 v[2][2];
#pragma unroll
        for (int bj = 0; bj < 2; ++bj) { const int idx = (ai * 2 + bj) * 4 + m; f32x4 a0 = {0.f, 0.f, 0.f, 0.f}, a1 = {0.f, 0.f, 0.f, 0.f};
#pragma unroll
            for (int q = 0; q < pg8::KCH; ++q) { const u32x4 w = p[(size_t)q * (16 * 512) + (size_t)idx * 512];
                a0[0] += __uint_as_float(w.x << 16); a0[1] += __uint_as_float(w.x & 0xffff0000u); a0[2] += __uint_as_float(w.y << 16); a0[3] += __uint_as_float(w.y & 0xffff0000u);
                a1[0] += __uint_as_float(w.z << 16); a1[1] += __uint_as_float(w.z & 0xffff0000u); a1[2] += __uint_as_float(w.w << 16); a1[3] += __uint_as_float(w.w & 0xffff0000u); }
            v[bj][0] = a0; v[bj][1] = a1; }
        const int slot = row0 + ai * pg8::HALF + m * 16; const int tok = E.slot_tok[slot]; const float g = E.slot_g[slot];
        if (tok >= 0) { const size_t off = (size_t)tok * DM + col0;
#pragma unroll
            for (int bj = 0; bj < 2; ++bj) { const u32x4 r = *(const u32x4*)(E.xs + off + bj * pg8::HALF); const f32x4 v0 = v[bj][0] * g, v1 = v[bj][1] * g;
                u32x4 w; w.x = cvt_pk_bf16(__uint_as_float(r.x << 16) + v0[0], __uint_as_float(r.x & 0xffff0000u) + v0[1]); w.y = cvt_pk_bf16(__uint_as_float(r.y << 16) + v0[2], __uint_as_float(r.y & 0xffff0000u) + v0[3]);
                w.z = cvt_pk_bf16(__uint_as_float(r.z << 16) + v1[0], __uint_as_float(r.z & 0xffff0000u) + v1[1]); w.w = cvt_pk_bf16(__uint_as_float(r.w << 16) + v1[2], __uint_as_float(r.w & 0xffff0000u) + v1[3]);
                *(u32x4*)(E.xd + off + bj * pg8::HALF) = w; } } }
}

namespace att {
constexpr int NW = 8, QBLK = 32, KVBLK = 64, QB = NW * QBLK;
constexpr int SHM_V = 16384, SHM_K = 16384, SHM_R = 8192;
constexpr int NBUF = 3;
constexpr int OFF_K = 0, OFF_R = OFF_K + NBUF * SHM_K, OFF_WS = OFF_R + NBUF * SHM_R, OFF_V = OFF_WS + NW * 64 * 4, LDS_BYTES = OFF_V + NBUF * SHM_V;
constexpr float THR_L2 = 11.5f;
#define KSWZ(row, colB) ((row) * 256 + ((colB) ^ (((row) & 7) << 4)))
#define RSWZ(row, colB) (((row) >> 1) * 256 + (((((row) & 1) << 7) | (colB)) ^ ((((row) >> 1) & 7) << 4)))
#define SBAR() __builtin_amdgcn_sched_barrier(0)
__device__ __forceinline__ int v_st(int k, int c) { const int kk = (k & ~0xC) | ((k & 4) << 1) | ((k & 8) >> 1); return ((kk >> 3) * 4 + (c >> 5)) * 512 + ((kk & 7) * 32 + (c & 31)) * 2; }
__device__ __forceinline__ int v_rd_base(int lane) { return ((lane & 3) << 3) | (((lane >> 2) & 3) << 6) | (((lane >> 4) & 1) << 5) | (((lane >> 5) & 1) << 8); }
constexpr int v_rd_off(int d0, int ks, int half) { return d0 * 512 + ks * 4096 + half * 2048; }
__device__ __forceinline__ int crow(int r, int hi) { return (r & 3) + 8 * (r >> 2) + 4 * hi; }
__device__ __forceinline__ void mask_tile(f32x16& p0, f32x16& p1, int dq) {
    const float NEG = -__builtin_inff();
#pragma unroll
    for (int r = 0; r < 16; ++r) {
        const int c = (r & 3) + 8 * (r >> 2);
        if (dq - c < 0) p0[r] = NEG;
        if (dq - c - 32 < 0) p1[r] = NEG;
    }
}
__device__ __forceinline__ void partialSM(f32x16& p0, f32x16& p1, float& m_reg, float& mn, float& alpha) {
    float pmax = p0[0];
#pragma unroll
    for (int r = 1; r < 16; ++r) pmax = fmaxf(pmax, p0[r]);
#pragma unroll
    for (int r = 0; r < 16; ++r) pmax = fmaxf(pmax, p1[r]);
    { auto rr = __builtin_amdgcn_permlane32_swap(__float_as_uint(pmax), __float_as_uint(pmax), false, false);
      pmax = fmaxf(__uint_as_float(rr[0]), __uint_as_float(rr[1])); }
    if (__builtin_expect(__all((pmax - m_reg) <= THR_L2), 1)) { mn = m_reg; alpha = 1.f; }
    else { mn = fmaxf(m_reg, pmax); alpha = __builtin_amdgcn_exp2f(m_reg - mn); m_reg = mn; }
#pragma unroll
    for (int r = 0; r < 16; ++r) p0[r] = p0[r] - mn;
#pragma unroll
    for (int r = 0; r < 16; ++r) p1[r] = p1[r] - mn;
#pragma unroll
    for (int r = 0; r < 16; ++r) p0[r] = __builtin_amdgcn_exp2f(p0[r]);
}
__device__ __forceinline__ void finishSM(f32x16& p0, f32x16& p1, float alpha, float& l_reg, bf16x8& pa0, bf16x8& pa1, bf16x8& pa2, bf16x8& pa3) {
#pragma unroll
    for (int r = 0; r < 16; ++r) p1[r] = __builtin_amdgcn_exp2f(p1[r]);
    float ps = 0;
#pragma unroll
    for (int r = 0; r < 16; ++r) ps += p0[r];
#pragma unroll
    for (int r = 0; r < 16; ++r) ps += p1[r];
    { auto rr = __builtin_amdgcn_permlane32_swap(__float_as_uint(ps), __float_as_uint(ps), false, false);
      ps = __uint_as_float(rr[0]) + __uint_as_float(rr[1]); }
    l_reg = l_reg * alpha + ps;
#define PK4(P, B_, OUT) do { unsigned a0 = cvt_pk_bf16(P[B_+0], P[B_+1]), a1 = cvt_pk_bf16(P[B_+2], P[B_+3]);                          \
        unsigned b0 = cvt_pk_bf16(P[B_+4], P[B_+5]), b1 = cvt_pk_bf16(P[B_+6], P[B_+7]);                                             \
        auto r0 = __builtin_amdgcn_permlane32_swap(a0, b0, false, false); auto r1 = __builtin_amdgcn_permlane32_swap(a1, b1, false, false); \
        u32x4 w = {r0[0], r1[0], r0[1], r1[1]}; OUT = *reinterpret_cast<bf16x8*>(&w); } while (0)
    PK4(p0, 0, pa0); PK4(p0, 8, pa1); PK4(p1, 0, pa2); PK4(p1, 8, pa3);
#undef PK4
}
__device__ __forceinline__ void qkt(f32x16& p0, f32x16& p1, const char* lbk, const char* lbrk, const bf16x8* qr) {
    p0 = f32x16{}; p1 = f32x16{};
    bf16x8 F0[4], F1[4];
#define KLD(F, g) do { if ((g) < 4) { F[0] = *reinterpret_cast<const bf16x8*>(lbk + (2 * (g)) * 1024); F[1] = *reinterpret_cast<const bf16x8*>(lbk + (2 * (g)) * 1024 + 8192); \
                                      F[2] = *reinterpret_cast<const bf16x8*>(lbk + (2 * (g) + 1) * 1024); F[3] = *reinterpret_cast<const bf16x8*>(lbk + (2 * (g) + 1) * 1024 + 8192); } \
                       else { F[0] = *reinterpret_cast<const bf16x8*>(lbrk + (2 * (g) - 8) * 1024); F[1] = *reinterpret_cast<const bf16x8*>(lbrk + (2 * (g) - 8) * 1024 + 4096); \
                              F[2] = *reinterpret_cast<const bf16x8*>(lbrk + (2 * (g) - 7) * 1024); F[3] = *reinterpret_cast<const bf16x8*>(lbrk + (2 * (g) - 7) * 1024 + 4096); } } while (0)
#define KMM(F, g) do { p0 = __builtin_amdgcn_mfma_f32_32x32x16_bf16(F[0], qr[2 * (g)], p0, 0, 0, 0); p1 = __builtin_amdgcn_mfma_f32_32x32x16_bf16(F[1], qr[2 * (g)], p1, 0, 0, 0); \
                       p0 = __builtin_amdgcn_mfma_f32_32x32x16_bf16(F[2], qr[2 * (g) + 1], p0, 0, 0, 0); p1 = __builtin_amdgcn_mfma_f32_32x32x16_bf16(F[3], qr[2 * (g) + 1], p1, 0, 0, 0); } while (0)
    KLD(F0, 0); KLD(F1, 1); SBAR();
    KMM(F0, 0); SBAR(); KLD(F0, 2); SBAR();
    KMM(F1, 1); SBAR(); KLD(F1, 3); SBAR();
    KMM(F0, 2); SBAR(); KLD(F0, 4); SBAR();
    KMM(F1, 3); SBAR(); KLD(F1, 5); SBAR();
    KMM(F0, 4); SBAR();
    KMM(F1, 5); SBAR();
#undef KLD
#undef KMM
}
__device__ __forceinline__ void pv_tile(f32x16* o, int vbt, bf16x8 pa0, bf16x8 pa1, bf16x8 pa2, bf16x8 pa3) {
#define TRRD(dst, off) asm volatile("ds_read_b64_tr_b16 %0, %1 offset:%2" : "=&v"(dst) : "v"(vbt), "i"(off) : "memory")
#define TRRD8(L, d0) do { constexpr int b_ = v_rd_off(d0, 0, 0); TRRD(L[0], b_); TRRD(L[1], b_ + 2048); TRRD(L[2], b_ + 4096); TRRD(L[3], b_ + 6144); TRRD(L[4], b_ + 8192); TRRD(L[5], b_ + 10240); TRRD(L[6], b_ + 12288); TRRD(L[7], b_ + 14336); } while (0)
#define PVMM(L, d0) do { \
        o[d0] = __builtin_amdgcn_mfma_f32_32x32x16_bf16(pa0, (bf16x8){L[0][0], L[0][1], L[0][2], L[0][3], L[1][0], L[1][1], L[1][2], L[1][3]}, o[d0], 0, 0, 0);   \
        o[d0] = __builtin_amdgcn_mfma_f32_32x32x16_bf16(pa1, (bf16x8){L[2][0], L[2][1], L[2][2], L[2][3], L[3][0], L[3][1], L[3][2], L[3][3]}, o[d0], 0, 0, 0);   \
        o[d0] = __builtin_amdgcn_mfma_f32_32x32x16_bf16(pa2, (bf16x8){L[4][0], L[4][1], L[4][2], L[4][3], L[5][0], L[5][1], L[5][2], L[5][3]}, o[d0], 0, 0, 0);   \
        o[d0] = __builtin_amdgcn_mfma_f32_32x32x16_bf16(pa3, (bf16x8){L[6][0], L[6][1], L[6][2], L[6][3], L[7][0], L[7][1], L[7][2], L[7][3]}, o[d0], 0, 0, 0); } while (0)
#define WAITL(n) asm volatile("s_waitcnt lgkmcnt(" #n ")" ::: "memory")
    s16x4 La[8], Lb[8];
    TRRD8(La, 0); TRRD8(Lb, 1);
    WAITL(8); SBAR(); PVMM(La, 0); SBAR(); TRRD8(La, 2);
    WAITL(8); SBAR(); PVMM(Lb, 1); SBAR(); TRRD8(Lb, 3);
    WAITL(8); SBAR(); PVMM(La, 2); SBAR();
    WAITL(0); SBAR(); PVMM(Lb, 3); SBAR();
#undef TRRD
#undef TRRD8
#undef PVMM
#undef WAITL
}

struct BlockRef { const bf16_t* Q; const bf16_t* Kl; const bf16_t* Kr; bf16_t* O; int P0; };
#define VMW() asm volatile("s_waitcnt vmcnt(0)" ::: "memory")
#define SLOAD(k0) do { const bf16_t* kp_ = cur.Kl + (size_t)((k0) + srow) * 128 + cc * 8; st_k0 = *(const bf16x8*)kp_; st_k1 = *(const bf16x8*)(kp_ + 64); \
                       st_r = *(const bf16x8*)(cur.Kr + (size_t)((k0) + srow) * 64 + cc * 8); } while (0)
#define SWRITE_K(bf) do { char* kd_ = lds + OFF_K + (bf) * SHM_K + kws; *(bf16x8*)kd_ = st_k0; *(bf16x8*)(kd_ + 4096) = st_k1; *(bf16x8*)(lds + OFF_R + (bf) * SHM_R + rws) = st_r; } while (0)
#define SWRITE_V(bf) do { char* vd_ = lds + OFF_V + (bf) * SHM_V + vst0; *(bf16x8*)vd_ = st_k0; *(bf16x8*)(vd_ + 1024) = st_k1; } while (0)
#define ABAR() asm volatile("s_waitcnt lgkmcnt(0)\n\ts_barrier" ::: "memory")
template <int VAR>
__device__ __forceinline__ void attn_block(const BlockRef& cur, char* lds, int tid) {
    asm volatile("" : "+v"(tid));
    const int wid = __builtin_amdgcn_readfirstlane(tid >> 6), lane = tid & 63, r32 = lane & 31, hi = lane >> 5, grp = wid >> 2;
    const int NT = (cur.P0 + QB - 1) / KVBLK + 1;
    const int qlo = cur.P0 + wid * QBLK, qm = qlo + r32 - 4 * hi;
    float* ws = (float*)(lds + OFF_WS) + wid * 64; float* li_l = ws, * al_l = ws + 32;
    float m_reg = -1e30f, l_reg = 0; f32x16 o[4] = {};
    const int srow = wid * 8 + (lane & 7), cc = lane >> 3;
    const int kws = (srow >> 5) * 8192 + (cc >> 1) * 1024 + ((cc & 1) * 32 + (srow & 31)) * 16, rws = (srow >> 5) * 4096 + (cc >> 1) * 1024 + ((cc & 1) * 32 + (srow & 31)) * 16, vst0 = v_st(srow, cc * 8);
    const int vb0 = (int)(uintptr_t)lds + OFF_V + v_rd_base(lane);
    const char* lb = lds + OFF_K + lane * 16;
    int lbr_i = (int)(uintptr_t)lds + OFF_R + lane * 16; asm volatile("" : "+v"(lbr_i));
    const char* lbr = (const char*)(const LAS char*)(uintptr_t)(unsigned)lbr_i;
    bf16x8 qr[12], st_k0, st_k1, st_r;
    { const bf16_t* qp = cur.Q + (size_t)(wid * QBLK + r32) * QW + hi * 8;
#pragma unroll
      for (int d0 = 0; d0 < 12; ++d0) qr[d0] = *(const bf16x8*)(qp + d0 * 16); }
#define RESC(a) do { if (__any((a) < 1.f)) { if (hi == 0) al_l[r32] = (a); asm volatile("s_waitcnt lgkmcnt(0)" ::: "memory");              \
                     _Pragma("unroll") for (int d_ = 0; d_ < 4; ++d_) _Pragma("unroll") for (int r = 0; r < 16; ++r) o[d_][r] *= al_l[crow(r, hi)]; } } while (0)
#define KBASE(t) ((t) * KVBLK)
#define MASKT(P0_, P1_, t) do { const int kb_ = KBASE(t); if (kb_ + KVBLK - 1 > qlo) mask_tile(P0_, P1_, qm - kb_); } while (0)
    f32x16 p0 = {}, p1 = {}; float mn, al = 1.f; bf16x8 pa0 = {}, pa1 = {}, pa2 = {}, pa3 = {};
    const int dist = 1 + grp;
    SLOAD(0); VMW(); SWRITE_K(0); SWRITE_V(0);
    if (grp) { SLOAD(KBASE(1)); VMW(); SWRITE_K(1); SWRITE_V(1); }
    SLOAD(KBASE(dist));
    ABAR();
    if (grp) ABAR();
    int bt = 0;
    for (int t = 0; t < NT; ++t) {
        if (VAR != 2) { SBAR(); qkt(p0, p1, lb + bt * SHM_K, lbr + bt * SHM_R, qr);
        if (t > 0) pv_tile(o, vb0 + (bt == 0 ? 2 : bt - 1) * SHM_V, pa0, pa1, pa2, pa3); }
        SBAR(); ABAR();
        if (VAR != 1) { MASKT(p0, p1, t); partialSM(p0, p1, m_reg, mn, al); finishSM(p0, p1, al, l_reg, pa0, pa1, pa2, pa3); RESC(al); }
        else { asm volatile("" : "+v"(p0), "+v"(p1), "+v"(pa0), "+v"(pa1), "+v"(pa2), "+v"(pa3)); }
        { const int td = t + dist; if (td < NT) { int wbi = bt + dist; wbi = wbi >= 3 ? wbi - 3 : wbi; VMW(); SWRITE_K(wbi); SWRITE_V(wbi); if (td + 1 < NT) SLOAD(KBASE(td + 1)); } }
        bt = bt == 2 ? 0 : bt + 1;
        SBAR(); ABAR();
    }
    pv_tile(o, vb0 + (bt == 0 ? 2 : bt - 1) * SHM_V, pa0, pa1, pa2, pa3);
    if (hi == 0) li_l[r32] = l_reg; asm volatile("s_waitcnt lgkmcnt(0)" ::: "memory");
    float rli[16];
#pragma unroll
    for (int r = 0; r < 16; ++r) rli[r] = __builtin_amdgcn_rcpf(li_l[crow(r, hi)]);
    bf16_t* Ow = cur.O + (size_t)(wid * QBLK) * DM;
#pragma unroll
    for (int r = 0; r < 16; ++r) { const int orow = crow(r, hi);
#pragma unroll
        for (int d0 = 0; d0 < 4; ++d0) { const float v = o[d0][r] * rli[r];
            const float vn = xlane1(v);
            if ((r32 & 1) == 0) *(unsigned*)(Ow + (size_t)orow * DM + d0 * 32 + r32) = cvt_pk_bf16(v, vn); } }
    if (!grp) ABAR();
    ABAR();
#undef RESC
#undef KBASE
#undef MASKT
}
#undef ABAR
#undef VMW
#undef SLOAD
#undef SWRITE_K
#undef SWRITE_V
}

constexpr int NWAVES = 8;
constexpr int RING_BYTES = 157696, MISC_OFF = RING_BYTES + 64, LDS_BYTES = 158720;
static_assert(att::LDS_BYTES <= RING_BYTES && pg8::STAGE_BYTES <= RING_BYTES, "phase scratch fits the ring region");
#define RLX_AGENT __ATOMIC_RELAXED, __HIP_MEMORY_SCOPE_AGENT

#define XB_TMO      128
#define XB_XCNT(j)  (256  + 64 * (j))
#define XB_XSUB(j)  (1280 + 64 * (j))
#define XB_XGEN(j)  (2304 + 64 * (j))
#define XB_TOP      3328
#define XB_TOPGEN   3392
#define XCD_BAR_WORDS 3456
#define XB_SPIN_CAP (1u << 18)
__device__ __forceinline__ unsigned xb_ld(unsigned* p)              { return __hip_atomic_load(p, __ATOMIC_RELAXED, __HIP_MEMORY_SCOPE_AGENT); }
__device__ __forceinline__ unsigned xb_add(unsigned* p, unsigned v) { return __hip_atomic_fetch_add(p, v, __ATOMIC_RELAXED, __HIP_MEMORY_SCOPE_AGENT); }
__device__ __forceinline__ unsigned xb_xcc_id() { return (unsigned)__builtin_amdgcn_s_getreg((3 << 11) | 20) & 0xFu; }
#define XB_SPIN(cond, bar) do { unsigned _sp = 0; while (cond) { __builtin_amdgcn_s_sleep(1); \
    if ((++_sp & 255u) == 0u) { if (xb_ld(&(bar)[XB_TMO])) break; if (_sp > XB_SPIN_CAP) { atomicAdd(&(bar)[XB_TMO], 1u); break; } } } } while (0)
struct XcdBarrier { unsigned* bar; unsigned x; volatile LAS unsigned* st; };
__device__ __forceinline__ XcdBarrier xcd_barrier_post(unsigned* bar, volatile LAS unsigned* st) {
    XcdBarrier b; b.bar = bar; b.x = xb_xcc_id(); b.st = st;
    if (threadIdx.x == 0) (void)xb_add(&bar[XB_XCNT(b.x)], 1u);
    return b;
}
__device__ __forceinline__ void xcd_barrier_complete(unsigned* bar, unsigned x, unsigned& nloc, unsigned& nx) {
    const unsigned G = gridDim.x * gridDim.y * gridDim.z;
    unsigned sum, cnt, mine, sp = 0u;
    for (;;) {
        sum = 0u; cnt = 0u; mine = 0u;
#pragma unroll
        for (unsigned j = 0; j < 16; ++j) { const unsigned c = xb_ld(&bar[XB_XCNT(j)]); sum += c; cnt += (c > 0u) ? 1u : 0u; mine = (j == x) ? c : mine; }
        if (sum == G) break;
        __builtin_amdgcn_s_sleep(1);
        if ((++sp & 255u) == 0u) { if (xb_ld(&bar[XB_TMO])) break; if (sp > XB_SPIN_CAP) { atomicAdd(&bar[XB_TMO], 1u); break; } }
    }
    nloc = mine > 0u ? mine : 1u; nx = cnt > 0u ? cnt : 1u;
}
__device__ __forceinline__ void xcd_barrier(const XcdBarrier& b, const bool leader  ) {
    asm volatile("s_waitcnt vmcnt(0)" ::: "memory");
    __syncthreads();
    if (leader) {
        unsigned* bar = b.bar;
        __builtin_amdgcn_s_waitcnt(0);
        unsigned nloc = b.st[0], nx = b.st[1];
        if (nloc == 0u) { xcd_barrier_complete(bar, b.x, nloc, nx); b.st[0] = nloc; b.st[1] = nx; }
        const unsigned old = xb_add(&bar[XB_XSUB(b.x)], 1u);
        const unsigned gen = old / nloc;
        if (old + 1u == (gen + 1u) * nloc) {
            __builtin_amdgcn_fence(__ATOMIC_RELEASE, "agent");
            asm volatile("s_waitcnt vmcnt(0)" ::: "memory");
            const unsigned og = xb_add(&bar[XB_TOP], 1u);
            const unsigned tg = og / nx;
            if (og + 1u == (tg + 1u) * nx) xb_add(&bar[XB_TOPGEN], 1u);
            else XB_SPIN(xb_ld(&bar[XB_TOPGEN]) == tg, bar);
            __builtin_amdgcn_fence(__ATOMIC_ACQUIRE, "agent");
            xb_add(&bar[XB_XGEN(b.x)], 1u);
            asm volatile("s_waitcnt vmcnt(0)" ::: "memory");
        } else {
            XB_SPIN(xb_ld(&bar[XB_XGEN(b.x)]) == gen, bar);
            __builtin_amdgcn_fence(__ATOMIC_ACQUIRE, "agent");
            asm volatile("s_waitcnt vmcnt(0)" ::: "memory");
        }
    }
    __syncthreads();
}

__device__ const double ROPE_INVF[32] = {1.0, 0.7498942093324559, 0.5623413251903491, 0.4216965034285822, 0.31622776601683794, 0.23713737056616552, 0.1778279410038923, 0.1333521432163324, 0.1,
    0.07498942093324558, 0.05623413251903491, 0.042169650342858224, 0.03162277660168379, 0.023713737056616554, 0.01778279410038923, 0.01333521432163324, 0.01, 0.007498942093324558,
    0.005623413251903491, 0.004216965034285823, 0.0031622776601683794, 0.0023713737056616554, 0.0017782794100389228, 0.001333521432163324, 0.001, 0.0007498942093324559, 0.0005623413251903491,
    0.00042169650342858224, 0.00031622776601683794, 0.00023713737056616554, 0.00017782794100389227, 0.0001333521432163324};
__device__ __forceinline__ void sincos_d(double a, float& s_out, float& c_out) {
    const double kq = __builtin_rint(a * 0.6366197723675814);
    double r = a - kq * 1.570796325802803; r -= kq * 9.920935796805404e-10;
    const double r2 = r * r;
    double sp = -1.0 / 1307674368000.0; sp = sp * r2 + 1.0 / 6227020800.0; sp = sp * r2 - 1.0 / 39916800.0; sp = sp * r2 + 1.0 / 362880.0; sp = sp * r2 - 1.0 / 5040.0; sp = sp * r2 + 1.0 / 120.0; sp = sp * r2 - 1.0 / 6.0; sp = sp * r2 + 1.0;
    const double sn = sp * r;
    double cp = 1.0 / 20922789888000.0; cp = cp * r2 - 1.0 / 87178291200.0; cp = cp * r2 + 1.0 / 479001600.0; cp = cp * r2 - 1.0 / 3628800.0; cp = cp * r2 + 1.0 / 40320.0; cp = cp * r2 - 1.0 / 720.0; cp = cp * r2 + 1.0 / 24.0; cp = cp * r2 - 0.5; cp = cp * r2 + 1.0;
    const int q = ((int)kq) & 3;
    const double s = (q == 0) ? sn : (q == 1) ? cp : (q == 2) ? -sn : -cp;
    const double c = (q == 0) ? cp : (q == 1) ? -sn : (q == 2) ? -cp : sn;
    s_out = (float)s; c_out = (float)c;
}
struct TrItem { const float* W; bf16_t* dst; int N, k0, n0, drow0, ldd, kofs; };
__device__ __forceinline__ void tr_load(const TrItem& t, float (&tv)[32], int lane) {
#pragma unroll
    for (int i = 0; i < 32; ++i) tv[i] = t.W[(size_t)(t.k0 + 2 * i + (lane >> 5)) * t.N + t.n0 + (lane & 31)];
}
__device__ __forceinline__ void tr_store(const TrItem& t, const float (&tv)[32], LAS float* scr, int lane) {
#pragma unroll
    for (int i = 0; i < 32; ++i) scr[(2 * i + (lane >> 5)) * 33 + (lane & 31)] = tv[i];
    LDS_WAIT(); asm volatile("" ::: "memory");
    const int c = lane & 7;
#pragma unroll
    for (int j = 0; j < 4; ++j) { const int n = (lane >> 3) + 8 * j; const LAS float* s = scr + (8 * c) * 33 + n;
        u32x4 o; o.x = cvt_pk_bf16(s[0 * 33], s[1 * 33]); o.y = cvt_pk_bf16(s[2 * 33], s[3 * 33]); o.z = cvt_pk_bf16(s[4 * 33], s[5 * 33]); o.w = cvt_pk_bf16(s[6 * 33], s[7 * 33]);
        *(u32x4*)(t.dst + (size_t)(t.drow0 + n) * t.ldd + t.kofs + 8 * c) = o; }
    LDS_WAIT(); asm volatile("" ::: "memory");
}
template <class Dec>
__device__ __forceinline__ void tr_run(const Dec& dec, int nit, int gw, int NGW, LAS float* scr, int lane) {
    float ta[32], tb[32]; TrItem A, B;
    int it = gw; if (it < nit) { A = dec(it); tr_load(A, ta, lane); }
    while (it < nit) {
        const int it1 = it + NGW; if (it1 < nit) { B = dec(it1); tr_load(B, tb, lane); }
        tr_store(A, ta, scr, lane);
        const int it2 = it1 + NGW; if (it2 < nit) { A = dec(it2); tr_load(A, ta, lane); }
        if (it1 < nit) tr_store(B, tb, scr, lane);
        it = it2;
    }
}

struct Args { const float* in[21]; float* out; unsigned char* ws; int ph_lo, ph_hi; };
typedef const Args __attribute__((address_space(4))) * KArgsP;
enum { I_X = 0, I_ATTN_NORM, I_W_IN, I_LB, I_OUT_NORM, I_Q_NORM, I_W_UQ, I_KV_NORM, I_W_UKV, I_POOL_W, I_POOL_SCALE, I_W_O, I_FFN_NORM, I_DG, I_DU, I_DD, I_ROUTER, I_MG, I_MU, I_MD, I_FINAL_NORM };
constexpr int NPH = 23;

constexpr int P0_I_WIN = 16 * 70, P0_I_WOP = 8 * 32, P0_I_DGU = 16 * 80, P0_I_DDN = 40 * 32, P0_NIT = 2 * P0_I_WIN + 2 * P0_I_WOP + 2 * P0_I_DGU + P0_I_DDN;
struct DenseDec { KArgsP ap_; unsigned char* ws;
    __device__ __forceinline__ TrItem operator()(int it) const { constexpr int I_WIN = P0_I_WIN, I_WOP = P0_I_WOP, I_DGU = P0_I_DGU; int r = it; TrItem t;
        if (r < 2 * I_WIN) { const int l = r / I_WIN; r -= l * I_WIN; const int kb = r / 70, nb = r % 70;
            t.W = ap_->in[I_W_IN] + (size_t)l * DM * DIN; t.N = DIN; t.k0 = kb * 64; t.n0 = nb * 32; t.dst = (bf16_t*)(ws + WS_WIN) + (size_t)l * DINP * DM; t.drow0 = nb * 32; t.ldd = DM; t.kofs = kb * 64; return t; }
        r -= 2 * I_WIN;
        if (r < 2 * I_WOP) { const int l = r / I_WOP; r -= l * I_WOP; const int kq = r / 32, nb = r % 32; const int kb = kq < 4 ? kq : kq + 8;
            t.W = ap_->in[I_W_O] + (size_t)l * DM * DM; t.N = DM; t.k0 = kb * 64; t.n0 = nb * 32; t.dst = (bf16_t*)(ws + WS_WO) + (size_t)l * DM * DM; t.drow0 = nb * 32; t.ldd = DM; t.kofs = kb * 64; return t; }
        r -= 2 * I_WOP;
        if (r < 2 * I_DGU) { const int up = r / I_DGU; r -= up * I_DGU; const int kb = r / 80, nb = r % 80; const int n0 = nb * 32;
            t.W = ap_->in[up ? I_DU : I_DG]; t.N = DFF; t.k0 = kb * 64; t.n0 = n0; t.dst = (bf16_t*)(ws + WS_WGU); t.drow0 = (n0 >> 7) * 256 + up * 128 + (n0 & 127); t.ldd = DM; t.kofs = kb * 64; return t; }
        r -= 2 * I_DGU;
        { const int kb = r / 32, nb = r % 32; t.W = ap_->in[I_DD]; t.N = DM; t.k0 = kb * 64; t.n0 = nb * 32; t.dst = (bf16_t*)(ws + WS_WD); t.drow0 = nb * 32; t.ldd = DFF; t.kofs = kb * 64; return t; } } };
constexpr int MOE_I_GU = 16 * 112, MOE_I_DN = 56 * 32, MOE_I_E = 2 * MOE_I_GU + MOE_I_DN;
struct MoeDec { const float* mg; const float* mu; const float* md; unsigned char* wsp;
    __device__ __forceinline__ TrItem operator()(int it) const { constexpr int I_GU = MOE_I_GU, I_E = MOE_I_E; const int e = it / I_E; int r = it % I_E; bf16_t* we = (bf16_t*)(wsp + WS_MOEW) + (size_t)e * MOEW_E; TrItem t;
        if (r < 2 * I_GU) { const int up = r / I_GU; r -= up * I_GU; const int kb = r / 112, nb = r % 112, n0 = nb * 32;
            t.W = (up ? mu : mg) + (size_t)e * DM * DFFE; t.N = DFFE; t.k0 = kb * 64; t.n0 = n0; t.dst = we; t.drow0 = (n0 >> 7) * 256 + up * 128 + (n0 & 127); t.ldd = DM; t.kofs = kb * 64; }
        else { r -= 2 * I_GU; const int kb = r / 32, nb = r % 32;
            t.W = md + (size_t)e * DFFE * DM; t.N = DM; t.k0 = kb * 64; t.n0 = nb * 32; t.dst = we + (size_t)2 * DFFE * DM; t.drow0 = nb * 32; t.ldd = DFFE; t.kofs = kb * 64; }
        return t; } };
struct P0StreamDec { DenseDec d; MoeDec m; __device__ __forceinline__ TrItem operator()(int it) const { if (it < P0_NIT) return d(it); return m(it - P0_NIT); } };
__device__ __forceinline__ void p0_stream(KArgsP ap_, LAS unsigned char* lds, int gw, int NGW, int wave, int lane) {
    LAS float* scr = (LAS float*)(lds + wave * 16384);
    P0StreamDec dec{DenseDec{ap_, ap_->ws}, MoeDec{ap_->in[I_MG], ap_->in[I_MU], ap_->in[I_MD], ap_->ws}};
    tr_run(dec, P0_NIT + NE * MOE_I_E, gw, NGW, scr, lane);
}

__device__ __forceinline__ void p0_prologue(KArgsP ap_, LAS unsigned char* lds, int gw, int NGW, int gt, int NGT, int wave, int lane, const int part) {
    unsigned char* ws = ap_->ws;
    LAS float* scr = (LAS float*)(lds + wave * 16384);
    for (int i = gt; i < 2 * 64 * DM / 8; i += NGT) { const int l = i / (64 * DM / 8), r = i % (64 * DM / 8);
        *(u32x4*)((bf16_t*)(ws + WS_WIN) + ((size_t)l * DINP + DIN) * DM + (size_t)r * 8) = (u32x4){0u, 0u, 0u, 0u}; }
    const float qscale = 0.07216878364870322f * 1.4426950408889634f;
    for (int i = gt; i < 2 * 4 * 16 * 256; i += NGT) { const int c = i & 255, jg = (i >> 8) & 15, h = (i >> 12) & 3, l = i >> 14, j0 = jg * 8;
        const float* wuq = ap_->in[I_W_UQ] + (size_t)l * 256 * QW + (size_t)c * QW + h * 192; const float* wk = ap_->in[I_W_UKV] + (size_t)l * 128 * 1024 + (size_t)j0 * 1024 + h * 256;
        float acc[8];
#pragma unroll
        for (int q = 0; q < 8; ++q) acc[q] = 0.f;
#pragma unroll 4
        for (int d = 0; d < 128; d += 4) { const f32x4 x = *(const f32x4*)(wuq + d);
#pragma unroll
            for (int q = 0; q < 8; ++q) { const f32x4 y = *(const f32x4*)(wk + (size_t)q * 1024 + d); acc[q] += (x[0] * y[0] + x[1] * y[1]) + (x[2] * y[2] + x[3] * y[3]); } }
        const float gsc = ap_->in[I_Q_NORM][l * 256 + c] * qscale;
#pragma unroll
        for (int q = 0; q < 8; ++q) ((bf16_t*)(ws + WS_WQ))[((size_t)l * QW + h * 192 + j0 + q) * 256 + c] = f2bf(acc[q] * gsc); }
    for (int i = gt; i < 2 * 4 * 64 * 256; i += NGT) { const int c = i & 255, jj = (i >> 8) & 63, h = (i >> 14) & 3, l = i >> 16;
        const float v = ap_->in[I_W_UQ][(size_t)l * 256 * QW + (size_t)c * QW + h * 192 + 128 + (jj >> 1) + 32 * (jj & 1)];
        ((bf16_t*)(ws + WS_WQ))[((size_t)l * QW + h * 192 + 128 + jj) * 256 + c] = f2bf(v * ap_->in[I_Q_NORM][l * 256 + c] * qscale); }
    for (int i = gt; i < 2 * DM * 64; i += NGT) { const int n = i & 1023, g = (i >> 10) & 63, l = i >> 16, kk0 = g * 8, h = kk0 >> 7, r0 = kk0 & 127;
        const float* wv = ap_->in[I_W_UKV] + (size_t)l * 128 * 1024 + (size_t)r0 * 1024 + h * 256 + 128; const float* wo = ap_->in[I_W_O] + (size_t)l * DM * DM + (size_t)(256 + h * 128) * DM + n;
        float acc[8];
#pragma unroll
        for (int j = 0; j < 8; ++j) acc[j] = 0.f;
#pragma unroll 4
        for (int e = 0; e < 128; e += 4) { const float w0 = wo[(size_t)e * DM], w1 = wo[(size_t)(e + 1) * DM], w2 = wo[(size_t)(e + 2) * DM], w3 = wo[(size_t)(e + 3) * DM];
#pragma unroll
            for (int j = 0; j < 8; ++j) { const f32x4 x = *(const f32x4*)(wv + (size_t)j * 1024 + e); acc[j] += (x[0] * w0 + x[1] * w1) + (x[2] * w2 + x[3] * w3); } }
        *(u32x4*)((bf16_t*)(ws + WS_WO) + (size_t)l * DM * DM + (size_t)n * DM + 256 + kk0) = (u32x4){cvt_pk_bf16(acc[0], acc[1]), cvt_pk_bf16(acc[2], acc[3]), cvt_pk_bf16(acc[4], acc[5]), cvt_pk_bf16(acc[6], acc[7])}; }
    for (int i = gt; i < SEQ * 32; i += NGT) { const int pos = i >> 5, f = i & 31; float s, c; sincos_d((double)pos * ROPE_INVF[f], s, c); ((float*)(ws + WS_COS))[i] = c; ((float*)(ws + WS_SIN))[i] = s; }
    for (int i = gt; i < 512; i += NGT) { const float x0 = ap_->in[I_LB][i], x1 = ap_->in[I_LB][512 + i]; ((float*)(ws + WS_LBS))[i] = 0.f; ((float*)(ws + WS_LBS))[512 + i] = 1.f / (1.f + expf(x0 - x1)); }
}
__device__ __forceinline__ void unpack4(const u32x2 w, f32x4& v) { v[0] = __uint_as_float(w.x << 16); v[1] = __uint_as_float(w.x & 0xffff0000u); v[2] = __uint_as_float(w.y << 16); v[3] = __uint_as_float(w.y & 0xffff0000u); }
template <bool XB16>
__device__ __forceinline__ void norm_to_bf16(const void* xs_, const bf16_t* dl, bf16_t* xd, const float* g, bf16_t* hn, int gw, int NGW, int lane) {
    f32x4 gv[4];
#pragma unroll
    for (int j = 0; j < 4; ++j) gv[j] = *(const f32x4*)(g + 4 * lane + 256 * j);
    for (int m0 = gw; m0 < T; m0 += 2 * NGW) {
        const int m1 = m0 + NGW < T ? m0 + NGW : m0; f32x4 v[2][4]; u32x2 xw[2][4], dw[2][4];
#pragma unroll
        for (int u = 0; u < 2; ++u) { const int m = u ? m1 : m0;
            if (XB16) { const u32x2* xr = (const u32x2*)((const bf16_t*)xs_ + (size_t)m * DM) + lane;
#pragma unroll
                for (int j = 0; j < 4; ++j) xw[u][j] = xr[64 * j]; }
            else { const f32x4* xr = (const f32x4*)((const float*)xs_ + (size_t)m * DM) + lane;
#pragma unroll
                for (int j = 0; j < 4; ++j) v[u][j] = xr[64 * j]; }
            if (dl) { const u32x2* dr = (const u32x2*)(dl + (size_t)m * DM) + lane;
#pragma unroll
                for (int j = 0; j < 4; ++j) dw[u][j] = dr[64 * j]; } }
#pragma unroll
        for (int u = 0; u < 2; ++u) { const int m = u ? m1 : m0; if (u && m1 == m0) break; float s = 0.f;
            if (XB16) {
#pragma unroll
                for (int j = 0; j < 4; ++j) unpack4(xw[u][j], v[u][j]); }
            if (dl) {
#pragma unroll
                for (int j = 0; j < 4; ++j) { f32x4 d; unpack4(dw[u][j], d); v[u][j] += d;
                    u32x2 w; w.x = cvt_pk_bf16(v[u][j][0], v[u][j][1]); w.y = cvt_pk_bf16(v[u][j][2], v[u][j][3]); *(u32x2*)(xd + (size_t)m * DM + 4 * lane + 256 * j) = w; } }
#pragma unroll
            for (int j = 0; j < 4; ++j) s += (v[u][j][0] * v[u][j][0] + v[u][j][1] * v[u][j][1]) + (v[u][j][2] * v[u][j][2] + v[u][j][3] * v[u][j][3]);
            const float rstd = 1.0f / sqrtf(wave_sum(s) * (1.f / DM) + EPS);
#pragma unroll
            for (int j = 0; j < 4; ++j) { const f32x4 o = v[u][j] * rstd * gv[j]; u32x2 w; w.x = cvt_pk_bf16(o[0], o[1]); w.y = cvt_pk_bf16(o[2], o[3]); *(u32x2*)(hn + (size_t)m * DM + 4 * lane + 256 * j) = w; } }
    }
}
__device__ __forceinline__ void norm_final(const bf16_t* x, float* out, const float* g, int gw, int NGW, int lane) {
    f32x4 gv[4];
#pragma unroll
    for (int j = 0; j < 4; ++j) gv[j] = *(const f32x4*)(g + 4 * lane + 256 * j);
    for (int m0 = gw; m0 < T; m0 += 2 * NGW) {
        const int m1 = m0 + NGW < T ? m0 + NGW : m0; u32x2 xw[2][4];
#pragma unroll
        for (int u = 0; u < 2; ++u) { const int m = u ? m1 : m0; const u32x2* xr = (const u32x2*)(x + (size_t)m * DM) + lane;
#pragma unroll
            for (int j = 0; j < 4; ++j) xw[u][j] = xr[64 * j]; }
#pragma unroll
        for (int u = 0; u < 2; ++u) { const int m = u ? m1 : m0; if (u && m1 == m0) break; float s = 0.f; f32x4 v[4];
#pragma unroll
            for (int j = 0; j < 4; ++j) { unpack4(xw[u][j], v[j]); s += (v[j][0] * v[j][0] + v[j][1] * v[j][1]) + (v[j][2] * v[j][2] + v[j][3] * v[j][3]); }
            const float rstd = 1.0f / sqrtf(wave_sum(s) * (1.f / DM) + EPS);
            f32x4* xw4 = (f32x4*)(out + (size_t)m * DM) + lane;
#pragma unroll
            for (int j = 0; j < 4; ++j) xw4[64 * j] = v[j] * rstd * gv[j]; }
    }
}
template <bool SLIM>
__device__ __forceinline__ void norm_router(bf16_t* x, const bf16_t* dl, const float* g, const float* router, bf16_t* hn, int* tok_e, float* tok_g, int* counts, LAS unsigned char* lds, int bx, int G, int tid, int wave, int lane) {
    LAS float* rl = (LAS float*)lds;
    LAS int* cl = (LAS int*)(lds + 32768);
    for (int i = tid; i < DM * NE; i += NWAVES * 64) rl[i] = router[i];
    f32x4 gv[4];
#pragma unroll
    for (int j = 0; j < 4; ++j) gv[j] = *(const f32x4*)(g + 4 * lane + 256 * j);
    for (int rg = bx; rg < T / 128; rg += G) {
        if (tid < 16) cl[tid] = 0;
        __syncthreads();
        u32x2 dwn[4], xwn[4];
        { const int m = rg * 128 + wave * 16; const u32x2* xr = (const u32x2*)(x + (size_t)m * DM) + lane; const u32x2* dr = (const u32x2*)(dl + (size_t)m * DM) + lane;
#pragma unroll
          for (int j = 0; j < 4; ++j) { if constexpr (!SLIM) dwn[j] = dr[64 * j]; xwn[j] = xr[64 * j]; } }
        for (int rr = 0; rr < 16; ++rr) { const int m = rg * 128 + wave * 16 + rr;
            u32x2* xr = (u32x2*)(x + (size_t)m * DM) + lane; f32x4 v[4]; u32x2 dw[4], xw[4]; float s = 0.f;
#pragma unroll
            for (int j = 0; j < 4; ++j) { dw[j] = dwn[j]; xw[j] = xwn[j]; }
            if (rr + 1 < 16) { const u32x2* xq = (const u32x2*)(x + (size_t)(m + 1) * DM) + lane; const u32x2* dq = (const u32x2*)(dl + (size_t)(m + 1) * DM) + lane;
#pragma unroll
                for (int j = 0; j < 4; ++j) { if constexpr (!SLIM) dwn[j] = dq[64 * j]; xwn[j] = xq[64 * j]; } }
#pragma unroll
            for (int j = 0; j < 4; ++j) { unpack4(xw[j], v[j]);
                if constexpr (!SLIM) { f32x4 d; unpack4(dw[j], d); v[j] += d; u32x2 w; w.x = cvt_pk_bf16(v[j][0], v[j][1]); w.y = cvt_pk_bf16(v[j][2], v[j][3]); xr[64 * j] = w; }
                s += (v[j][0] * v[j][0] + v[j][1] * v[j][1]) + (v[j][2] * v[j][2] + v[j][3] * v[j][3]); }
            const float rstd = 1.0f / sqrtf(wave_sum(s) * (1.f / DM) + EPS);
            float lg[NE];
#pragma unroll
            for (int e = 0; e < NE; ++e) lg[e] = 0.f;
#pragma unroll
            for (int j = 0; j < 4; ++j) { const f32x4 o = v[j] * rstd * gv[j]; if constexpr (!SLIM) { u32x2 w; w.x = cvt_pk_bf16(o[0], o[1]); w.y = cvt_pk_bf16(o[2], o[3]); *(u32x2*)(hn + (size_t)m * DM + 4 * lane + 256 * j) = w; }
#pragma unroll
                for (int i = 0; i < 4; ++i) { const LAS f32x4* rp = (const LAS f32x4*)(rl + (size_t)(4 * lane + 256 * j + i) * NE); const f32x4 r0 = rp[0], r1 = rp[1];
                    lg[0] += o[i] * r0[0]; lg[1] += o[i] * r0[1]; lg[2] += o[i] * r0[2]; lg[3] += o[i] * r0[3]; lg[4] += o[i] * r1[0]; lg[5] += o[i] * r1[1]; lg[6] += o[i] * r1[2]; lg[7] += o[i] * r1[3]; } }
#pragma unroll
            for (int e = 0; e < NE; ++e) lg[e] = wave_sum(lg[e]);
            int i1 = 0; float v1 = lg[0];
#pragma unroll
            for (int e = 1; e < NE; ++e) if (lg[e] > v1) { v1 = lg[e]; i1 = e; }
            int i2 = -1; float v2 = -3.0e38f;
#pragma unroll
            for (int e = 0; e < NE; ++e) if (e != i1 && lg[e] > v2) { v2 = lg[e]; i2 = e; }
            const float ex = expf(v2 - v1), g1 = 1.f / (1.f + ex), g2 = ex * g1;
            if (lane == 0) { tok_e[2 * m] = i1; tok_e[2 * m + 1] = i2; tok_g[2 * m] = g1; tok_g[2 * m + 1] = g2; atomicAdd((int*)&cl[i1], 1); atomicAdd((int*)&cl[8 + i2], 1); }
        }
        __syncthreads();
        if (tid < 16) counts[rg * 16 + tid] = cl[tid];
        __syncthreads();
    }
}
__device__ __forceinline__ void route_tables(const int* tok_e, const float* tok_g, const int* counts, int* slot_tok, float* slot_g, int* tile_e, LAS unsigned char* lds, int bx, int G, int tid) {
    LAS int* pre = (LAS int*)lds;
    LAS int* off = (LAS int*)(lds + 257 * 16 * 4);
    LAS int* el = off + 16;
    { LAS int* segt = el + 256;
      for (int i = tid; i < 256 * 16; i += NWAVES * 64) pre[i] = counts[i];
      __syncthreads();
      const int col = tid & 15, seg = (tid >> 4) & 15;
      if (tid < 256) { int run = 0; for (int k = 0; k < 16; ++k) { const int rg = seg * 16 + k; const int v = pre[rg * 16 + col]; pre[rg * 16 + col] = run; run += v; } segt[seg * 16 + col] = run; }
      __syncthreads();
      if (tid < 256) { int base = 0; for (int s2 = 0; s2 < seg; ++s2) base += segt[s2 * 16 + col];
          for (int k = 0; k < 16; ++k) pre[(seg * 16 + k) * 16 + col] += base;
          if (seg == 15) pre[256 * 16 + col] = base + segt[15 * 16 + col]; }
      __syncthreads(); }
    if (tid < 2) { int run = 0; for (int e = 0; e < NE; ++e) { off[tid * 8 + e] = run; run += (pre[256 * 16 + tid * 8 + e] + 255) & ~255; }
        if (bx == 0) { tile_e[tid * 256] = run >> 8; for (int e = 0; e < NE; ++e) { const int t0 = off[tid * 8 + e] >> 8, nt = (pre[256 * 16 + tid * 8 + e] + 255) >> 8; for (int t = 0; t < nt; ++t) tile_e[tid * 256 + 1 + t0 + t] = e; } } }
    __syncthreads();
    if (bx == 0) {
        for (int i = tid; i < 16 * 256; i += NWAVES * 64) { const int re = i >> 8, j = i & 255, r = re >> 3; const int tot = pre[256 * 16 + re], padn = ((tot + 255) & ~255) - tot;
            if (j < padn) { slot_tok[r * MOE_ROWS + off[re] + tot + j] = -1; slot_g[r * MOE_ROWS + off[re] + tot + j] = 0.f; } } }
    for (int rg = bx; rg < T / 128; rg += G) {
        if (tid < 256) { const int r = tid >> 7, j = tid & 127; el[r * 128 + j] = tok_e[2 * (rg * 128 + j) + r]; }
        __syncthreads();
        if (tid < 256) { const int r = tid >> 7, j = tid & 127, m = rg * 128 + j, e = el[r * 128 + j]; int loc = 0;
            for (int jj = 0; jj < j; ++jj) loc += (el[r * 128 + jj] == e) ? 1 : 0;
            const int slot = off[r * 8 + e] + pre[rg * 16 + r * 8 + e] + loc;
            slot_tok[r * MOE_ROWS + slot] = m; slot_g[r * MOE_ROWS + slot] = tok_g[2 * m + r]; }
        __syncthreads();
    }
}

__device__ __forceinline__ void prep_tokens(const bf16_t* proj, const float* kvg, const float* cosT, const float* sinT, float* rstdq, bf16_t* klat, bf16_t* krope, int gw, int NGW, int lane) {
    const float g0 = kvg[2 * lane], g1 = kvg[2 * lane + 1];
    constexpr int NT = 4;
    for (int mb = gw; mb < T; mb += NT * NGW) {
        u32x2 cq[NT]; unsigned ck[NT]; unsigned short xa[NT], xb[NT]; float cc[NT], sn[NT];
#pragma unroll
        for (int u = 0; u < NT; ++u) { const int m = mb + u * NGW < T ? mb + u * NGW : mb; const bf16_t* pr = proj + (size_t)m * DINP;
            cq[u] = *(const u32x2*)(pr + COL_CQ + 4 * lane); ck[u] = *(const unsigned*)(pr + COL_CKV + 2 * lane);
            const int pos = m & (SEQ - 1), l5 = lane & 31; xa[u] = pr[COL_KPE + l5]; xb[u] = pr[COL_KPE + 32 + l5]; cc[u] = cosT[pos * 32 + l5]; sn[u] = sinT[pos * 32 + l5]; }
#pragma unroll
        for (int u = 0; u < NT; ++u) { const int m = mb + u * NGW; if (m >= T) break;
            const float a0 = __uint_as_float(cq[u].x << 16), a1 = __uint_as_float(cq[u].x & 0xffff0000u), a2 = __uint_as_float(cq[u].y << 16), a3 = __uint_as_float(cq[u].y & 0xffff0000u);
            const float k0 = __uint_as_float(ck[u] << 16), k1 = __uint_as_float(ck[u] & 0xffff0000u);
            const float sq = wave_sum((a0 * a0 + a1 * a1) + (a2 * a2 + a3 * a3)), sk = wave_sum(k0 * k0 + k1 * k1);
            if (lane == 0) rstdq[m] = 1.0f / sqrtf(sq * (1.f / 256.f) + EPS);
            const float rk = 1.0f / sqrtf(sk * (1.f / 128.f) + EPS);
            *(unsigned*)(klat + (size_t)m * 128 + 2 * lane) = cvt_pk_bf16(k0 * rk * g0, k1 * rk * g1);
            if (lane < 32) { const float x1 = bf2f(xa[u]), x2 = bf2f(xb[u]);
                *(unsigned*)(krope + (size_t)m * 64 + 2 * lane) = cvt_pk_bf16(x1 * cc[u] - x2 * sn[u], x1 * sn[u] + x2 * cc[u]); } }
    }
}

__device__ __forceinline__ void pool_phase(const bf16_t* proj, const float* pw, const float* pscale, bf16_t* ocat, LAS unsigned char* lds, int bx, int G, int tid) {
    constexpr int PP = 264, WP = 72;
    LAS bf16_t* xs = (LAS bf16_t*)lds;
    LAS bf16_t* pl = (LAS bf16_t*)(lds + 40960);
    LAS bf16_t* wt = (LAS bf16_t*)(lds + 40960 + 64 * PP * 2);
    const int lane = tid & 63, wave = tid >> 6, r32 = lane & 31, hi = lane >> 5;
    for (int i = tid; i < 4 * 64 * 64; i += NWAVES * 64) { const int g = i >> 12, c = (i >> 6) & 63, d = i & 63; wt[(g * 64 + d) * WP + c] = f2bf(pw[i]); }
    const int ch = tid & 255, half = tid >> 8, gch = ch >> 6, w = 2 << gch;
    const int g = wave >> 1, tb = wave & 1;
    const float sc0 = pscale[g * 64 + r32], sc1 = pscale[g * 64 + 32 + r32];
    for (int tile = bx; tile < T / 64; tile += G) {
        const int tok0 = tile * 64, pos0 = tok0 & (SEQ - 1);
#pragma unroll
        for (int i = 0; i < 5; ++i) { const int idx = tid + i * 512, r = idx >> 5, c8 = (idx & 31) * 8; u32x4 v = {0u, 0u, 0u, 0u};
            if (pos0 - 16 + r >= 0) v = *(const u32x4*)(proj + (size_t)(tok0 - 16 + r) * DINP + COL_XP + c8);
            *(LAS u32x4*)(xs + r * 256 + c8) = v; }
        __syncthreads();
        { const int t0 = half * 32; float s = 0.f;
          for (int j = 1; j < w; ++j) s += bf2f(xs[(t0 + 16 - j) * 256 + ch]);
          for (int tt = 0; tt < 32; ++tt) { const int t = t0 + tt, r = t + 16; const float xv = bf2f(xs[r * 256 + ch]); s += xv;
              const int pc = pos0 + t + 1; const float cnt = (float)(pc < w ? pc : w);
              pl[t * PP + ch] = f2bf(s / cnt - xv);
              s -= bf2f(xs[(r - w + 1) * 256 + ch]); } }
        __syncthreads();
        { f32x16 acc0 = {}, acc1 = {};
#pragma unroll
          for (int ks = 0; ks < 4; ++ks) { const bf16x8 af = *(const LAS bf16x8*)(pl + (tb * 32 + r32) * PP + g * 64 + ks * 16 + 8 * hi);
              const bf16x8 b0 = *(const LAS bf16x8*)(wt + (g * 64 + r32) * WP + ks * 16 + 8 * hi), b1 = *(const LAS bf16x8*)(wt + (g * 64 + 32 + r32) * WP + ks * 16 + 8 * hi);
              acc0 = __builtin_amdgcn_mfma_f32_32x32x16_bf16(af, b0, acc0, 0, 0, 0); acc1 = __builtin_amdgcn_mfma_f32_32x32x16_bf16(af, b1, acc1, 0, 0, 0); }
          bf16_t* op = ocat + (size_t)(tok0 + tb * 32) * DM + 768 + g * 64 + r32;
#pragma unroll
          for (int i = 0; i < 16; ++i) { const int row = (i & 3) + 8 * (i >> 2) + 4 * hi; const float v0 = acc0[i] * sc0, v1 = acc1[i] * sc1;
              const float n0 = xlane1(v0), n1 = xlane1(v1);
              if ((r32 & 1) == 0) { *(unsigned*)(op + (size_t)row * DM) = cvt_pk_bf16(v0, n0); *(unsigned*)(op + (size_t)row * DM + 32) = cvt_pk_bf16(v1, n1); } } }
        __syncthreads();
    }
}

__device__ __forceinline__ void hg_load16(const bf16_t* p, bf16_t (&z)[16]) {
#pragma unroll
    for (int j = 0; j < 16; ++j) z[j] = p[(size_t)j * DINP];
}
__device__ __forceinline__ void hg_gates(const bf16_t (&zr)[16], const float lb, LAS float* qs, int k, int q, float (&bc)[16], float (&kk)[16], float& blast, float& bmid) {
    const float omlb = 1.f - lb;
    float run = 0.f;
#pragma unroll
    for (int j = 0; j < 16; ++j) { const float z = bf2f(zr[j]);
        const float e = fast_exp(fminf(-z, 80.f)), sg = __builtin_amdgcn_rcpf(1.f + e);
        const float f = lb + omlb * sg; run += __builtin_amdgcn_logf(fmaxf(f, 1e-20f)) * 0.6931471805599453f; bc[j] = run; kk[j] = omlb * e * sg; }
    qs[q * 128 + k] = run;
    __syncthreads();
    const float s0 = qs[k], s1 = qs[128 + k], s2 = qs[256 + k], s3 = qs[384 + k];
    const float base = q == 0 ? 0.f : q == 1 ? s0 : q == 2 ? s0 + s1 : s0 + s1 + s2;
#pragma unroll
    for (int j = 0; j < 16; ++j) bc[j] += base;
    blast = (s0 + s1) + (s2 + s3); bmid = s0 + s1;
}
__device__ __forceinline__ f32x16 mfma32(bf16x8 a, bf16x8 b, f32x16 c) { return __builtin_amdgcn_mfma_f32_32x32x16_bf16(a, b, c, 0, 0, 0); }
constexpr int HG_PK = 136, HG_PS = 72;
#define HG_UNIT(u, b_, h_, tok0_) const int b_ = (u) >> 10, h_ = ((u) >> 8) & 3, tok0_ = b_ * SEQ + ((u) & 255) * 64
__device__ __forceinline__ void hgrn_local(const bf16_t* proj, const float* lbs_l, bf16_t* ubuf, float* dvec, LAS unsigned char* lds, int bx, int G, int tid, int wave, int lane) {
    LAS float* qs = (LAS float*)lds; LAS bf16_t* Kt = (LAS bf16_t*)(lds + 2048); LAS bf16_t* Vt = (LAS bf16_t*)(lds + 2048 + 128 * HG_PS * 2);
    const int k = tid & 127, q = tid >> 7, r32 = lane & 31, hi = lane >> 5, vs = tid >> 3, v0 = (tid & 7) * 8;
    bf16_t zc[16]; bf16x8 vc;
    if (bx < NUNIT) { HG_UNIT(bx, b, h, tok0); hg_load16(proj + (size_t)(tok0 + q * 16) * DINP + COL_HF + h * 128 + k, zc); vc = *(const bf16x8*)(proj + (size_t)(tok0 + vs) * DINP + COL_HI + h * 64 + v0); }
    for (int u = bx; u < NUNIT; u += G) {
        HG_UNIT(u, b, h, tok0); (void)b; (void)tok0;
        const float lb = lbs_l[h * 128 + k];
        bf16_t zn[16]; bf16x8 vn;
        { const int un = (u + G < NUNIT) ? u + G : u; HG_UNIT(un, bn, hn, tokn); (void)bn;
          hg_load16(proj + (size_t)(tokn + q * 16) * DINP + COL_HF + hn * 128 + k, zn); vn = *(const bf16x8*)(proj + (size_t)(tokn + vs) * DINP + COL_HI + hn * 64 + v0); }
        float bc[16], kk[16], blast, bmid;
        hg_gates(zc, lb, qs, k, q, bc, kk, blast, bmid);
        { unsigned w[8];
#pragma unroll
          for (int j = 0; j < 8; ++j) w[j] = cvt_pk_bf16(kk[2 * j] * fast_exp(blast - bc[2 * j]), kk[2 * j + 1] * fast_exp(blast - bc[2 * j + 1]));
          *(LAS u32x4*)(Kt + k * HG_PS + q * 16) = (u32x4){w[0], w[1], w[2], w[3]}; *(LAS u32x4*)(Kt + k * HG_PS + q * 16 + 8) = (u32x4){w[4], w[5], w[6], w[7]}; }
#pragma unroll
        for (int j = 0; j < 8; ++j) Vt[(v0 + j) * HG_PS + vs] = (bf16_t)vc[j];
        if (q == 0) dvec[(size_t)u * 128 + k] = fast_exp(blast);
        __syncthreads();
        { const int vb = wave >> 2, kb = wave & 3; f32x16 acc = {};
#pragma unroll
          for (int ks = 0; ks < 4; ++ks) { const bf16x8 af = *(const LAS bf16x8*)(Vt + (vb * 32 + r32) * HG_PS + ks * 16 + 8 * hi), bfr = *(const LAS bf16x8*)(Kt + (kb * 32 + r32) * HG_PS + ks * 16 + 8 * hi);
              acc = mfma32(af, bfr, acc); }
          bf16_t* up = ubuf + ((size_t)u * 64 + vb * 32) * 128 + kb * 32 + r32;
#pragma unroll
          for (int i = 0; i < 16; ++i) { const float vn = xlane1(acc[i]); if ((r32 & 1) == 0) *(unsigned*)(up + (size_t)((i & 3) + 8 * (i >> 2) + 4 * hi) * 128) = cvt_pk_bf16(acc[i], vn); } }
#pragma unroll
        for (int j = 0; j < 16; ++j) zc[j] = zn[j];
        vc = vn;
        __syncthreads();
    }
}
__device__ __forceinline__ void hgrn_scan(bf16_t* ubuf, const float* dvec, int bx, int G, int tid) {
    for (int j = (G >= 256 ? bx - (G - 128) : bx); j < 128; j += G) {
        if (j < 0 || tid >= 256) continue;
        const int bh = j >> 4, e = (j & 15) * 512 + tid * 2, k = e & 127;
        unsigned* up = (unsigned*)(ubuf + (size_t)bh * 256 * 8192 + e); const f32x2* dp = (const f32x2*)(dvec + (size_t)bh * 256 * 128 + k);
        float S0 = 0.f, S1 = 0.f;
        for (int c = 0; c < NCHUNK; c += 64) { unsigned uv[64]; f32x2 dv[64];
#pragma unroll
            for (int i = 0; i < 64; ++i) { uv[i] = up[(size_t)(c + i) * 4096]; dv[i] = dp[(size_t)(c + i) * 64]; }
#pragma unroll
            for (int i = 0; i < 64; ++i) { up[(size_t)(c + i) * 4096] = cvt_pk_bf16(S0, S1); S0 = dv[i][0] * S0 + __uint_as_float(uv[i] << 16); S1 = dv[i][1] * S1 + __uint_as_float(uv[i] & 0xffff0000u); } }
    }
}
__device__ __forceinline__ void hgrn_out(const bf16_t* proj, const float* lbs_l, const bf16_t* ubuf, const float* onorm, bf16_t* ocat, LAS unsigned char* lds, int bx, int G, int tid, int wave, int lane) {
    LAS float* qs = (LAS float*)lds;
    LAS bf16_t* Qi = (LAS bf16_t*)(lds + 2048); LAS bf16_t* Qp = Qi + 64 * HG_PK; LAS bf16_t* Kp = Qp + 64 * HG_PK; LAS bf16_t* St = Kp + 64 * HG_PK;
    LAS bf16_t* Vt = St + 64 * HG_PK; LAS bf16_t* Aq = Vt + 64 * HG_PS; LAS float* Ol = (LAS float*)(Aq + 64 * HG_PS);
    const int k = tid & 127, q = tid >> 7, r32 = lane & 31, hi = lane >> 5, vs = tid >> 3, v0 = (tid & 7) * 8, k0 = (tid & 7) * 16;
    bf16_t zc[16], qc[16]; bf16x8 vc;
    if (bx < NUNIT) { HG_UNIT(bx, b, h, tok0); hg_load16(proj + (size_t)(tok0 + q * 16) * DINP + COL_HF + h * 128 + k, zc); hg_load16(proj + (size_t)(tok0 + q * 16) * DINP + COL_HQ + h * 128 + k, qc);
        vc = *(const bf16x8*)(proj + (size_t)(tok0 + vs) * DINP + COL_HI + h * 64 + v0); }
    for (int u = bx; u < NUNIT; u += G) {
        HG_UNIT(u, b, h, tok0); (void)b;
        const float lb = lbs_l[h * 128 + k];
        const bf16_t* sp = ubuf + ((size_t)u * 64 + vs) * 128 + k0;
        const u32x4 a0 = *(const u32x4*)sp, a1 = *(const u32x4*)(sp + 8);
        const bf16x8 gg = *(const bf16x8*)(proj + (size_t)(tok0 + vs) * DINP + COL_HG + h * 64 + v0);
        bf16_t zn[16], qn[16]; bf16x8 vn;
        { const int un = (u + G < NUNIT) ? u + G : u; HG_UNIT(un, bn, hn, tokn); (void)bn;
          hg_load16(proj + (size_t)(tokn + q * 16) * DINP + COL_HF + hn * 128 + k, zn); hg_load16(proj + (size_t)(tokn + q * 16) * DINP + COL_HQ + hn * 128 + k, qn);
          vn = *(const bf16x8*)(proj + (size_t)(tokn + vs) * DINP + COL_HI + hn * 64 + v0); }
        float bc[16], kk[16], blast, bmid;
        hg_gates(zc, lb, qs, k, q, bc, kk, blast, bmid);
#pragma unroll
        for (int j = 0; j < 16; ++j) { const int t = q * 16 + j; const float qr = bf2f(qc[j]); const float qf = qr * sigmoidf_(qr);
            Qi[t * HG_PK + k] = f2bf(qf * fast_exp(bc[j])); Qp[t * HG_PK + k] = f2bf(qf * fast_exp(bc[j] - bmid)); Kp[t * HG_PK + k] = f2bf(kk[j] * fast_exp(bmid - bc[j])); }
        *(LAS u32x4*)(St + vs * HG_PK + k0) = a0;
        *(LAS u32x4*)(St + vs * HG_PK + k0 + 8) = a1;
#pragma unroll
        for (int j = 0; j < 8; ++j) Vt[(v0 + j) * HG_PS + vs] = (bf16_t)vc[j];
        __syncthreads();
        f32x16 oacc = {};
        const int tb = (wave >> 1) & 1, vb = wave & 1;
        if (wave < 4) {
#pragma unroll
            for (int kc = 0; kc < 8; ++kc) { const bf16x8 af = *(const LAS bf16x8*)(Qi + (tb * 32 + r32) * HG_PK + kc * 16 + 8 * hi), bfr = *(const LAS bf16x8*)(St + (vb * 32 + r32) * HG_PK + kc * 16 + 8 * hi);
                oacc = mfma32(af, bfr, oacc); }
        } else if (wave < 7) {
            const int tb2 = wave == 4 ? 0 : 1, sb = wave == 6 ? 1 : 0; f32x16 sacc = {};
#pragma unroll
            for (int kc = 0; kc < 8; ++kc) { const bf16x8 af = *(const LAS bf16x8*)(Qp + (tb2 * 32 + r32) * HG_PK + kc * 16 + 8 * hi), bfr = *(const LAS bf16x8*)(Kp + (sb * 32 + r32) * HG_PK + kc * 16 + 8 * hi);
                sacc = mfma32(af, bfr, sacc); }
#pragma unroll
            for (int i = 0; i < 16; ++i) { const int t = tb2 * 32 + (i & 3) + 8 * (i >> 2) + 4 * hi, s = sb * 32 + r32; Aq[t * HG_PS + s] = (s <= t) ? f2bf(sacc[i]) : (bf16_t)0; }
        }
        __syncthreads();
        if (wave < 4) {
            const int nks = tb == 0 ? 2 : 4;
            for (int ks = 0; ks < nks; ++ks) { const bf16x8 af = *(const LAS bf16x8*)(Aq + (tb * 32 + r32) * HG_PS + ks * 16 + 8 * hi), bfr = *(const LAS bf16x8*)(Vt + (vb * 32 + r32) * HG_PS + ks * 16 + 8 * hi);
                oacc = mfma32(af, bfr, oacc); }
#pragma unroll
            for (int i = 0; i < 16; ++i) Ol[(tb * 32 + (i & 3) + 8 * (i >> 2) + 4 * hi) * 68 + vb * 32 + r32] = oacc[i];
        }
        __syncthreads();
        { const int t = vs; const LAS f32x4* op = (const LAS f32x4*)(Ol + t * 68 + v0); const f32x4 o0 = op[0], o1 = op[1];
          float ss = (o0[0] * o0[0] + o0[1] * o0[1]) + (o0[2] * o0[2] + o0[3] * o0[3]) + (o1[0] * o1[0] + o1[1] * o1[1]) + (o1[2] * o1[2] + o1[3] * o1[3]);
          ss = sum8(ss);
          const float rstd = 1.0f / sqrtf(ss * (1.f / 64.f) + EPS);
          const f32x4 n0 = *(const f32x4*)(onorm + h * 64 + v0), n1 = *(const f32x4*)(onorm + h * 64 + v0 + 4);
          float r[8];
#pragma unroll
          for (int j = 0; j < 8; ++j) { const float gv = bf2f((bf16_t)gg[j]); const float ov = j < 4 ? o0[j] : o1[j - 4]; const float nv = j < 4 ? n0[j] : n1[j - 4]; r[j] = ov * rstd * nv * (gv * sigmoidf_(gv)); }
          *(u32x4*)(ocat + (size_t)(tok0 + t) * DM + h * 64 + v0) = (u32x4){cvt_pk_bf16(r[0], r[1]), cvt_pk_bf16(r[2], r[3]), cvt_pk_bf16(r[4], r[5]), cvt_pk_bf16(r[6], r[7])}; }
#pragma unroll
        for (int j = 0; j < 16; ++j) { zc[j] = zn[j]; qc[j] = qn[j]; }
        vc = vn;
        __syncthreads();
    }
}

typedef const Args __attribute__((address_space(4))) * KArgsPtr;
#ifndef ONLY_KIND
#define ONLY_KIND -1
#endif
#ifndef KIND_MASK
#define KIND_MASK 0xFFFFFFFFu
#endif
#define KIND(k) ((ONLY_KIND < 0 || ONLY_KIND == (k)) && ((KIND_MASK >> (k)) & 1u))
#define IN(k) (lo <= (k) && (k) < hi)
#ifndef REPEAT_KIND
#define REPEAT_KIND -1
#endif
#ifndef REPEAT_N
#define REPEAT_N 3
#endif
#define REP(k) for (int rep_ = 0; rep_ < ((REPEAT_KIND) == (k) ? REPEAT_N : 1); ++rep_)
#define SEAM(k) do { if (MK_ONE_LAUNCH && IN(k) && IN((k) + 1)) xcd_barrier(bar, (wave_s * 64 + (int)__builtin_amdgcn_mbcnt_hi(~0u, __builtin_amdgcn_mbcnt_lo(~0u, 0u))) == 0); } while (0)
#define PH_BEGIN() int tid = wave_s * 64 + (int)__builtin_amdgcn_mbcnt_hi(~0u, __builtin_amdgcn_mbcnt_lo(~0u, 0u)); asm volatile("" : "+v"(tid)); const int lane = tid & 63, wave = __builtin_amdgcn_readfirstlane(tid >> 6), gw = bx * NWAVES + wave, gt = bx * (NWAVES * 64) + tid; \
    (void)lane; (void)wave; (void)gw; (void)gt; KArgsPtr ap = (KArgsPtr)__builtin_amdgcn_kernarg_segment_ptr(); asm volatile("" : "+s"(ap)); unsigned char* const ws = ap->ws; (void)ws

template <int l>
__device__ __forceinline__ void layer_body(LAS unsigned char* L, unsigned char* lds, const int lo, const int hi, const XcdBarrier& bar, const int G, const int bx, const int NGW, const int NGT, const int wave_s) {
    constexpr int pb = l == 0 ? 1 : 10;
        if (KIND(1) && IN(l == 0 ? 0 : pb + 0)) REP(1) { PH_BEGIN(); if constexpr (l == 0) norm_to_bf16<false>(ap->in[I_X], nullptr, nullptr, ap->in[I_ATTN_NORM], (bf16_t*)(ws + WS_HN), gw, NGW, lane); }
        if constexpr (l == 0) SEAM(0);
        if (KIND(2) && IN(pb + 1)) REP(2) { PH_BEGIN(); pg8::DenseSched S; S.init(T, DINP, DM, (const bf16_t*)(ws + WS_WIN) + (size_t)l * DINP * DM, G, bx); pg8::EpiBf16 E{(bf16_t*)(ws + WS_PROJ), DINP};
            pg8::gemm_phase<pg8::EpiBf16, pg8::DenseSched, true>(L, (const bf16_t*)(ws + WS_HN), DM, DM, S, E, tid); }
        SEAM(pb + 1);
        if (KIND(3) && IN(pb + 2)) REP(3) {
            { PH_BEGIN(); prep_tokens((const bf16_t*)(ws + WS_PROJ), ap->in[I_KV_NORM] + l * 128, (const float*)(ws + WS_COS), (const float*)(ws + WS_SIN), (float*)(ws + WS_RSTDQ), (bf16_t*)(ws + WS_KLAT), (bf16_t*)(ws + WS_KROPE), gw, NGW, lane); }
            { PH_BEGIN(); pool_phase((const bf16_t*)(ws + WS_PROJ), ap->in[I_POOL_W] + (size_t)l * 4 * 64 * 64, ap->in[I_POOL_SCALE] + l * 256, (bf16_t*)(ws + WS_OCAT), L, bx, G, tid); }
            { PH_BEGIN(); hgrn_local((const bf16_t*)(ws + WS_PROJ), (const float*)(ws + WS_LBS) + l * 512, (bf16_t*)(ws + WS_UBUF), (float*)(ws + WS_DVEC), L, bx, G, tid, wave, lane); }
        }
        SEAM(pb + 2);
        if ((KIND(4) || KIND(16)) && IN(pb + 3)) {
            if (KIND(16)) { PH_BEGIN(); hgrn_scan((bf16_t*)(ws + WS_UBUF), (const float*)(ws + WS_DVEC), bx, G, tid); }
            if (KIND(4)) REP(4) { PH_BEGIN(); pg8::DenseSched S; S.init(T, QW, 256, (const bf16_t*)(ws + WS_WQ) + (size_t)l * QW * 256, G, bx);
                pg8::EpiQ E{(bf16_t*)(ws + WS_Q), (const float*)(ws + WS_RSTDQ), (const float*)(ws + WS_COS), (const float*)(ws + WS_SIN)};
                pg8::gemm_phase<pg8::EpiQ, pg8::DenseSched, true>(L, (const bf16_t*)(ws + WS_PROJ) + COL_CQ, DINP, 256, S, E, tid); }
        }
        SEAM(pb + 3);
        if ((KIND(5) || KIND(15)) && IN(pb + 4)) {
            if (KIND(15)) REP(15) { PH_BEGIN(); hgrn_out((const bf16_t*)(ws + WS_PROJ), (const float*)(ws + WS_LBS) + l * 512, (const bf16_t*)(ws + WS_UBUF), ap->in[I_OUT_NORM] + l * 256, (bf16_t*)(ws + WS_OCAT), L, bx, G, tid, wave, lane); }
            if (KIND(5)) REP(5) { PH_BEGIN();
                for (int item = bx; item < 8 * 32; item += G)
                    for (int ps = 0; ps < 2; ++ps) { const int b = item & 1, h = (item >> 1) & 3, x = item >> 3, qb = ps ? x : 63 - x; att::BlockRef r;
                        r.Q = (const bf16_t*)(ws + WS_Q) + ((size_t)b * SEQ + (size_t)qb * 256) * QW + h * 192; r.Kl = (const bf16_t*)(ws + WS_KLAT) + (size_t)b * SEQ * 128; r.Kr = (const bf16_t*)(ws + WS_KROPE) + (size_t)b * SEQ * 64;
                        r.O = (bf16_t*)(ws + WS_OCAT) + ((size_t)b * SEQ + (size_t)qb * 256) * DM + 256 + h * 128; r.P0 = qb * 256;
                        att::attn_block<0>(r, (char*)lds, tid); }
#if defined(PROBE_ATT_VAR)
                for (int item = bx; item < 8 * 32; item += G)
                    for (int ps = 0; ps < 2; ++ps) { const int bh = item >> 5, x = item & 31, qb = ps ? 63 - x : x, b = bh >> 2, h = bh & 3; att::BlockRef r;
                        r.Q = (const bf16_t*)(ws + WS_Q) + ((size_t)b * SEQ + (size_t)qb * 256) * QW + h * 192; r.Kl = (const bf16_t*)(ws + WS_KLAT) + (size_t)b * SEQ * 128; r.Kr = (const bf16_t*)(ws + WS_KROPE) + (size_t)b * SEQ * 64;
                        r.O = (bf16_t*)(ws + WS_UBUF) + ((size_t)b * SEQ + (size_t)qb * 256) * DM + 256 + h * 128; r.P0 = qb * 256;
                        att::attn_block<PROBE_ATT_VAR>(r, (char*)lds, tid); }
#endif
            }
        }
        SEAM(pb + 4);
        if constexpr (l == 0) {
            if (KIND(6) && IN(pb + 5)) { PH_BEGIN();
                pg8::EpiRmsRes<true> E{(const void*)ap->in[I_X], (bf16_t*)ap->out, (bf16_t*)(ws + WS_HN), ap->in[I_FFN_NORM], (float*)((char*)ap->out + (size_t)T * DM * 2), (unsigned*)(ws + WS_CTL + CW_FUSE_BYTES) + 8192, L + pg8::STAGE_BYTES};
                { pg8::SliceSched S; S.init(T, DM, DM, (const bf16_t*)(ws + WS_WO), G, bx, 0); pg8::gemm_phase<pg8::EpiRmsRes<true>, pg8::SliceSched, true>(L, (const bf16_t*)(ws + WS_OCAT), DM, DM, S, E, tid); }
                __syncthreads();
                { pg8::SliceSched S; S.init(T, DM, DM, (const bf16_t*)(ws + WS_WO), G, bx, 1); pg8::gemm_phase<pg8::EpiRmsRes<true>, pg8::SliceSched, true>(L, (const bf16_t*)(ws + WS_OCAT), DM, DM, S, E, tid); } }
        } else {
            if (KIND(6) && IN(pb + 5)) { PH_BEGIN();
                pg8::EpiRmsRes<false> E{(const void*)ap->out, (bf16_t*)ap->out, (bf16_t*)(ws + WS_HN), ap->in[I_FFN_NORM] + DM, (float*)((char*)ap->out + (size_t)T * DM * 2), (unsigned*)(ws + WS_CTL + CW_FUSE_BYTES) + 16384, L + pg8::STAGE_BYTES};
                { pg8::SliceSched S; S.init(T, DM, DM, (const bf16_t*)(ws + WS_WO) + (size_t)DM * DM, G, bx, 0); pg8::gemm_phase<pg8::EpiRmsRes<false>, pg8::SliceSched, true>(L, (const bf16_t*)(ws + WS_OCAT), DM, DM, S, E, tid); }
                __syncthreads();
                { pg8::SliceSched S; S.init(T, DM, DM, (const bf16_t*)(ws + WS_WO) + (size_t)DM * DM, G, bx, 1); pg8::gemm_phase<pg8::EpiRmsRes<false>, pg8::SliceSched, true>(L, (const bf16_t*)(ws + WS_OCAT), DM, DM, S, E, tid); } } }
        if (false) { PH_BEGIN(); pg8::DenseSched S; S.init(T, DM, DM, (const bf16_t*)(ws + WS_WO) + (size_t)l * DM * DM, G, bx); pg8::EpiBf16 E{(bf16_t*)(ws + WS_HN), DM};
            pg8::gemm_phase<pg8::EpiBf16, pg8::DenseSched, true>(L, (const bf16_t*)(ws + WS_OCAT), DM, DM, S, E, tid); }
        SEAM(pb + 5);
        if constexpr (l == 0) {
            if (KIND(8) && IN(8)) REP(8) { PH_BEGIN(); pg8::DenseSched S; S.init(T, 2 * DFF, DM, (const bf16_t*)(ws + WS_WGU), G, bx); pg8::EpiSwiGLU E{(bf16_t*)(ws + WS_ACTD), DFF};
                pg8::gemm_phase<pg8::EpiSwiGLU, pg8::DenseSched, true>(L, (const bf16_t*)(ws + WS_HN), DM, DM, S, E, tid); }
            SEAM(8);
            if (KIND(9) && IN(9)) { PH_BEGIN();
                pg8::EpiRmsRes<false> E{(const void*)ap->out, (bf16_t*)ap->out, (bf16_t*)(ws + WS_HN), ap->in[I_ATTN_NORM] + DM, (float*)((char*)ap->out + (size_t)T * DM * 2), (unsigned*)(ws + WS_CTL + CW_FUSE_BYTES), L + pg8::STAGE_BYTES};
                { pg8::SliceSched S; S.init(T, DM, DFF, (const bf16_t*)(ws + WS_WD), G, bx, 0); pg8::gemm_phase<pg8::EpiRmsRes<false>, pg8::SliceSched, true>(L, (const bf16_t*)(ws + WS_ACTD), DFF, DFF, S, E, tid); }
                __syncthreads();
                { pg8::SliceSched S; S.init(T, DM, DFF, (const bf16_t*)(ws + WS_WD), G, bx, 1); pg8::gemm_phase<pg8::EpiRmsRes<false>, pg8::SliceSched, true>(L, (const bf16_t*)(ws + WS_ACTD), DFF, DFF, S, E, tid); } }
            SEAM(9);
        } else {
            if (KIND(10) && IN(16)) REP(10) {
                { PH_BEGIN(); norm_router<true>((bf16_t*)ap->out, (const bf16_t*)(ws + WS_HN), ap->in[I_FFN_NORM] + DM, ap->in[I_ROUTER], (bf16_t*)(ws + WS_HN), (int*)(ws + WS_TOKE), (float*)(ws + WS_TOKG), (int*)(ws + WS_CNT), L, bx, G, tid, wave, lane); }
                __syncthreads(); }
            SEAM(16);
            if (KIND(11) && IN(17)) REP(11) { PH_BEGIN(); route_tables((const int*)(ws + WS_TOKE), (const float*)(ws + WS_TOKG), (const int*)(ws + WS_CNT), (int*)(ws + WS_SLOTTOK), (float*)(ws + WS_SLOTG), (int*)(ws + WS_TILEE), L, bx, G, tid); }
            SEAM(17);
            for (int r = 0; r < 2; ++r) {
                if (KIND(12) && IN(18 + 2 * r)) REP(12) { PH_BEGIN(); pg8::MoeSched<true> S; S.init(2 * DFFE, DM, (const bf16_t*)(ws + WS_MOEW), MOEW_E, (const int*)(ws + WS_TILEE) + r * 256, (const int*)(ws + WS_SLOTTOK) + r * MOE_ROWS, G, bx);
                    pg8::EpiSwiGLU E{(bf16_t*)(ws + WS_ACTM), DFFE};
                    pg8::gemm_phase<pg8::EpiSwiGLU, pg8::MoeSched<true>, true>(L, (const bf16_t*)(ws + WS_HN), DM, DM, S, E, tid); }
                SEAM(18 + 2 * r);
                if (KIND(13) && IN(19 + 2 * r)) REP(13) { PH_BEGIN(); pg8::MoeDownSched S; S.init(DM, DFFE, (const bf16_t*)(ws + WS_MOEW) + (size_t)2 * DFFE * DM, MOEW_E, (const int*)(ws + WS_TILEE) + r * 256, G, bx);
                    pg8::EpiMoeDownB E{(const bf16_t*)ap->out, r == 0 ? (bf16_t*)ap->out : (bf16_t*)(ws + WS_HN), (const int*)(ws + WS_SLOTTOK) + r * MOE_ROWS, (const float*)(ws + WS_SLOTG) + r * MOE_ROWS,
                                       (f32x4*)((char*)ap->out + (size_t)T * DM * 2), (unsigned*)(ws + WS_CTL + CW_SPLIT_BYTES) + r * 64};
                    pg8::gemm_phase<pg8::EpiMoeDownB, pg8::MoeDownSched, true>(L, (const bf16_t*)(ws + WS_ACTM), DFFE, DFFE, S, E, tid);
                    moe_down_fixup(S, E, tid); }
                SEAM(19 + 2 * r);
            }
        }
}

__global__ void __launch_bounds__(NWAVES * 64, 2) trunk_fwd(Args args_unused) {
    extern __shared__ __attribute__((aligned(16))) unsigned char lds[];
    LAS unsigned char* L = (LAS unsigned char*)lds;
    const int G = gridDim.x, bx = blockIdx.x, NGW = G * NWAVES, NGT = G * NWAVES * 64;
    const int wave_s = __builtin_amdgcn_readfirstlane((int)threadIdx.x >> 6);
    for (int u = threadIdx.x; u < (LDS_BYTES - RING_BYTES) / 4; u += NWAVES * 64) ((LAS unsigned*)(L + RING_BYTES))[u] = 0u;
    __syncthreads();
    int lo, hi; XcdBarrier bar;
    { KArgsPtr ap0 = (KArgsPtr)__builtin_amdgcn_kernarg_segment_ptr(); lo = ap0->ph_lo; hi = ap0->ph_hi;
      bar.bar = (unsigned*)(ap0->ws + WS_CTL) + CW_BAR; bar.x = 0; bar.st = nullptr;
      if (MK_ONE_LAUNCH) bar = xcd_barrier_post((unsigned*)(ap0->ws + WS_CTL) + CW_BAR, (volatile LAS unsigned*)(L + MISC_OFF) + 8); }
    if (KIND(0) && IN(0)) REP(0) { PH_BEGIN();
        if (wave < 4) p0_stream(ap, L, bx * 4 + wave, G * 4, wave, lane);
        else p0_prologue(ap, L, 0, 1, bx * 256 + (tid - 256), G * 256, wave, lane, 1); }

    layer_body<0>(L, lds, lo, hi, bar, G, bx, NGW, NGT, wave_s);
    layer_body<1>(L, lds, lo, hi, bar, G, bx, NGW, NGT, wave_s);
    if (KIND(14) && IN(22)) REP(14) { PH_BEGIN(); norm_final((const bf16_t*)(ws + WS_HN), ap->out, ap->in[I_FINAL_NORM], gw, NGW, lane); }
#undef IN
#undef SEAM
}

extern "C" void kernel_launch(void* const* d_in, const int* in_sizes, int n_in, void* d_out, int out_size, void* d_ws, size_t ws_size, hipStream_t stream) {
    static int grid = 0;
    if (grid == 0) {
        if (n_in != 21 || in_sizes[0] != T * DM || out_size != T * DM || ws_size < WS_END) {
            fprintf(stderr, "kernel_launch: unexpected shapes (n_in %d, in0 %d, out %d, ws %zu, need %zu); nothing launched\n", n_in, n_in > 0 ? in_sizes[0] : -1, out_size, ws_size, (size_t)WS_END); grid = -1; return; }
        int dev = 0, cus = 0, per_cu = 0;
        if (hipGetDevice(&dev) != hipSuccess || hipDeviceGetAttribute(&cus, hipDeviceAttributeMultiprocessorCount, dev) != hipSuccess) { grid = -1; return; }
        if (hipFuncSetAttribute((const void*)trunk_fwd, hipFuncAttributeMaxDynamicSharedMemorySize, LDS_BYTES) != hipSuccess) { fprintf(stderr, "kernel_launch: hipFuncSetAttribute failed\n"); grid = -1; return; }
        if (hipOccupancyMaxActiveBlocksPerMultiprocessor(&per_cu, (const void*)trunk_fwd, NWAVES * 64, LDS_BYTES) != hipSuccess || per_cu < 1)
            fprintf(stderr, "kernel_launch: note: occupancy query reports %d workgroups per CU\n", per_cu);
        (void)hipGetLastError();
        grid = cus;
    }
    if (grid < 0) return;
    (void)hipMemsetAsync((char*)d_ws + WS_CTL, 0, CTL_ZERO_BYTES, stream);
    Args a{};
    for (int i = 0; i < 21; ++i) a.in[i] = (const float*)d_in[i];
    a.out = (float*)d_out; a.ws = (unsigned char*)d_ws;
#if MK_ONE_LAUNCH
    a.ph_lo = 0; a.ph_hi = NPH;
    hipLaunchKernelGGL(trunk_fwd, dim3(grid), dim3(NWAVES * 64), LDS_BYTES, stream, a);
#else
    for (int p = 0; p < NPH; ++p) { a.ph_lo = p; a.ph_hi = p + 1; hipLaunchKernelGGL(trunk_fwd, dim3(grid), dim3(NWAVES * 64), LDS_BYTES, stream, a); }
#endif
}
```

```cpp
#include <hip/hip_runtime.h>
#include <cstdio>
#include <cstdint>

#ifndef MK_ONE_LAUNCH
#define MK_ONE_LAUNCH 1
#endif

#define LAS __attribute__((address_space(3)))
#define GAS __attribute__((address_space(1)))
typedef unsigned short bf16_t;
typedef short bf16x8 __attribute__((ext_vector_type(8)));
typedef short s16x4 __attribute__((ext_vector_type(4)));
typedef float f32x2 __attribute__((ext_vector_type(2)));
typedef float f32x4 __attribute__((ext_vector_type(4)));
typedef float f32x16 __attribute__((ext_vector_type(16)));
typedef unsigned u32x2 __attribute__((ext_vector_type(2)));
typedef unsigned u32x4 __attribute__((ext_vector_type(4)));

constexpr int BATCH = 2, SEQ = 16384, T = BATCH * SEQ, DM = 1024, DIN = 2240, DINP = 2304;
constexpr int HG_H = 4, HG_DK = 128, HG_DV = 64, HG_C = 64, NCHUNK = SEQ / HG_C, NUNIT = BATCH * HG_H * NCHUNK;
constexpr int COL_HQ = 0, COL_HF = 512, COL_HI = 1024, COL_HG = 1280, COL_CQ = 1536, COL_CKV = 1792, COL_KPE = 1920, COL_XP = 1984;
constexpr int QW = 768;
constexpr int DFF = 2560, NE = 8, DFFE = 3584;
constexpr float EPS = 1e-6f;
constexpr int MOE_ROWS = T + NE * 256;
constexpr int MOE_MAXT = MOE_ROWS / 256;

constexpr size_t MiB = 1u << 20;
constexpr size_t WS_CTL = 0, CTL_ZERO_BYTES = 1 * MiB;
constexpr size_t WS_LBS = 1 * MiB;
constexpr size_t WS_RSTDQ = WS_LBS + 64 * 1024;
constexpr size_t WS_DVEC = WS_RSTDQ + (size_t)T * 4;
constexpr size_t WS_COS = WS_DVEC + (size_t)NUNIT * 128 * 4;
constexpr size_t WS_SIN = WS_COS + (size_t)SEQ * 32 * 4;
constexpr size_t WS_TOKE = WS_SIN + (size_t)SEQ * 32 * 4;
constexpr size_t WS_TOKG = WS_TOKE + (size_t)T * 2 * 4;
constexpr size_t WS_CNT = WS_TOKG + (size_t)T * 2 * 4;
constexpr size_t WS_SLOTTOK = WS_CNT + 256 * 16 * 4;
constexpr size_t WS_SLOTG = WS_SLOTTOK + (size_t)2 * MOE_ROWS * 4;
constexpr size_t WS_TILEE = WS_SLOTG + (size_t)2 * MOE_ROWS * 4;
constexpr size_t WS_WIN = 8 * MiB;
constexpr size_t WS_WQ = WS_WIN + (size_t)2 * DINP * DM * 2;
constexpr size_t WS_WO = WS_WQ + (size_t)2 * QW * 256 * 2;
constexpr size_t WS_WGU = WS_WO + (size_t)2 * DM * DM * 2;
constexpr size_t WS_WD = WS_WGU + (size_t)2 * DFF * DM * 2;
constexpr size_t WS_SMALL_END = WS_WD + (size_t)DM * DFF * 2;
constexpr size_t WS_ACT0 = 40 * MiB;
static_assert(WS_TILEE + 2 * 256 * 4 <= WS_WIN && WS_SMALL_END <= WS_ACT0, "small region");
constexpr size_t WS_HN = WS_ACT0;
constexpr size_t WS_Q = WS_ACT0;
constexpr size_t WS_KLAT = WS_ACT0 + 48 * MiB;
constexpr size_t WS_KROPE = WS_ACT0 + 56 * MiB;
constexpr size_t WS_PROJ = WS_ACT0 + 64 * MiB;
constexpr size_t WS_UBUF = WS_PROJ + 144 * MiB;
constexpr size_t WS_OCAT = WS_UBUF + 32 * MiB;
constexpr size_t WS_MIX_END = WS_OCAT + 64 * MiB;
constexpr size_t WS_ACTD = WS_PROJ;
constexpr size_t WS_MOEW = WS_MIX_END;
constexpr size_t MOEW_E = (size_t)(2 * DFFE * DM + DM * DFFE);
constexpr size_t WS_ACTM = WS_PROJ;
constexpr size_t WS_END = WS_MOEW + (size_t)NE * MOEW_E * 2;
static_assert(WS_END <= 512 * MiB && WS_ACTM + (size_t)MOE_ROWS * DFFE * 2 <= WS_MOEW, "workspace");

constexpr int CW_TMO = 0, CW_BAR = 4096; constexpr size_t CW_FUSE_BYTES = 576 * 1024;
constexpr size_t CW_SPLIT_BYTES = 512 * 1024;

__device__ __forceinline__ float bf2f(bf16_t v) { return __uint_as_float((unsigned)v << 16); }
typedef __bf16 bf16n2 __attribute__((ext_vector_type(2)));
typedef float f32n2 __attribute__((ext_vector_type(2)));
__device__ __forceinline__ unsigned cvt_pk_bf16(float lo, float hi) { const f32n2 v = {lo, hi}; return __builtin_bit_cast(unsigned, __builtin_convertvector(v, bf16n2)); }
__device__ __forceinline__ bf16_t f2bf(float f) { return __builtin_bit_cast(unsigned short, (__bf16)f); }
template <int CTRL> __device__ __forceinline__ float dppf(float v) { return __int_as_float(__builtin_amdgcn_update_dpp(0, __float_as_int(v), CTRL, 0xf, 0xf, true)); }
__device__ __forceinline__ float xlane1(float v) { return dppf<0xB1>(v); }
__device__ __forceinline__ float sum8(float v) { v += dppf<0xB1>(v); v += dppf<0x4E>(v); v += dppf<0x141>(v); return v; }
__device__ __forceinline__ float wave_sum(float v) {
    v = sum8(v); v += dppf<0x140>(v);
    const float r0 = __int_as_float(__builtin_amdgcn_readlane(__float_as_int(v), 0)), r1 = __int_as_float(__builtin_amdgcn_readlane(__float_as_int(v), 16));
    const float r2 = __int_as_float(__builtin_amdgcn_readlane(__float_as_int(v), 32)), r3 = __int_as_float(__builtin_amdgcn_readlane(__float_as_int(v), 48));
    return (r0 + r1) + (r2 + r3);
}
__device__ __forceinline__ float fast_exp(float x) { return __builtin_amdgcn_exp2f(x * 1.4426950408889634f); }
__device__ __forceinline__ float sigmoidf_(float x) { return __builtin_amdgcn_rcpf(1.f + fast_exp(-x)); }
#define LDS_WAIT() asm volatile("s_waitcnt lgkmcnt(0)" ::: "memory")
#define VM_WAIT() asm volatile("s_waitcnt vmcnt(0)" ::: "memory")

namespace pg8 {
constexpr int BM = 256, BK = 64, HALF = 128, HTB = HALF * BK * 2, STAGE_BYTES = 8 * HTB, NXCD = 8, WGM = 8;
__host__ __device__ __forceinline__ int lds_byte(int r, int c) { const int st = (r >> 4) * 2 + (c >> 5), rr = r & 15, cc = c & 31, ob = rr * 64 + cc * 2; return st * 1024 + (ob ^ (((ob >> 9) & 1) << 5)); }
__host__ __device__ __forceinline__ void stage_rc(int b, int& R, int& C) { const int st = b / 1024, sb = b % 1024, swz = sb ^ (((sb >> 9) & 1) << 5); R = (st >> 1) * 16 + swz / 64; C = (st & 1) * 32 + (swz % 64) / 2; }
__host__ __device__ __forceinline__ int perm32(int rho) { const int n = rho >> 4, i = rho & 15; return 8 * (i >> 2) + 4 * n + (i & 3); }

struct Unit { int pm, pn; int k0, nt, role, aux; };

struct OrderBase {
    int nM, nN, nwg, G, c;
    __device__ __forceinline__ void init_order(int nM_, int nN_, int G_, int c_) { nM = nM_; nN = nN_; nwg = nM * nN; G = G_; c = c_; }
    __device__ __forceinline__ void map(int L, Unit& u) const {
        int wgid = L; { const int q = nwg / NXCD, r = nwg % NXCD, xcd = wgid % NXCD, off = wgid / NXCD; wgid = (xcd < r ? xcd * (q + 1) : r * (q + 1) + (xcd - r) * q) + off; }
        const int nig = WGM * nN, gid = wgid / nig, fm = gid * WGM, gsz = (nM - fm) < WGM ? (nM - fm) : WGM;
        u.pm = fm + ((wgid % nig) % gsz); u.pn = (wgid % nig) / gsz;
    }
    __device__ __forceinline__ bool next(int i, Unit& u) const {
        const long L = (long)i * G + c; if (L >= nwg) return false;
        map((int)L, u); return true;
    }
};
struct DenseSched : OrderBase {
    static constexpr bool GATHER = false, SPLITK = false;
    const bf16_t* Bt; int K;
    __device__ __forceinline__ void init(int M, int N, int K_, const bf16_t* Bt_, int G_, int c_) { init_order(M / BM, N / BM, G_, c_); Bt = Bt_; K = K_; }
    __device__ __forceinline__ int arow(const Unit& u, int r) const { return u.pm * BM + r; }
    __device__ __forceinline__ const char* bptr(const Unit& u) const { return (const char*)Bt + (size_t)u.pn * BM * K * 2; }
};
struct SliceSched : OrderBase {
    static constexpr bool GATHER = false, SPLITK = false;
    const bf16_t* Bt; int K, slice;
    __device__ __forceinline__ void init(int M, int N, int K_, const bf16_t* Bt_, int G_, int c_, int slice_) { init_order(M / BM, N / BM, G_, c_); Bt = Bt_; K = K_; slice = slice_; }
    __device__ __forceinline__ bool next(int i, Unit& u) const { const long L = (long)slice * G + c; if (i != 0 || L >= nwg) return false; map((int)L, u); return true; }
    __device__ __forceinline__ int arow(const Unit& u, int r) const { return u.pm * BM + r; }
    __device__ __forceinline__ const char* bptr(const Unit& u) const { return (const char*)Bt + (size_t)u.pn * BM * K * 2; }
};
template <bool GATHER_> struct MoeSched : OrderBase {
    static constexpr bool GATHER = GATHER_, SPLITK = false;
    const bf16_t* W; size_t wstride; int K; const int* tile_e; const int* slot_tok;
    __device__ __forceinline__ void init(int N, int K_, const bf16_t* W_, size_t wstride_, const int* tile_e_, const int* slot_tok_, int G_, int c_) {
        tile_e = tile_e_; slot_tok = slot_tok_; W = W_; wstride = wstride_; K = K_; init_order(tile_e_[0], N / BM, G_, c_); }
    __device__ __forceinline__ int arow(const Unit& u, int r) const { if (GATHER) { const int t = slot_tok[u.pm * BM + r]; return t < 0 ? 0 : t; } return u.pm * BM + r; }
    __device__ __forceinline__ const char* bptr(const Unit& u) const { return (const char*)(W + (size_t)tile_e[1 + u.pm] * wstride) + (size_t)u.pn * BM * K * 2; }
};

constexpr int KCH = 7;
struct MoeDownSched : OrderBase {
    static constexpr bool GATHER = false, SPLITK = true;
    const bf16_t* W; size_t wstride; int K; const int* tile_e; int nfullu, nleft, nchunk;
    __device__ __forceinline__ void init(int N, int K_, const bf16_t* W_, size_t wstride_, const int* tile_e_, int G_, int c_) {
        tile_e = tile_e_; W = W_; wstride = wstride_; K = K_; init_order(tile_e_[0], N / BM, G_, c_);
        nfullu = (nwg / G) * G; nleft = nwg - nfullu; nchunk = nleft * KCH;
        if (nchunk > G) { nfullu = nwg; nleft = 0; nchunk = 0; } }
    __device__ __forceinline__ bool next(int i, Unit& u) const {
        const long L = (long)i * G + c;
        if (L < nfullu) { map((int)L, u); u.k0 = 0; u.nt = K / BK; u.role = 0; u.aux = 0; return true; }
        if (i == nfullu / G && c < nchunk) { const int lu = c / KCH, kc = c - lu * KCH; map(nfullu + lu, u); u.k0 = kc * (K / KCH); u.nt = (K / KCH) / BK; u.role = 1; u.aux = c; return true; }
        return false; }
    __device__ __forceinline__ int arow(const Unit& u, int r) const { return u.pm * BM + r; }
    __device__ __forceinline__ const char* bptr(const Unit& u) const { return (const char*)(W + (size_t)tile_e[1 + u.pm] * wstride) + (size_t)u.pn * BM * K * 2; }
};

struct EpiBf16 {
    static constexpr bool PERM = true;
    bf16_t* O; int ldc;
    __device__ __forceinline__ void operator()(const f32x4 (&acc)[2][2][4][2], const Unit& u, int wr, int wc, int fr, int fq) const {
        const int row0 = u.pm * BM + wr * 64 + fr, col0 = u.pn * BM + wc * 32 + 8 * fq;
#pragma unroll
        for (int ai = 0; ai < 2; ++ai)
#pragma unroll
            for (int m = 0; m < 4; ++m) { bf16_t* rowp = O + (size_t)(row0 + ai * HALF + m * 16) * ldc + col0;
#pragma unroll
                for (int bj = 0; bj < 2; ++bj) { const f32x4 v0 = acc[ai][bj][m][0], v1 = acc[ai][bj][m][1];
                    u32x4 w; w.x = cvt_pk_bf16(v0[0], v0[1]); w.y = cvt_pk_bf16(v0[2], v0[3]); w.z = cvt_pk_bf16(v1[0], v1[1]); w.w = cvt_pk_bf16(v1[2], v1[3]);
                    *(u32x4*)(rowp + bj * HALF) = w; } }
    }
};
template <bool XF32>
struct EpiRmsRes {
    static constexpr bool PERM = true;
    const void* xs; bf16_t* xd; bf16_t* hn; const float* g; float* slots; unsigned* cnt; LAS unsigned char* tab;
    __device__ __forceinline__ void operator()(const f32x4 (&acc)[2][2][4][2], const Unit& u, int wr, int wc, int fr, int fq) const {
        LAS float* P = (LAS float*)tab;
        LAS float* S = (LAS float*)(tab + 16384);
        const int col0 = u.pn * BM + wc * 32 + 8 * fq, rl0 = wr * 64 + fr, lane = fq * 16 + fr, wid = wr * 4 + wc, tid = wid * 64 + lane;
        f32x4 gv[2][2];
#pragma unroll
        for (int bj = 0; bj < 2; ++bj) { gv[bj][0] = *(const f32x4*)(g + col0 + bj * HALF); gv[bj][1] = *(const f32x4*)(g + col0 + bj * HALF + 4); }
        f32x4 v[2][2][4][2];
#pragma unroll
        for (int ai = 0; ai < 2; ++ai) {
            u32x4 rr[4][2]; f32x4 rf[XF32 ? 4 : 1][2][2];
#pragma unroll
            for (int m = 0; m < 4; ++m) { const size_t off = (size_t)(u.pm * BM + ai * HALF + rl0 + m * 16) * DM + col0;
                if constexpr (XF32) { const float* xp = (const float*)xs + off;
#pragma unroll
                    for (int bj = 0; bj < 2; ++bj) { rf[m][bj][0] = *(const f32x4*)(xp + bj * HALF); rf[m][bj][1] = *(const f32x4*)(xp + bj * HALF + 4); } }
                else { rr[m][0] = *(const u32x4*)((const bf16_t*)xs + off); rr[m][1] = *(const u32x4*)((const bf16_t*)xs + off + HALF); } }
#pragma unroll
            for (int m = 0; m < 4; ++m) { float sq = 0.f;
#pragma unroll
                for (int bj = 0; bj < 2; ++bj) { f32x4 a0 = acc[ai][bj][m][0], a1 = acc[ai][bj][m][1];
                    if constexpr (XF32) { a0 += rf[m][bj][0]; a1 += rf[m][bj][1]; }
                    else { const u32x4 r = rr[m][bj];
                        a0[0] += __uint_as_float(r.x << 16); a0[1] += __uint_as_float(r.x & 0xffff0000u); a0[2] += __uint_as_float(r.y << 16); a0[3] += __uint_as_float(r.y & 0xffff0000u);
                        a1[0] += __uint_as_float(r.z << 16); a1[1] += __uint_as_float(r.z & 0xffff0000u); a1[2] += __uint_as_float(r.w << 16); a1[3] += __uint_as_float(r.w & 0xffff0000u); }
                    v[ai][bj][m][0] = a0; v[ai][bj][m][1] = a1;
                    sq += ((a0[0] * a0[0] + a0[1] * a0[1]) + (a0[2] * a0[2] + a0[3] * a0[3])) + ((a1[0] * a1[0] + a1[1] * a1[1]) + (a1[2] * a1[2] + a1[3] * a1[3])); }
                P[(ai * HALF + rl0 + m * 16) * 16 + wc * 4 + fq] = sq; } }
        asm volatile("s_waitcnt lgkmcnt(0)" ::: "memory"); __builtin_amdgcn_s_barrier(); asm volatile("" ::: "memory");
        if (tid < 256) { const LAS f32x4* pp = (const LAS f32x4*)(P + tid * 16); const f32x4 p0 = pp[0], p1 = pp[1], p2 = pp[2], p3 = pp[3];
            const float tot = (((p0[0] + p0[1]) + (p0[2] + p0[3])) + ((p1[0] + p1[1]) + (p1[2] + p1[3]))) + (((p2[0] + p2[1]) + (p2[2] + p2[3])) + ((p3[0] + p3[1]) + (p3[2] + p3[3])));
            __hip_atomic_store(slots + ((size_t)(u.pm * BM + tid) * 4 + u.pn), tot, __ATOMIC_RELAXED, __HIP_MEMORY_SCOPE_AGENT); }
        asm volatile("s_waitcnt vmcnt(0)" ::: "memory");
        if (lane == 0) (void)__hip_atomic_fetch_add(cnt + 64 * u.pm, 1u, __ATOMIC_RELAXED, __HIP_MEMORY_SCOPE_AGENT);
        if (wid == 0) { unsigned sp = 0;
            while ((unsigned)__builtin_amdgcn_readfirstlane(__hip_atomic_load(cnt + 64 * u.pm, __ATOMIC_RELAXED, __HIP_MEMORY_SCOPE_AGENT)) < 32u) { __builtin_amdgcn_s_sleep(2); if (++sp > (1u << 22)) break; } }
        asm volatile("s_waitcnt vmcnt(0) lgkmcnt(0)" ::: "memory"); __builtin_amdgcn_s_barrier(); asm volatile("" ::: "memory");
        if (tid < 256) { const float* sl = slots + (size_t)(u.pm * BM + tid) * 4;
            const float s0 = __hip_atomic_load(sl + 0, __ATOMIC_RELAXED, __HIP_MEMORY_SCOPE_AGENT), s1 = __hip_atomic_load(sl + 1, __ATOMIC_RELAXED, __HIP_MEMORY_SCOPE_AGENT);
            const float s2 = __hip_atomic_load(sl + 2, __ATOMIC_RELAXED, __HIP_MEMORY_SCOPE_AGENT), s3 = __hip_atomic_load(sl + 3, __ATOMIC_RELAXED, __HIP_MEMORY_SCOPE_AGENT);
            S[tid] = 1.0f / sqrtf(((s0 + s1) + (s2 + s3)) * (1.f / DM) + EPS); }
        asm volatile("s_waitcnt vmcnt(0) lgkmcnt(0)" ::: "memory"); __builtin_amdgcn_s_barrier(); asm volatile("" ::: "memory");
#pragma unroll
        for (int ai = 0; ai < 2; ++ai)
#pragma unroll
            for (int m = 0; m < 4; ++m) { const int rl = ai * HALF + rl0 + m * 16; const float rs = S[rl]; const size_t off = (size_t)(u.pm * BM + rl) * DM + col0;
#pragma unroll
                for (int bj = 0; bj < 2; ++bj) { const f32x4 a0 = v[ai][bj][m][0], a1 = v[ai][bj][m][1]; const f32x4 o0 = a0 * rs * gv[bj][0], o1 = a1 * rs * gv[bj][1];
                    u32x4 wx; wx.x = cvt_pk_bf16(a0[0], a0[1]); wx.y = cvt_pk_bf16(a0[2], a0[3]); wx.z = cvt_pk_bf16(a1[0], a1[1]); wx.w = cvt_pk_bf16(a1[2], a1[3]);
                    u32x4 wh; wh.x = cvt_pk_bf16(o0[0], o0[1]); wh.y = cvt_pk_bf16(o0[2], o0[3]); wh.z = cvt_pk_bf16(o1[0], o1[1]); wh.w = cvt_pk_bf16(o1[2], o1[3]);
                    *(u32x4*)(xd + off + bj * HALF) = wx; *(u32x4*)(hn + off + bj * HALF) = wh; } }
    }
};
struct EpiQ {
    static constexpr bool PERM = true;
    bf16_t* Q; const float* rstd; const float* cosT; const float* sinT;
    __device__ __forceinline__ void operator()(const f32x4 (&acc)[2][2][4][2], const Unit& u, int wr, int wc, int fr, int fq) const {
        const int row0 = u.pm * BM + wr * 64 + fr;
        float rsv[2][4];
#pragma unroll
        for (int ai = 0; ai < 2; ++ai)
#pragma unroll
            for (int m = 0; m < 4; ++m) rsv[ai][m] = rstd[row0 + ai * HALF + m * 16];
#pragma unroll
        for (int bj = 0; bj < 2; ++bj) {
            const int col0 = u.pn * BM + bj * HALF + wc * 32 + 8 * fq, within = col0 % 192; const bool rope = within >= 128; const int i0 = (within - 128) >> 1;
#pragma unroll
            for (int ai = 0; ai < 2; ++ai) {
                f32x4 cv[4], sv[4];
                if (rope) {
#pragma unroll
                    for (int m = 0; m < 4; ++m) { const int pos = (row0 + ai * HALF + m * 16) & (SEQ - 1); cv[m] = *(const f32x4*)(cosT + pos * 32 + i0); sv[m] = *(const f32x4*)(sinT + pos * 32 + i0); } }
#pragma unroll
                for (int m = 0; m < 4; ++m) { const int row = row0 + ai * HALF + m * 16; const float rs = rsv[ai][m];
                    f32x4 v0 = acc[ai][bj][m][0] * rs, v1 = acc[ai][bj][m][1] * rs;
                    if (rope) { const f32x4 c4 = cv[m], s4 = sv[m];
                        const f32x4 a = v0, b = v1;
                        v0[0] = a[0] * c4[0] - a[1] * s4[0]; v0[1] = a[0] * s4[0] + a[1] * c4[0]; v0[2] = a[2] * c4[1] - a[3] * s4[1]; v0[3] = a[2] * s4[1] + a[3] * c4[1];
                        v1[0] = b[0] * c4[2] - b[1] * s4[2]; v1[1] = b[0] * s4[2] + b[1] * c4[2]; v1[2] = b[2] * c4[3] - b[3] * s4[3]; v1[3] = b[2] * s4[3] + b[3] * c4[3]; }
                    u32x4 w; w.x = cvt_pk_bf16(v0[0], v0[1]); w.y = cvt_pk_bf16(v0[2], v0[3]); w.z = cvt_pk_bf16(v1[0], v1[1]); w.w = cvt_pk_bf16(v1[2], v1[3]);
                    *(u32x4*)(Q + (size_t)row * QW + col0) = w; asm volatile("" ::: "memory"); } } }
    }
};
struct EpiResid {
    static constexpr bool PERM = false;
    const float* res; float* out;
    __device__ __forceinline__ void operator()(const f32x4 (&acc)[2][2][4][2], const Unit& u, int wr, int wc, int fr, int fq) const {
        const int row0 = u.pm * BM + wr * 64 + fr, col0 = u.pn * BM + wc * 32 + 4 * fq;
#pragma unroll
        for (int ai = 0; ai < 2; ++ai)
#pragma unroll
            for (int m = 0; m < 4; ++m) { const size_t off = (size_t)(row0 + ai * HALF + m * 16) * DM + col0;
#pragma unroll
                for (int bj = 0; bj < 2; ++bj)
#pragma unroll
                    for (int n = 0; n < 2; ++n) { const f32x4 r = *(const f32x4*)(res + off + bj * HALF + n * 16); *(f32x4*)(out + off + bj * HALF + n * 16) = r + acc[ai][bj][m][n]; } }
    }
};
struct EpiSwiGLU {
    static constexpr bool PERM = true;
    bf16_t* O; int ldc;
    __device__ __forceinline__ void operator()(const f32x4 (&acc)[2][2][4][2], const Unit& u, int wr, int wc, int fr, int fq) const {
        const int row0 = u.pm * BM + wr * 64 + fr, col0 = u.pn * HALF + wc * 32 + 8 * fq;
#pragma unroll
        for (int ai = 0; ai < 2; ++ai)
#pragma unroll
            for (int m = 0; m < 4; ++m) { f32x4 h[2];
#pragma unroll
                for (int n = 0; n < 2; ++n) { const f32x4 g = acc[ai][0][m][n], up = acc[ai][1][m][n];
#pragma unroll
                    for (int e = 0; e < 4; ++e) h[n][e] = g[e] * sigmoidf_(g[e]) * up[e]; }
                u32x4 w; w.x = cvt_pk_bf16(h[0][0], h[0][1]); w.y = cvt_pk_bf16(h[0][2], h[0][3]); w.z = cvt_pk_bf16(h[1][0], h[1][1]); w.w = cvt_pk_bf16(h[1][2], h[1][3]);
                *(u32x4*)(O + (size_t)(row0 + ai * HALF + m * 16) * ldc + col0) = w; asm volatile("" ::: "memory"); }
    }
};
struct EpiMoeDown {
    static constexpr bool PERM = false;
    float* x; const int* slot_tok; const float* slot_g;
    __device__ __forceinline__ void operator()(const f32x4 (&acc)[2][2][4][2], const Unit& u, int wr, int wc, int fr, int fq) const {
        const int row0 = u.pm * BM + wr * 64 + fr, col0 = u.pn * BM + wc * 32 + 4 * fq;
#pragma unroll
        for (int ai = 0; ai < 2; ++ai)
#pragma unroll
            for (int m = 0; m < 4; ++m) { const int slot = row0 + ai * HALF + m * 16; const int tok = slot_tok[slot]; const float g = slot_g[slot];
                if (tok >= 0) { const size_t off = (size_t)tok * DM + col0;
#pragma unroll
                    for (int bj = 0; bj < 2; ++bj)
#pragma unroll
                        for (int n = 0; n < 2; ++n) { const f32x4 r = *(const f32x4*)(x + off + bj * HALF + n * 16); *(f32x4*)(x + off + bj * HALF + n * 16) = r + acc[ai][bj][m][n] * g; } } }
    }
};

struct EpiMoeDownB {
    static constexpr bool PERM = true;
    const bf16_t* xs; bf16_t* xd; const int* slot_tok; const float* slot_g; f32x4* part; unsigned* cnt;
    __device__ __forceinline__ void operator()(const f32x4 (&acc)[2][2][4][2], const Unit& u, int wr, int wc, int fr, int fq) const {
        if (u.role == 1) {
            u32x4* p = (u32x4*)part + (size_t)u.aux * (16 * 512) + (wr * 4 + wc) * 64 + fq * 16 + fr;
#pragma unroll
            for (int ai = 0; ai < 2; ++ai)
#pragma unroll
                for (int bj = 0; bj < 2; ++bj)
#pragma unroll
                    for (int m = 0; m < 4; ++m) { const f32x4 v0 = acc[ai][bj][m][0], v1 = acc[ai][bj][m][1];
                        u32x4 w; w.x = cvt_pk_bf16(v0[0], v0[1]); w.y = cvt_pk_bf16(v0[2], v0[3]); w.z = cvt_pk_bf16(v1[0], v1[1]); w.w = cvt_pk_bf16(v1[2], v1[3]);
                        p[(size_t)((ai * 2 + bj) * 4 + m) * 512] = w; }
            return; }
        const int row0 = u.pm * BM + wr * 64 + fr, col0 = u.pn * BM + wc * 32 + 8 * fq;
        int tk[2][4]; float gg[2][4];
#pragma unroll
        for (int ai = 0; ai < 2; ++ai)
#pragma unroll
            for (int m = 0; m < 4; ++m) { tk[ai][m] = slot_tok[row0 + ai * HALF + m * 16]; gg[ai][m] = slot_g[row0 + ai * HALF + m * 16]; }
#pragma unroll
        for (int ai = 0; ai < 2; ++ai)
#pragma unroll
            for (int m = 0; m < 4; ++m) if (tk[ai][m] >= 0) { const size_t off = (size_t)tk[ai][m] * DM + col0; const float g = gg[ai][m];
                const u32x4 r0 = *(const u32x4*)(xs + off), r1 = *(const u32x4*)(xs + off + HALF);
#pragma unroll
                for (int bj = 0; bj < 2; ++bj) { const u32x4 r = bj ? r1 : r0; const f32x4 v0 = acc[ai][bj][m][0] * g, v1 = acc[ai][bj][m][1] * g;
                    u32x4 w; w.x = cvt_pk_bf16(__uint_as_float(r.x << 16) + v0[0], __uint_as_float(r.x & 0xffff0000u) + v0[1]); w.y = cvt_pk_bf16(__uint_as_float(r.y << 16) + v0[2], __uint_as_float(r.y & 0xffff0000u) + v0[3]);
                    w.z = cvt_pk_bf16(__uint_as_float(r.z << 16) + v1[0], __uint_as_float(r.z & 0xffff0000u) + v1[1]); w.w = cvt_pk_bf16(__uint_as_float(r.w << 16) + v1[2], __uint_as_float(r.w & 0xffff0000u) + v1[3]);
                    *(u32x4*)(xd + off + bj * HALF) = w; } }
    }
};
struct EpiMoeDelta {
    static constexpr bool PERM = true;
    bf16_t* d1; const int* slot_tok; const float* slot_g;
    __device__ __forceinline__ void operator()(const f32x4 (&acc)[2][2][4][2], const Unit& u, int wr, int wc, int fr, int fq) const {
        const int row0 = u.pm * BM + wr * 64 + fr, col0 = u.pn * BM + wc * 32 + 8 * fq;
        int tk[2][4]; float gg[2][4];
#pragma unroll
        for (int ai = 0; ai < 2; ++ai)
#pragma unroll
            for (int m = 0; m < 4; ++m) { tk[ai][m] = slot_tok[row0 + ai * HALF + m * 16]; gg[ai][m] = slot_g[row0 + ai * HALF + m * 16]; }
#pragma unroll
        for (int ai = 0; ai < 2; ++ai)
#pragma unroll
            for (int m = 0; m < 4; ++m) if (tk[ai][m] >= 0) { bf16_t* rowp = d1 + (size_t)tk[ai][m] * DM + col0; const float g = gg[ai][m];
#pragma unroll
                for (int bj = 0; bj < 2; ++bj) { const f32x4 v0 = acc[ai][bj][m][0] * g, v1 = acc[ai][bj][m][1] * g;
                    u32x4 w; w.x = cvt_pk_bf16(v0[0], v0[1]); w.y = cvt_pk_bf16(v0[2], v0[3]); w.z = cvt_pk_bf16(v1[0], v1[1]); w.w = cvt_pk_bf16(v1[2], v1[3]);
                    *(u32x4*)(rowp + bj * HALF) = w; } }
    }
};
__device__ __forceinline__ void glds16_s(const void* sbase, unsigned voff, unsigned lds_dst) { unsigned keep;
    asm volatile("s_mov_b32 %0, m0\n\ts_mov_b32 m0, %3\n\ts_nop 0\n\tglobal_load_lds_dwordx4 %2, %1\n\ts_mov_b32 m0, %0" : "=&s"(keep) : "s"(sbase), "v"(voff), "s"(lds_dst) : "memory"); }
template <class Epi, class Sched, bool ALIGN_EPI>
__device__ __forceinline__ void gemm_phase(LAS unsigned char* lds, const bf16_t* Aptr, const int lda, const int K, const Sched& S, const Epi& E, int tid) {
    asm volatile("" : "+v"(tid));
    const int wid = __builtin_amdgcn_readfirstlane(tid >> 6), lane = tid & 63, wr = wid >> 2, wc = wid & 3, fr = lane & 15, fq = lane >> 4;
    const int nt = K / BK;
    int RA[2]; unsigned CA2[2], voffB[2];
#pragma unroll
    for (int i = 0; i < 2; ++i) { int R, C; stage_rc(tid * 16 + i * 8192, R, C); const int Rb = Epi::PERM ? ((R & ~31) + perm32(R & 31)) : R;
        RA[i] = R; CA2[i] = (unsigned)C * 2u; voffB[i] = (unsigned)(Rb * K + C) * 2u; }
    const size_t kstep = (size_t)(BK * 2);
    const size_t hstep = (size_t)HALF * K * 2;
    const unsigned ldsb = (unsigned)(uintptr_t)lds + (unsigned)wid * 1024u;
    const int aoff = lds_byte(wr * 64 + fr, fq * 8), boff = lds_byte(wc * 32 + fr, fq * 8);
#define PG8_SA(b, h) (((b) * 2 + (h)) * HTB)
#define PG8_SB(b, h) ((4 + (b) * 2 + (h)) * HTB)
#define PG8_STAGE(bufoff, gbase, voff) do { _Pragma("unroll") for (int _i = 0; _i < 2; ++_i) \
        glds16_s((const void*)(gbase), (voff)[_i], ldsb + (unsigned)((bufoff) + _i * 8192)); } while (0)
#define PG8_LDA(dst, b, h) do { _Pragma("unroll") for (int m = 0; m < 4; ++m) _Pragma("unroll") for (int k = 0; k < 2; ++k) dst[m][k] = *(const LAS bf16x8*)(lds + PG8_SA(b, h) + aoff + m * 2048 + k * 1024); } while (0)
#define PG8_LDB(dst, b, h) do { _Pragma("unroll") for (int n = 0; n < 2; ++n) _Pragma("unroll") for (int k = 0; k < 2; ++k) dst[n][k] = *(const LAS bf16x8*)(lds + PG8_SB(b, h) + boff + n * 2048 + k * 1024); } while (0)
#define PG8_MMA(ai, bj, At, Bt) do { __builtin_amdgcn_s_setprio(1); _Pragma("unroll") for (int m = 0; m < 4; ++m) _Pragma("unroll") for (int n = 0; n < 2; ++n) _Pragma("unroll") for (int k = 0; k < 2; ++k) \
        acc[ai][bj][m][n] = __builtin_amdgcn_mfma_f32_16x16x32_bf16(Bt[n][k], At[m][k], acc[ai][bj][m][n], 0, 0, 0); __builtin_amdgcn_s_setprio(0); } while (0)
#define PG8_WAIT_V(n) asm volatile("s_waitcnt vmcnt(" #n ")" ::: "memory")
#define PG8_WAIT_L(n) asm volatile("s_waitcnt lgkmcnt(" #n ")" ::: "memory")
#define PG8_BAR __builtin_amdgcn_s_barrier()
#define PG8_SCHED __builtin_amdgcn_sched_barrier(0)
#define PG8_MKOFF(dst, u) do { _Pragma("unroll") for (int _h = 0; _h < 2; ++_h) _Pragma("unroll") for (int _i = 0; _i < 2; ++_i) \
        dst[_h][_i] = (unsigned)S.arow(u, _h * HALF + RA[_i]) * (unsigned)(lda * 2) + CA2[_i]; } while (0)
    Unit cur, nxt; int ui = 0;
    if (!S.next(0, cur)) return;
    constexpr bool SK = Sched::SPLITK;
    f32x4 acc[2][2][4][2];
#pragma unroll
    for (int a = 0; a < 2; ++a)
#pragma unroll
        for (int b = 0; b < 2; ++b)
#pragma unroll
            for (int m = 0; m < 4; ++m)
#pragma unroll
                for (int n = 0; n < 2; ++n) acc[a][b][m][n] = (f32x4){0.f, 0.f, 0.f, 0.f};
    bf16x8 At[4][2], B0[2][2], B1[2][2];
    constexpr bool GA = Sched::GATHER;
    unsigned ca[2][2], na[2][2];
    const char* const Ab = (const char*)Aptr;
    const size_t tstepA = (size_t)BM * lda * 2;
    const char* cAp = Ab;
    if constexpr (GA) { PG8_MKOFF(ca, cur); }
    else { cAp = Ab + (size_t)cur.pm * tstepA + (SK ? (size_t)cur.k0 * 2 : (size_t)0);
#pragma unroll
        for (int h = 0; h < 2; ++h)
#pragma unroll
            for (int i = 0; i < 2; ++i) { ca[h][i] = (unsigned)((h * HALF + RA[i]) * lda) * 2u + CA2[i]; na[h][i] = ca[h][i]; } }
    const char* cB = S.bptr(cur) + (SK ? (size_t)cur.k0 * 2 : (size_t)0);
    PG8_STAGE(PG8_SB(0, 0), cB, voffB); PG8_STAGE(PG8_SB(0, 1), cB + hstep, voffB); PG8_STAGE(PG8_SA(0, 0), cAp, ca[0]); PG8_STAGE(PG8_SA(0, 1), cAp, ca[1]);
    if (wr == 1) PG8_BAR;
    PG8_WAIT_V(2); PG8_BAR;
    PG8_STAGE(PG8_SB(1, 0), cB + kstep, voffB); PG8_STAGE(PG8_SA(1, 0), cAp + kstep, ca[0]); PG8_STAGE(PG8_SB(1, 1), cB + hstep + kstep, voffB);
    PG8_WAIT_V(6); PG8_BAR;
    for (;;) {
        const bool has_next = S.next(ui + 1, nxt);
        const char* nB = cB; const char* nAp = cAp;
        if (has_next) { nB = S.bptr(nxt) + (SK ? (size_t)nxt.k0 * 2 : (size_t)0); if constexpr (GA) { PG8_MKOFF(na, nxt); } else nAp = Ab + (size_t)nxt.pm * tstepA + (SK ? (size_t)nxt.k0 * 2 : (size_t)0); }
        else if constexpr (GA) {
#pragma unroll
            for (int h = 0; h < 2; ++h)
#pragma unroll
                for (int i = 0; i < 2; ++i) na[h][i] = ca[h][i]; }
        const int cnt_t = SK ? __builtin_amdgcn_readfirstlane(cur.nt) : nt;
        for (int t = 0; t < cnt_t; t += 2) {
            const bool last = (t == cnt_t - 2);
            const char* a1 = cAp + (size_t)(t + 1) * kstep;
            const char* a2 = last ? nAp : cAp + (size_t)(t + 2) * kstep; const char* b2 = last ? nB : cB + (size_t)(t + 2) * kstep;
            const char* a3 = a2 + kstep; const char* b3 = b2 + kstep;
            unsigned o2[2][2];
#pragma unroll
            for (int h = 0; h < 2; ++h)
#pragma unroll
                for (int i = 0; i < 2; ++i) o2[h][i] = (GA && last) ? na[h][i] : ca[h][i];
            PG8_LDB(B0, 0, 0); PG8_LDB(B1, 0, 1); PG8_SCHED; PG8_LDA(At, 0, 0); PG8_STAGE(PG8_SA(1, 1), a1, ca[1]);
            PG8_WAIT_V(8); PG8_WAIT_L(0); PG8_BAR; PG8_MMA(0, 0, At, B0); PG8_MMA(0, 1, At, B1); PG8_BAR; PG8_SCHED;
            PG8_LDA(At, 0, 1); PG8_STAGE(PG8_SB(0, 0), b2, voffB); PG8_STAGE(PG8_SB(0, 1), b2 + hstep, voffB); PG8_STAGE(PG8_SA(0, 0), a2, o2[0]);
            PG8_WAIT_V(8); PG8_WAIT_L(0); PG8_BAR; PG8_MMA(1, 0, At, B0); PG8_MMA(1, 1, At, B1); PG8_BAR; PG8_SCHED;
            PG8_LDB(B0, 1, 0); PG8_LDB(B1, 1, 1); PG8_SCHED; PG8_LDA(At, 1, 0); PG8_STAGE(PG8_SA(0, 1), a2, o2[1]);
            PG8_WAIT_V(8); PG8_WAIT_L(0); PG8_BAR; PG8_MMA(0, 0, At, B0); PG8_MMA(0, 1, At, B1); PG8_BAR; PG8_SCHED;
            PG8_LDA(At, 1, 1); PG8_STAGE(PG8_SB(1, 0), b3, voffB); PG8_STAGE(PG8_SB(1, 1), b3 + hstep, voffB); PG8_STAGE(PG8_SA(1, 0), a3, o2[0]);
            PG8_WAIT_V(8); PG8_WAIT_L(0); PG8_BAR; PG8_MMA(1, 0, At, B0); PG8_MMA(1, 1, At, B1); PG8_BAR; PG8_SCHED;
        }
        if constexpr (ALIGN_EPI) { if (wr == 0) PG8_BAR; }
        E(acc, cur, wr, wc, fr, fq);
        if (!has_next) break;
#pragma unroll
        for (int a = 0; a < 2; ++a)
#pragma unroll
            for (int b = 0; b < 2; ++b)
#pragma unroll
                for (int m = 0; m < 4; ++m)
#pragma unroll
                    for (int n = 0; n < 2; ++n) acc[a][b][m][n] = (f32x4){0.f, 0.f, 0.f, 0.f};
        cur = nxt; cB = nB; cAp = nAp; ++ui;
        if constexpr (GA) {
#pragma unroll
            for (int h = 0; h < 2; ++h)
#pragma unroll
                for (int i = 0; i < 2; ++i) ca[h][i] = na[h][i]; }
        if constexpr (ALIGN_EPI) { if (wr == 1) PG8_BAR; }
    }
    PG8_WAIT_V(0);
    if constexpr (!ALIGN_EPI) { if (wr == 0) PG8_BAR; }
    PG8_BAR;
#undef PG8_SA
#undef PG8_SB
#undef PG8_STAGE
#undef PG8_LDA
#undef PG8_LDB
#undef PG8_MMA
#undef PG8_WAIT_V
#undef PG8_WAIT_L
#undef PG8_BAR
#undef PG8_SCHED
#undef PG8_MKOFF
}
}

__device__ __forceinline__ void moe_down_fixup(const pg8::MoeDownSched& S, const pg8::EpiMoeDownB& E, int tid) {
    if (S.c >= S.nchunk) return;
    const int lu = S.c / pg8::KCH, kc = S.c - lu * pg8::KCH;
    if (tid == 0) {
        __builtin_amdgcn_fence(__ATOMIC_RELEASE, "agent"); asm volatile("s_waitcnt vmcnt(0)" ::: "memory");
        (void)__hip_atomic_fetch_add(E.cnt + lu, 1u, __ATOMIC_RELAXED, __HIP_MEMORY_SCOPE_AGENT);
        unsigned sp = 0;
        while (__hip_atomic_load(E.cnt + lu, __ATOMIC_RELAXED, __HIP_MEMORY_SCOPE_AGENT) < (unsigned)pg8::KCH) { __builtin_amdgcn_s_sleep(1); if (++sp > (1u << 22)) break; }
        __builtin_amdgcn_fence(__ATOMIC_ACQUIRE, "agent"); asm volatile("s_waitcnt vmcnt(0)" ::: "memory"); }
    __syncthreads();
    const int wid = tid >> 6, lane = tid & 63, wr = wid >> 2, wc = wid & 3, fr = lane & 15, fq = lane >> 4;
    const u32x4* p = (const u32x4*)E.part + (size_t)(lu * pg8::KCH) * (16 * 512) + tid;
    pg8::Unit u; S.map(S.nfullu + lu, u);
    const int row0 = u.pm * pg8::BM + wr * 64 + fr, col0 = u.pn * pg8::BM + wc * 32 + 8 * fq;
#pragma unroll 1
    for (int am = kc; am < 8; am += pg8::KCH) { const int ai = am >> 2, m = am & 3; f32x4 v[2][2];
#pragma unroll
        for (int bj = 0; bj < 2; ++bj) { const int idx = (ai * 2 + bj) * 4 + m; f32x4 a0 = {0.f, 0.f, 0.f, 0.f}, a1 = {0.f, 0.f, 0.f, 0.f};
#pragma unroll
            for (int q = 0; q < pg8::KCH; ++q) { const u32x4 w = p[(size_t)q * (16 * 512) + (size_t)idx * 512];
                a0[0] += __uint_as_float(w.x << 16); a0[1] += __uint_as_float(w.x & 0xffff0000u); a0[2] += __uint_as_float(w.y << 16); a0[3] += __uint_as_float(w.y & 0xffff0000u);
                a1[0] += __uint_as_float(w.z << 16); a1[1] += __uint_as_float(w.z & 0xffff0000u); a1[2] += __uint_as_float(w.w << 16); a1[3] += __uint_as_float(w.w & 0xffff0000u); }
            v[bj][0] = a0; v[bj][1] = a1; }
        const int slot = row0 + ai * pg8::HALF + m * 16; const int tok = E.slot_tok[slot]; const float g = E.slot_g[slot];
        if (tok >= 0) { const size_t off = (size_t)tok * DM + col0;
#pragma unroll
            for (int bj = 0; bj < 2; ++bj) { const u32x4 r = *(const u32x4*)(E.xs + off + bj * pg8::HALF); const f32x4 v0 = v[bj][0] * g, v1 = v[bj][1] * g;
                u32x4 w; w.x = cvt_pk_bf16(__uint_as_float(r.x << 16) + v0[0], __uint_as_float(r.x & 0xffff0000u) + v0[1]); w.y = cvt_pk_bf16(__uint_as_float(r.y << 16) + v0[2], __uint_as_float(r.y & 0xffff0000u) + v0[3]);
                w.z = cvt_pk_bf16(__uint_as_float(r.z << 16) + v1[0], __uint_as_float(r.z & 0xffff0000u) + v1[1]); w.w = cvt_pk_bf16(__uint_as_float(r.w << 16) + v1[2], __uint_as_float(r.w & 0xffff0000u) + v1[3]);
                *(u32x4*)(E.xd + off + bj * pg8::HALF) = w; } } }
}

namespace att {
constexpr int NW = 8, QBLK = 32, KVBLK = 64, QB = NW * QBLK;
constexpr int SHM_V = 16384, SHM_K = 16384, SHM_R = 8192;
constexpr int NBUF = 3;
constexpr int OFF_K = 0, OFF_R = OFF_K + NBUF * SHM_K, OFF_WS = OFF_R + NBUF * SHM_R, OFF_V = OFF_WS + NW * 64 * 4, LDS_BYTES = OFF_V + NBUF * SHM_V;
constexpr float THR_L2 = 11.5f;
#define KSWZ(row, colB) ((row) * 256 + ((colB) ^ (((row) & 7) << 4)))
#define RSWZ(row, colB) (((row) >> 1) * 256 + (((((row) & 1) << 7) | (colB)) ^ ((((row) >> 1) & 7) << 4)))
#define SBAR() __builtin_amdgcn_sched_barrier(0)
__device__ __forceinline__ int v_st(int k, int c) { const int kk = (k & ~0xC) | ((k & 4) << 1) | ((k & 8) >> 1); return ((kk >> 3) * 4 + (c >> 5)) * 512 + ((kk & 7) * 32 + (c & 31)) * 2; }
__device__ __forceinline__ int v_rd_base(int lane) { return ((lane & 3) << 3) | (((lane >> 2) & 3) << 6) | (((lane >> 4) & 1) << 5) | (((lane >> 5) & 1) << 8); }
constexpr int v_rd_off(int d0, int ks, int half) { return d0 * 512 + ks * 4096 + half * 2048; }
__device__ __forceinline__ int crow(int r, int hi) { return (r & 3) + 8 * (r >> 2) + 4 * hi; }
__device__ __forceinline__ void mask_tile(f32x16& p0, f32x16& p1, int dq) {
    const float NEG = -__builtin_inff();
#pragma unroll
    for (int r = 0; r < 16; ++r) {
        const int c = (r & 3) + 8 * (r >> 2);
        if (dq - c < 0) p0[r] = NEG;
        if (dq - c - 32 < 0) p1[r] = NEG;
    }
}
__device__ __forceinline__ void partialSM(f32x16& p0, f32x16& p1, float& m_reg, float& mn, float& alpha) {
    float pmax = p0[0];
#pragma unroll
    for (int r = 1; r < 16; ++r) pmax = fmaxf(pmax, p0[r]);
#pragma unroll
    for (int r = 0; r < 16; ++r) pmax = fmaxf(pmax, p1[r]);
    { auto rr = __builtin_amdgcn_permlane32_swap(__float_as_uint(pmax), __float_as_uint(pmax), false, false);
      pmax = fmaxf(__uint_as_float(rr[0]), __uint_as_float(rr[1])); }
    if (__builtin_expect(__all((pmax - m_reg) <= THR_L2), 1)) { mn = m_reg; alpha = 1.f; }
    else { mn = fmaxf(m_reg, pmax); alpha = __builtin_amdgcn_exp2f(m_reg - mn); m_reg = mn; }
#pragma unroll
    for (int r = 0; r < 16; ++r) p0[r] = p0[r] - mn;
#pragma unroll
    for (int r = 0; r < 16; ++r) p1[r] = p1[r] - mn;
#pragma unroll
    for (int r = 0; r < 16; ++r) p0[r] = __builtin_amdgcn_exp2f(p0[r]);
}
__device__ __forceinline__ void finishSM(f32x16& p0, f32x16& p1, float alpha, float& l_reg, bf16x8& pa0, bf16x8& pa1, bf16x8& pa2, bf16x8& pa3) {
#pragma unroll
    for (int r = 0; r < 16; ++r) p1[r] = __builtin_amdgcn_exp2f(p1[r]);
    float ps = 0;
#pragma unroll
    for (int r = 0; r < 16; ++r) ps += p0[r];
#pragma unroll
    for (int r = 0; r < 16; ++r) ps += p1[r];
    { auto rr = __builtin_amdgcn_permlane32_swap(__float_as_uint(ps), __float_as_uint(ps), false, false);
      ps = __uint_as_float(rr[0]) + __uint_as_float(rr[1]); }
    l_reg = l_reg * alpha + ps;
#define PK4(P, B_, OUT) do { unsigned a0 = cvt_pk_bf16(P[B_+0], P[B_+1]), a1 = cvt_pk_bf16(P[B_+2], P[B_+3]);                          \
        unsigned b0 = cvt_pk_bf16(P[B_+4], P[B_+5]), b1 = cvt_pk_bf16(P[B_+6], P[B_+7]);                                             \
        auto r0 = __builtin_amdgcn_permlane32_swap(a0, b0, false, false); auto r1 = __builtin_amdgcn_permlane32_swap(a1, b1, false, false); \
        u32x4 w = {r0[0], r1[0], r0[1], r1[1]}; OUT = *reinterpret_cast<bf16x8*>(&w); } while (0)
    PK4(p0, 0, pa0); PK4(p0, 8, pa1); PK4(p1, 0, pa2); PK4(p1, 8, pa3);
#undef PK4
}
__device__ __forceinline__ void qkt(f32x16& p0, f32x16& p1, const char* lbk, const char* lbrk, const bf16x8* qr) {
    p0 = f32x16{}; p1 = f32x16{};
    bf16x8 F0[4], F1[4];
#define KLD(F, g) do { if ((g) < 4) { F[0] = *reinterpret_cast<const bf16x8*>(lbk + (2 * (g)) * 1024); F[1] = *reinterpret_cast<const bf16x8*>(lbk + (2 * (g)) * 1024 + 8192); \
                                      F[2] = *reinterpret_cast<const bf16x8*>(lbk + (2 * (g) + 1) * 1024); F[3] = *reinterpret_cast<const bf16x8*>(lbk + (2 * (g) + 1) * 1024 + 8192); } \
                       else { F[0] = *reinterpret_cast<const bf16x8*>(lbrk + (2 * (g) - 8) * 1024); F[1] = *reinterpret_cast<const bf16x8*>(lbrk + (2 * (g) - 8) * 1024 + 4096); \
                              F[2] = *reinterpret_cast<const bf16x8*>(lbrk + (2 * (g) - 7) * 1024); F[3] = *reinterpret_cast<const bf16x8*>(lbrk + (2 * (g) - 7) * 1024 + 4096); } } while (0)
#define KMM(F, g) do { p0 = __builtin_amdgcn_mfma_f32_32x32x16_bf16(F[0], qr[2 * (g)], p0, 0, 0, 0); p1 = __builtin_amdgcn_mfma_f32_32x32x16_bf16(F[1], qr[2 * (g)], p1, 0, 0, 0); \
                       p0 = __builtin_amdgcn_mfma_f32_32x32x16_bf16(F[2], qr[2 * (g) + 1], p0, 0, 0, 0); p1 = __builtin_amdgcn_mfma_f32_32x32x16_bf16(F[3], qr[2 * (g) + 1], p1, 0, 0, 0); } while (0)
    KLD(F0, 0); KLD(F1, 1); SBAR();
    KMM(F0, 0); SBAR(); KLD(F0, 2); SBAR();
    KMM(F1, 1); SBAR(); KLD(F1, 3); SBAR();
    KMM(F0, 2); SBAR(); KLD(F0, 4); SBAR();
    KMM(F1, 3); SBAR(); KLD(F1, 5); SBAR();
    KMM(F0, 4); SBAR();
    KMM(F1, 5); SBAR();
#undef KLD
#undef KMM
}
__device__ __forceinline__ void pv_tile(f32x16* o, int vbt, bf16x8 pa0, bf16x8 pa1, bf16x8 pa2, bf16x8 pa3) {
#define TRRD(dst, off) asm volatile("ds_read_b64_tr_b16 %0, %1 offset:%2" : "=&v"(dst) : "v"(vbt), "i"(off) : "memory")
#define TRRD8(L, d0) do { constexpr int b_ = v_rd_off(d0, 0, 0); TRRD(L[0], b_); TRRD(L[1], b_ + 2048); TRRD(L[2], b_ + 4096); TRRD(L[3], b_ + 6144); TRRD(L[4], b_ + 8192); TRRD(L[5], b_ + 10240); TRRD(L[6], b_ + 12288); TRRD(L[7], b_ + 14336); } while (0)
#define PVMM(L, d0) do { \
        o[d0] = __builtin_amdgcn_mfma_f32_32x32x16_bf16(pa0, (bf16x8){L[0][0], L[0][1], L[0][2], L[0][3], L[1][0], L[1][1], L[1][2], L[1][3]}, o[d0], 0, 0, 0);   \
        o[d0] = __builtin_amdgcn_mfma_f32_32x32x16_bf16(pa1, (bf16x8){L[2][0], L[2][1], L[2][2], L[2][3], L[3][0], L[3][1], L[3][2], L[3][3]}, o[d0], 0, 0, 0);   \
        o[d0] = __builtin_amdgcn_mfma_f32_32x32x16_bf16(pa2, (bf16x8){L[4][0], L[4][1], L[4][2], L[4][3], L[5][0], L[5][1], L[5][2], L[5][3]}, o[d0], 0, 0, 0);   \
        o[d0] = __builtin_amdgcn_mfma_f32_32x32x16_bf16(pa3, (bf16x8){L[6][0], L[6][1], L[6][2], L[6][3], L[7][0], L[7][1], L[7][2], L[7][3]}, o[d0], 0, 0, 0); } while (0)
#define WAITL(n) asm volatile("s_waitcnt lgkmcnt(" #n ")" ::: "memory")
    s16x4 La[8], Lb[8];
    TRRD8(La, 0); TRRD8(Lb, 1);
    WAITL(8); SBAR(); PVMM(La, 0); SBAR(); TRRD8(La, 2);
    WAITL(8); SBAR(); PVMM(Lb, 1); SBAR(); TRRD8(Lb, 3);
    WAITL(8); SBAR(); PVMM(La, 2); SBAR();
    WAITL(0); SBAR(); PVMM(Lb, 3); SBAR();
#undef TRRD
#undef TRRD8
#undef PVMM
#undef WAITL
}

struct BlockRef { const bf16_t* Q; const bf16_t* Kl; const bf16_t* Kr; bf16_t* O; int P0; };
#define VMW() asm volatile("s_waitcnt vmcnt(0)" ::: "memory")
#define SLOAD(k0) do { const bf16_t* kp_ = cur.Kl + (size_t)((k0) + srow) * 128 + cc * 8; st_k0 = *(const bf16x8*)kp_; st_k1 = *(const bf16x8*)(kp_ + 64); \
                       st_r = *(const bf16x8*)(cur.Kr + (size_t)((k0) + srow) * 64 + cc * 8); } while (0)
#define SWRITE_K(bf) do { char* kd_ = lds + OFF_K + (bf) * SHM_K + kws; *(bf16x8*)kd_ = st_k0; *(bf16x8*)(kd_ + 4096) = st_k1; *(bf16x8*)(lds + OFF_R + (bf) * SHM_R + rws) = st_r; } while (0)
#define SWRITE_V(bf) do { char* vd_ = lds + OFF_V + (bf) * SHM_V + vst0; *(bf16x8*)vd_ = st_k0; *(bf16x8*)(vd_ + 1024) = st_k1; } while (0)
#define ABAR() asm volatile("s_waitcnt lgkmcnt(0)\n\ts_barrier" ::: "memory")
template <int VAR>
__device__ __forceinline__ void attn_block(const BlockRef& cur, char* lds, int tid) {
    asm volatile("" : "+v"(tid));
    const int wid = __builtin_amdgcn_readfirstlane(tid >> 6), lane = tid & 63, r32 = lane & 31, hi = lane >> 5, grp = wid >> 2;
    const int NT = (cur.P0 + QB - 1) / KVBLK + 1;
    const int qlo = cur.P0 + wid * QBLK, qm = qlo + r32 - 4 * hi;
    float* ws = (float*)(lds + OFF_WS) + wid * 64; float* li_l = ws, * al_l = ws + 32;
    float m_reg = -1e30f, l_reg = 0; f32x16 o[4] = {};
    const int srow = wid * 8 + (lane & 7), cc = lane >> 3;
    const int kws = (srow >> 5) * 8192 + (cc >> 1) * 1024 + ((cc & 1) * 32 + (srow & 31)) * 16, rws = (srow >> 5) * 4096 + (cc >> 1) * 1024 + ((cc & 1) * 32 + (srow & 31)) * 16, vst0 = v_st(srow, cc * 8);
    const int vb0 = (int)(uintptr_t)lds + OFF_V + v_rd_base(lane);
    const char* lb = lds + OFF_K + lane * 16;
    int lbr_i = (int)(uintptr_t)lds + OFF_R + lane * 16; asm volatile("" : "+v"(lbr_i));
    const char* lbr = (const char*)(const LAS char*)(uintptr_t)(unsigned)lbr_i;
    bf16x8 qr[12], st_k0, st_k1, st_r;
    { const bf16_t* qp = cur.Q + (size_t)(wid * QBLK + r32) * QW + hi * 8;
#pragma unroll
      for (int d0 = 0; d0 < 12; ++d0) qr[d0] = *(const bf16x8*)(qp + d0 * 16); }
#define RESC(a) do { if (__any((a) < 1.f)) { if (hi == 0) al_l[r32] = (a); asm volatile("s_waitcnt lgkmcnt(0)" ::: "memory");              \
                     _Pragma("unroll") for (int d_ = 0; d_ < 4; ++d_) _Pragma("unroll") for (int r = 0; r < 16; ++r) o[d_][r] *= al_l[crow(r, hi)]; } } while (0)
#define KBASE(t) ((t) * KVBLK)
#define MASKT(P0_, P1_, t) do { const int kb_ = KBASE(t); if (kb_ + KVBLK - 1 > qlo) mask_tile(P0_, P1_, qm - kb_); } while (0)
    f32x16 p0 = {}, p1 = {}; float mn, al = 1.f; bf16x8 pa0 = {}, pa1 = {}, pa2 = {}, pa3 = {};
    const int dist = 1 + grp;
    SLOAD(0); VMW(); SWRITE_K(0); SWRITE_V(0);
    if (grp) { SLOAD(KBASE(1)); VMW(); SWRITE_K(1); SWRITE_V(1); }
    SLOAD(KBASE(dist));
    ABAR();
    if (grp) ABAR();
    int bt = 0;
    for (int t = 0; t < NT; ++t) {
        if (VAR != 2) { SBAR(); qkt(p0, p1, lb + bt * SHM_K, lbr + bt * SHM_R, qr);
        if (t > 0) pv_tile(o, vb0 + (bt == 0 ? 2 : bt - 1) * SHM_V, pa0, pa1, pa2, pa3); }
        SBAR(); ABAR();
        if (VAR != 1) { MASKT(p0, p1, t); partialSM(p0, p1, m_reg, mn, al); finishSM(p0, p1, al, l_reg, pa0, pa1, pa2, pa3); RESC(al); }
        else { asm volatile("" : "+v"(p0), "+v"(p1), "+v"(pa0), "+v"(pa1), "+v"(pa2), "+v"(pa3)); }
        { const int td = t + dist; if (td < NT) { int wbi = bt + dist; wbi = wbi >= 3 ? wbi - 3 : wbi; VMW(); SWRITE_K(wbi); SWRITE_V(wbi); if (td + 1 < NT) SLOAD(KBASE(td + 1)); } }
        bt = bt == 2 ? 0 : bt + 1;
        SBAR(); ABAR();
    }
    pv_tile(o, vb0 + (bt == 0 ? 2 : bt - 1) * SHM_V, pa0, pa1, pa2, pa3);
    if (hi == 0) li_l[r32] = l_reg; asm volatile("s_waitcnt lgkmcnt(0)" ::: "memory");
    float rli[16];
#pragma unroll
    for (int r = 0; r < 16; ++r) rli[r] = __builtin_amdgcn_rcpf(li_l[crow(r, hi)]);
    bf16_t* Ow = cur.O + (size_t)(wid * QBLK) * DM;
#pragma unroll
    for (int r = 0; r < 16; ++r) { const int orow = crow(r, hi);
#pragma unroll
        for (int d0 = 0; d0 < 4; ++d0) { const float v = o[d0][r] * rli[r];
            const float vn = xlane1(v);
            if ((r32 & 1) == 0) *(unsigned*)(Ow + (size_t)orow * DM + d0 * 32 + r32) = cvt_pk_bf16(v, vn); } }
    if (!grp) ABAR();
    ABAR();
#undef RESC
#undef KBASE
#undef MASKT
}
#undef ABAR
#undef VMW
#undef SLOAD
#undef SWRITE_K
#undef SWRITE_V
}

constexpr int NWAVES = 8;
constexpr int RING_BYTES = 157696, MISC_OFF = RING_BYTES + 64, LDS_BYTES = 158720;
static_assert(att::LDS_BYTES <= RING_BYTES && pg8::STAGE_BYTES <= RING_BYTES, "phase scratch fits the ring region");
#define RLX_AGENT __ATOMIC_RELAXED, __HIP_MEMORY_SCOPE_AGENT

#define XB_TMO      128
#define XB_XCNT(j)  (256  + 64 * (j))
#define XB_XSUB(j)  (1280 + 64 * (j))
#define XB_XGEN(j)  (2304 + 64 * (j))
#define XB_TOP      3328
#define XB_TOPGEN   3392
#define XCD_BAR_WORDS 3456
#define XB_SPIN_CAP (1u << 18)
__device__ __forceinline__ unsigned xb_ld(unsigned* p)              { return __hip_atomic_load(p, __ATOMIC_RELAXED, __HIP_MEMORY_SCOPE_AGENT); }
__device__ __forceinline__ unsigned xb_add(unsigned* p, unsigned v) { return __hip_atomic_fetch_add(p, v, __ATOMIC_RELAXED, __HIP_MEMORY_SCOPE_AGENT); }
__device__ __forceinline__ unsigned xb_xcc_id() { return (unsigned)__builtin_amdgcn_s_getreg((3 << 11) | 20) & 0xFu; }
#define XB_SPIN(cond, bar) do { unsigned _sp = 0; while (cond) { __builtin_amdgcn_s_sleep(1); \
    if ((++_sp & 255u) == 0u) { if (xb_ld(&(bar)[XB_TMO])) break; if (_sp > XB_SPIN_CAP) { atomicAdd(&(bar)[XB_TMO], 1u); break; } } } } while (0)
struct XcdBarrier { unsigned* bar; unsigned x; volatile LAS unsigned* st; };
__device__ __forceinline__ XcdBarrier xcd_barrier_post(unsigned* bar, volatile LAS unsigned* st) {
    XcdBarrier b; b.bar = bar; b.x = xb_xcc_id(); b.st = st;
    if (threadIdx.x == 0) (void)xb_add(&bar[XB_XCNT(b.x)], 1u);
    return b;
}
__device__ __forceinline__ void xcd_barrier_complete(unsigned* bar, unsigned x, unsigned& nloc, unsigned& nx) {
    const unsigned G = gridDim.x * gridDim.y * gridDim.z;
    unsigned sum, cnt, mine, sp = 0u;
    for (;;) {
        sum = 0u; cnt = 0u; mine = 0u;
#pragma unroll
        for (unsigned j = 0; j < 16; ++j) { const unsigned c = xb_ld(&bar[XB_XCNT(j)]); sum += c; cnt += (c > 0u) ? 1u : 0u; mine = (j == x) ? c : mine; }
        if (sum == G) break;
        __builtin_amdgcn_s_sleep(1);
        if ((++sp & 255u) == 0u) { if (xb_ld(&bar[XB_TMO])) break; if (sp > XB_SPIN_CAP) { atomicAdd(&bar[XB_TMO], 1u); break; } }
    }
    nloc = mine > 0u ? mine : 1u; nx = cnt > 0u ? cnt : 1u;
}
__device__ __forceinline__ void xcd_barrier(const XcdBarrier& b, const bool leader  ) {
    asm volatile("s_waitcnt vmcnt(0)" ::: "memory");
    __syncthreads();
    if (leader) {
        unsigned* bar = b.bar;
        __builtin_amdgcn_s_waitcnt(0);
        unsigned nloc = b.st[0], nx = b.st[1];
        if (nloc == 0u) { xcd_barrier_complete(bar, b.x, nloc, nx); b.st[0] = nloc; b.st[1] = nx; }
        const unsigned old = xb_add(&bar[XB_XSUB(b.x)], 1u);
        const unsigned gen = old / nloc;
        if (old + 1u == (gen + 1u) * nloc) {
            __builtin_amdgcn_fence(__ATOMIC_RELEASE, "agent");
            asm volatile("s_waitcnt vmcnt(0)" ::: "memory");
            const unsigned og = xb_add(&bar[XB_TOP], 1u);
            const unsigned tg = og / nx;
            if (og + 1u == (tg + 1u) * nx) xb_add(&bar[XB_TOPGEN], 1u);
            else XB_SPIN(xb_ld(&bar[XB_TOPGEN]) == tg, bar);
            __builtin_amdgcn_fence(__ATOMIC_ACQUIRE, "agent");
            xb_add(&bar[XB_XGEN(b.x)], 1u);
            asm volatile("s_waitcnt vmcnt(0)" ::: "memory");
        } else {
            XB_SPIN(xb_ld(&bar[XB_XGEN(b.x)]) == gen, bar);
            __builtin_amdgcn_fence(__ATOMIC_ACQUIRE, "agent");
            asm volatile("s_waitcnt vmcnt(0)" ::: "memory");
        }
    }
    __syncthreads();
}

__device__ const double ROPE_INVF[32] = {1.0, 0.7498942093324559, 0.5623413251903491, 0.4216965034285822, 0.31622776601683794, 0.23713737056616552, 0.1778279410038923, 0.1333521432163324, 0.1,
    0.07498942093324558, 0.05623413251903491, 0.042169650342858224, 0.03162277660168379, 0.023713737056616554, 0.01778279410038923, 0.01333521432163324, 0.01, 0.007498942093324558,
    0.005623413251903491, 0.004216965034285823, 0.0031622776601683794, 0.0023713737056616554, 0.0017782794100389228, 0.001333521432163324, 0.001, 0.0007498942093324559, 0.0005623413251903491,
    0.00042169650342858224, 0.00031622776601683794, 0.00023713737056616554, 0.00017782794100389227, 0.0001333521432163324};
__device__ __forceinline__ void sincos_d(double a, float& s_out, float& c_out) {
    const double kq = __builtin_rint(a * 0.6366197723675814);
    double r = a - kq * 1.570796325802803; r -= kq * 9.920935796805404e-10;
    const double r2 = r * r;
    double sp = -1.0 / 1307674368000.0; sp = sp * r2 + 1.0 / 6227020800.0; sp = sp * r2 - 1.0 / 39916800.0; sp = sp * r2 + 1.0 / 362880.0; sp = sp * r2 - 1.0 / 5040.0; sp = sp * r2 + 1.0 / 120.0; sp = sp * r2 - 1.0 / 6.0; sp = sp * r2 + 1.0;
    const double sn = sp * r;
    double cp = 1.0 / 20922789888000.0; cp = cp * r2 - 1.0 / 87178291200.0; cp = cp * r2 + 1.0 / 479001600.0; cp = cp * r2 - 1.0 / 3628800.0; cp = cp * r2 + 1.0 / 40320.0; cp = cp * r2 - 1.0 / 720.0; cp = cp * r2 + 1.0 / 24.0; cp = cp * r2 - 0.5; cp = cp * r2 + 1.0;
    const int q = ((int)kq) & 3;
    const double s = (q == 0) ? sn : (q == 1) ? cp : (q == 2) ? -sn : -cp;
    const double c = (q == 0) ? cp : (q == 1) ? -sn : (q == 2) ? -cp : sn;
    s_out = (float)s; c_out = (float)c;
}
struct TrItem { const float* W; bf16_t* dst; int N, k0, n0, drow0, ldd, kofs; };
__device__ __forceinline__ void tr_load(const TrItem& t, float (&tv)[32], int lane) {
#pragma unroll
    for (int i = 0; i < 32; ++i) tv[i] = t.W[(size_t)(t.k0 + 2 * i + (lane >> 5)) * t.N + t.n0 + (lane & 31)];
}
__device__ __forceinline__ void tr_store(const TrItem& t, const float (&tv)[32], LAS float* scr, int lane) {
#pragma unroll
    for (int i = 0; i < 32; ++i) scr[(2 * i + (lane >> 5)) * 33 + (lane & 31)] = tv[i];
    LDS_WAIT(); asm volatile("" ::: "memory");
    const int c = lane & 7;
#pragma unroll
    for (int j = 0; j < 4; ++j) { const int n = (lane >> 3) + 8 * j; const LAS float* s = scr + (8 * c) * 33 + n;
        u32x4 o; o.x = cvt_pk_bf16(s[0 * 33], s[1 * 33]); o.y = cvt_pk_bf16(s[2 * 33], s[3 * 33]); o.z = cvt_pk_bf16(s[4 * 33], s[5 * 33]); o.w = cvt_pk_bf16(s[6 * 33], s[7 * 33]);
        *(u32x4*)(t.dst + (size_t)(t.drow0 + n) * t.ldd + t.kofs + 8 * c) = o; }
    LDS_WAIT(); asm volatile("" ::: "memory");
}
template <class Dec>
__device__ __forceinline__ void tr_run(const Dec& dec, int nit, int gw, int NGW, LAS float* scr, int lane) {
    float ta[32], tb[32]; TrItem A, B;
    int it = gw; if (it < nit) { A = dec(it); tr_load(A, ta, lane); }
    while (it < nit) {
        const int it1 = it + NGW; if (it1 < nit) { B = dec(it1); tr_load(B, tb, lane); }
        tr_store(A, ta, scr, lane);
        const int it2 = it1 + NGW; if (it2 < nit) { A = dec(it2); tr_load(A, ta, lane); }
        if (it1 < nit) tr_store(B, tb, scr, lane);
        it = it2;
    }
}

struct Args { const float* in[21]; float* out; unsigned char* ws; int ph_lo, ph_hi; };
typedef const Args __attribute__((address_space(4))) * KArgsP;
enum { I_X = 0, I_ATTN_NORM, I_W_IN, I_LB, I_OUT_NORM, I_Q_NORM, I_W_UQ, I_KV_NORM, I_W_UKV, I_POOL_W, I_POOL_SCALE, I_W_O, I_FFN_NORM, I_DG, I_DU, I_DD, I_ROUTER, I_MG, I_MU, I_MD, I_FINAL_NORM };
constexpr int NPH = 23;

constexpr int P0_I_WIN = 16 * 70, P0_I_WOP = 8 * 32, P0_I_DGU = 16 * 80, P0_I_DDN = 40 * 32, P0_NIT = 2 * P0_I_WIN + 2 * P0_I_WOP + 2 * P0_I_DGU + P0_I_DDN;
struct DenseDec { KArgsP ap_; unsigned char* ws;
    __device__ __forceinline__ TrItem operator()(int it) const { constexpr int I_WIN = P0_I_WIN, I_WOP = P0_I_WOP, I_DGU = P0_I_DGU; int r = it; TrItem t;
        if (r < 2 * I_WIN) { const int l = r / I_WIN; r -= l * I_WIN; const int kb = r / 70, nb = r % 70;
            t.W = ap_->in[I_W_IN] + (size_t)l * DM * DIN; t.N = DIN; t.k0 = kb * 64; t.n0 = nb * 32; t.dst = (bf16_t*)(ws + WS_WIN) + (size_t)l * DINP * DM; t.drow0 = nb * 32; t.ldd = DM; t.kofs = kb * 64; return t; }
        r -= 2 * I_WIN;
        if (r < 2 * I_WOP) { const int l = r / I_WOP; r -= l * I_WOP; const int kq = r / 32, nb = r % 32; const int kb = kq < 4 ? kq : kq + 8;
            t.W = ap_->in[I_W_O] + (size_t)l * DM * DM; t.N = DM; t.k0 = kb * 64; t.n0 = nb * 32; t.dst = (bf16_t*)(ws + WS_WO) + (size_t)l * DM * DM; t.drow0 = nb * 32; t.ldd = DM; t.kofs = kb * 64; return t; }
        r -= 2 * I_WOP;
        if (r < 2 * I_DGU) { const int up = r / I_DGU; r -= up * I_DGU; const int kb = r / 80, nb = r % 80; const int n0 = nb * 32;
            t.W = ap_->in[up ? I_DU : I_DG]; t.N = DFF; t.k0 = kb * 64; t.n0 = n0; t.dst = (bf16_t*)(ws + WS_WGU); t.drow0 = (n0 >> 7) * 256 + up * 128 + (n0 & 127); t.ldd = DM; t.kofs = kb * 64; return t; }
        r -= 2 * I_DGU;
        { const int kb = r / 32, nb = r % 32; t.W = ap_->in[I_DD]; t.N = DM; t.k0 = kb * 64; t.n0 = nb * 32; t.dst = (bf16_t*)(ws + WS_WD); t.drow0 = nb * 32; t.ldd = DFF; t.kofs = kb * 64; return t; } } };
constexpr int MOE_I_GU = 16 * 112, MOE_I_DN = 56 * 32, MOE_I_E = 2 * MOE_I_GU + MOE_I_DN;
struct MoeDec { const float* mg; const float* mu; const float* md; unsigned char* wsp;
    __device__ __forceinline__ TrItem operator()(int it) const { constexpr int I_GU = MOE_I_GU, I_E = MOE_I_E; const int e = it / I_E; int r = it % I_E; bf16_t* we = (bf16_t*)(wsp + WS_MOEW) + (size_t)e * MOEW_E; TrItem t;
        if (r < 2 * I_GU) { const int up = r / I_GU; r -= up * I_GU; const int kb = r / 112, nb = r % 112, n0 = nb * 32;
            t.W = (up ? mu : mg) + (size_t)e * DM * DFFE; t.N = DFFE; t.k0 = kb * 64; t.n0 = n0; t.dst = we; t.drow0 = (n0 >> 7) * 256 + up * 128 + (n0 & 127); t.ldd = DM; t.kofs = kb * 64; }
        else { r -= 2 * I_GU; const int kb = r / 32, nb = r % 32;
            t.W = md + (size_t)e * DFFE * DM; t.N = DM; t.k0 = kb * 64; t.n0 = nb * 32; t.dst = we + (size_t)2 * DFFE * DM; t.drow0 = nb * 32; t.ldd = DFFE; t.kofs = kb * 64; }
        return t; } };
struct P0StreamDec { DenseDec d; MoeDec m; __device__ __forceinline__ TrItem operator()(int it) const { if (it < P0_NIT) return d(it); return m(it - P0_NIT); } };
__device__ __forceinline__ void p0_stream(KArgsP ap_, LAS unsigned char* lds, int gw, int NGW, int wave, int lane) {
    LAS float* scr = (LAS float*)(lds + wave * 16384);
    P0StreamDec dec{DenseDec{ap_, ap_->ws}, MoeDec{ap_->in[I_MG], ap_->in[I_MU], ap_->in[I_MD], ap_->ws}};
    tr_run(dec, P0_NIT + NE * MOE_I_E, gw, NGW, scr, lane);
}

__device__ __forceinline__ void p0_prologue(KArgsP ap_, LAS unsigned char* lds, int gw, int NGW, int gt, int NGT, int wave, int lane, const int part) {
    unsigned char* ws = ap_->ws;
    LAS float* scr = (LAS float*)(lds + wave * 16384);
    for (int i = gt; i < 2 * 64 * DM / 8; i += NGT) { const int l = i / (64 * DM / 8), r = i % (64 * DM / 8);
        *(u32x4*)((bf16_t*)(ws + WS_WIN) + ((size_t)l * DINP + DIN) * DM + (size_t)r * 8) = (u32x4){0u, 0u, 0u, 0u}; }
    const float qscale = 0.07216878364870322f * 1.4426950408889634f;
    for (int i = gt; i < 2 * 4 * 16 * 256; i += NGT) { const int c = i & 255, jg = (i >> 8) & 15, h = (i >> 12) & 3, l = i >> 14, j0 = jg * 8;
        const float* wuq = ap_->in[I_W_UQ] + (size_t)l * 256 * QW + (size_t)c * QW + h * 192; const float* wk = ap_->in[I_W_UKV] + (size_t)l * 128 * 1024 + (size_t)j0 * 1024 + h * 256;
        float acc[8];
#pragma unroll
        for (int q = 0; q < 8; ++q) acc[q] = 0.f;
#pragma unroll 4
        for (int d = 0; d < 128; d += 4) { const f32x4 x = *(const f32x4*)(wuq + d);
#pragma unroll
            for (int q = 0; q < 8; ++q) { const f32x4 y = *(const f32x4*)(wk + (size_t)q * 1024 + d); acc[q] += (x[0] * y[0] + x[1] * y[1]) + (x[2] * y[2] + x[3] * y[3]); } }
        const float gsc = ap_->in[I_Q_NORM][l * 256 + c] * qscale;
#pragma unroll
        for (int q = 0; q < 8; ++q) ((bf16_t*)(ws + WS_WQ))[((size_t)l * QW + h * 192 + j0 + q) * 256 + c] = f2bf(acc[q] * gsc); }
    for (int i = gt; i < 2 * 4 * 64 * 256; i += NGT) { const int c = i & 255, jj = (i >> 8) & 63, h = (i >> 14) & 3, l = i >> 16;
        const float v = ap_->in[I_W_UQ][(size_t)l * 256 * QW + (size_t)c * QW + h * 192 + 128 + (jj >> 1) + 32 * (jj & 1)];
        ((bf16_t*)(ws + WS_WQ))[((size_t)l * QW + h * 192 + 128 + jj) * 256 + c] = f2bf(v * ap_->in[I_Q_NORM][l * 256 + c] * qscale); }
    for (int i = gt; i < 2 * DM * 64; i += NGT) { const int n = i & 1023, g = (i >> 10) & 63, l = i >> 16, kk0 = g * 8, h = kk0 >> 7, r0 = kk0 & 127;
        const float* wv = ap_->in[I_W_UKV] + (size_t)l * 128 * 1024 + (size_t)r0 * 1024 + h * 256 + 128; const float* wo = ap_->in[I_W_O] + (size_t)l * DM * DM + (size_t)(256 + h * 128) * DM + n;
        float acc[8];
#pragma unroll
        for (int j = 0; j < 8; ++j) acc[j] = 0.f;
#pragma unroll 4
        for (int e = 0; e < 128; e += 4) { const float w0 = wo[(size_t)e * DM], w1 = wo[(size_t)(e + 1) * DM], w2 = wo[(size_t)(e + 2) * DM], w3 = wo[(size_t)(e + 3) * DM];
#pragma unroll
            for (int j = 0; j < 8; ++j) { const f32x4 x = *(const f32x4*)(wv + (size_t)j * 1024 + e); acc[j] += (x[0] * w0 + x[1] * w1) + (x[2] * w2 + x[3] * w3); } }
        *(u32x4*)((bf16_t*)(ws + WS_WO) + (size_t)l * DM * DM + (size_t)n * DM + 256 + kk0) = (u32x4){cvt_pk_bf16(acc[0], acc[1]), cvt_pk_bf16(acc[2], acc[3]), cvt_pk_bf16(acc[4], acc[5]), cvt_pk_bf16(acc[6], acc[7])}; }
    for (int i = gt; i < SEQ * 32; i += NGT) { const int pos = i >> 5, f = i & 31; float s, c; sincos_d((double)pos * ROPE_INVF[f], s, c); ((float*)(ws + WS_COS))[i] = c; ((float*)(ws + WS_SIN))[i] = s; }
    for (int i = gt; i < 512; i += NGT) { const float x0 = ap_->in[I_LB][i], x1 = ap_->in[I_LB][512 + i]; ((float*)(ws + WS_LBS))[i] = 0.f; ((float*)(ws + WS_LBS))[512 + i] = 1.f / (1.f + expf(x0 - x1)); }
}
__device__ __forceinline__ void unpack4(const u32x2 w, f32x4& v) { v[0] = __uint_as_float(w.x << 16); v[1] = __uint_as_float(w.x & 0xffff0000u); v[2] = __uint_as_float(w.y << 16); v[3] = __uint_as_float(w.y & 0xffff0000u); }
template <bool XB16>
__device__ __forceinline__ void norm_to_bf16(const void* xs_, const bf16_t* dl, bf16_t* xd, const float* g, bf16_t* hn, int gw, int NGW, int lane) {
    f32x4 gv[4];
#pragma unroll
    for (int j = 0; j < 4; ++j) gv[j] = *(const f32x4*)(g + 4 * lane + 256 * j);
    for (int m0 = gw; m0 < T; m0 += 2 * NGW) {
        const int m1 = m0 + NGW < T ? m0 + NGW : m0; f32x4 v[2][4]; u32x2 xw[2][4], dw[2][4];
#pragma unroll
        for (int u = 0; u < 2; ++u) { const int m = u ? m1 : m0;
            if (XB16) { const u32x2* xr = (const u32x2*)((const bf16_t*)xs_ + (size_t)m * DM) + lane;
#pragma unroll
                for (int j = 0; j < 4; ++j) xw[u][j] = xr[64 * j]; }
            else { const f32x4* xr = (const f32x4*)((const float*)xs_ + (size_t)m * DM) + lane;
#pragma unroll
                for (int j = 0; j < 4; ++j) v[u][j] = xr[64 * j]; }
            if (dl) { const u32x2* dr = (const u32x2*)(dl + (size_t)m * DM) + lane;
#pragma unroll
                for (int j = 0; j < 4; ++j) dw[u][j] = dr[64 * j]; } }
#pragma unroll
        for (int u = 0; u < 2; ++u) { const int m = u ? m1 : m0; if (u && m1 == m0) break; float s = 0.f;
            if (XB16) {
#pragma unroll
                for (int j = 0; j < 4; ++j) unpack4(xw[u][j], v[u][j]); }
            if (dl) {
#pragma unroll
                for (int j = 0; j < 4; ++j) { f32x4 d; unpack4(dw[u][j], d); v[u][j] += d;
                    u32x2 w; w.x = cvt_pk_bf16(v[u][j][0], v[u][j][1]); w.y = cvt_pk_bf16(v[u][j][2], v[u][j][3]); *(u32x2*)(xd + (size_t)m * DM + 4 * lane + 256 * j) = w; } }
#pragma unroll
            for (int j = 0; j < 4; ++j) s += (v[u][j][0] * v[u][j][0] + v[u][j][1] * v[u][j][1]) + (v[u][j][2] * v[u][j][2] + v[u][j][3] * v[u][j][3]);
            const float rstd = 1.0f / sqrtf(wave_sum(s) * (1.f / DM) + EPS);
#pragma unroll
            for (int j = 0; j < 4; ++j) { const f32x4 o = v[u][j] * rstd * gv[j]; u32x2 w; w.x = cvt_pk_bf16(o[0], o[1]); w.y = cvt_pk_bf16(o[2], o[3]); *(u32x2*)(hn + (size_t)m * DM + 4 * lane + 256 * j) = w; } }
    }
}
__device__ __forceinline__ void norm_final(const bf16_t* x, float* out, const float* g, int gw, int NGW, int lane) {
    f32x4 gv[4];
#pragma unroll
    for (int j = 0; j < 4; ++j) gv[j] = *(const f32x4*)(g + 4 * lane + 256 * j);
    for (int m0 = gw; m0 < T; m0 += 2 * NGW) {
        const int m1 = m0 + NGW < T ? m0 + NGW : m0; u32x2 xw[2][4];
#pragma unroll
        for (int u = 0; u < 2; ++u) { const int m = u ? m1 : m0; const u32x2* xr = (const u32x2*)(x + (size_t)m * DM) + lane;
#pragma unroll
            for (int j = 0; j < 4; ++j) xw[u][j] = xr[64 * j]; }
#pragma unroll
        for (int u = 0; u < 2; ++u) { const int m = u ? m1 : m0; if (u && m1 == m0) break; float s = 0.f; f32x4 v[4];
#pragma unroll
            for (int j = 0; j < 4; ++j) { unpack4(xw[u][j], v[j]); s += (v[j][0] * v[j][0] + v[j][1] * v[j][1]) + (v[j][2] * v[j][2] + v[j][3] * v[j][3]); }
            const float rstd = 1.0f / sqrtf(wave_sum(s) * (1.f / DM) + EPS);
            f32x4* xw4 = (f32x4*)(out + (size_t)m * DM) + lane;
#pragma unroll
            for (int j = 0; j < 4; ++j) xw4[64 * j] = v[j] * rstd * gv[j]; }
    }
}
template <bool SLIM>
__device__ __forceinline__ void norm_router(bf16_t* x, const bf16_t* dl, const float* g, const float* router, bf16_t* hn, int* tok_e, float* tok_g, int* counts, LAS unsigned char* lds, int bx, int G, int tid, int wave, int lane) {
    LAS float* rl = (LAS float*)lds;
    LAS int* cl = (LAS int*)(lds + 32768);
    for (int i = tid; i < DM * NE; i += NWAVES * 64) rl[i] = router[i];
    f32x4 gv[4];
#pragma unroll
    for (int j = 0; j < 4; ++j) gv[j] = *(const f32x4*)(g + 4 * lane + 256 * j);
    for (int rg = bx; rg < T / 128; rg += G) {
        if (tid < 16) cl[tid] = 0;
        __syncthreads();
        u32x2 dwn[4], xwn[4];
        { const int m = rg * 128 + wave * 16; const u32x2* xr = (const u32x2*)(x + (size_t)m * DM) + lane; const u32x2* dr = (const u32x2*)(dl + (size_t)m * DM) + lane;
#pragma unroll
          for (int j = 0; j < 4; ++j) { if constexpr (!SLIM) dwn[j] = dr[64 * j]; xwn[j] = xr[64 * j]; } }
        for (int rr = 0; rr < 16; ++rr) { const int m = rg * 128 + wave * 16 + rr;
            u32x2* xr = (u32x2*)(x + (size_t)m * DM) + lane; f32x4 v[4]; u32x2 dw[4], xw[4]; float s = 0.f;
#pragma unroll
            for (int j = 0; j < 4; ++j) { dw[j] = dwn[j]; xw[j] = xwn[j]; }
            if (rr + 1 < 16) { const u32x2* xq = (const u32x2*)(x + (size_t)(m + 1) * DM) + lane; const u32x2* dq = (const u32x2*)(dl + (size_t)(m + 1) * DM) + lane;
#pragma unroll
                for (int j = 0; j < 4; ++j) { if constexpr (!SLIM) dwn[j] = dq[64 * j]; xwn[j] = xq[64 * j]; } }
#pragma unroll
            for (int j = 0; j < 4; ++j) { unpack4(xw[j], v[j]);
                if constexpr (!SLIM) { f32x4 d; unpack4(dw[j], d); v[j] += d; u32x2 w; w.x = cvt_pk_bf16(v[j][0], v[j][1]); w.y = cvt_pk_bf16(v[j][2], v[j][3]); xr[64 * j] = w; }
                s += (v[j][0] * v[j][0] + v[j][1] * v[j][1]) + (v[j][2] * v[j][2] + v[j][3] * v[j][3]); }
            const float rstd = 1.0f / sqrtf(wave_sum(s) * (1.f / DM) + EPS);
            float lg[NE];
#pragma unroll
            for (int e = 0; e < NE; ++e) lg[e] = 0.f;
#pragma unroll
            for (int j = 0; j < 4; ++j) { const f32x4 o = v[j] * rstd * gv[j]; if constexpr (!SLIM) { u32x2 w; w.x = cvt_pk_bf16(o[0], o[1]); w.y = cvt_pk_bf16(o[2], o[3]); *(u32x2*)(hn + (size_t)m * DM + 4 * lane + 256 * j) = w; }
#pragma unroll
                for (int i = 0; i < 4; ++i) { const LAS f32x4* rp = (const LAS f32x4*)(rl + (size_t)(4 * lane + 256 * j + i) * NE); const f32x4 r0 = rp[0], r1 = rp[1];
                    lg[0] += o[i] * r0[0]; lg[1] += o[i] * r0[1]; lg[2] += o[i] * r0[2]; lg[3] += o[i] * r0[3]; lg[4] += o[i] * r1[0]; lg[5] += o[i] * r1[1]; lg[6] += o[i] * r1[2]; lg[7] += o[i] * r1[3]; } }
#pragma unroll
            for (int e = 0; e < NE; ++e) lg[e] = wave_sum(lg[e]);
            int i1 = 0; float v1 = lg[0];
#pragma unroll
            for (int e = 1; e < NE; ++e) if (lg[e] > v1) { v1 = lg[e]; i1 = e; }
            int i2 = -1; float v2 = -3.0e38f;
#pragma unroll
            for (int e = 0; e < NE; ++e) if (e != i1 && lg[e] > v2) { v2 = lg[e]; i2 = e; }
            const float ex = expf(v2 - v1), g1 = 1.f / (1.f + ex), g2 = ex * g1;
            if (lane == 0) { tok_e[2 * m] = i1; tok_e[2 * m + 1] = i2; tok_g[2 * m] = g1; tok_g[2 * m + 1] = g2; atomicAdd((int*)&cl[i1], 1); atomicAdd((int*)&cl[8 + i2], 1); }
        }
        __syncthreads();
        if (tid < 16) counts[rg * 16 + tid] = cl[tid];
        __syncthreads();
    }
}
__device__ __forceinline__ void route_tables(const int* tok_e, const float* tok_g, const int* counts, int* slot_tok, float* slot_g, int* tile_e, LAS unsigned char* lds, int bx, int G, int tid) {
    LAS int* pre = (LAS int*)lds;
    LAS int* off = (LAS int*)(lds + 257 * 16 * 4);
    LAS int* el = off + 16;
    { LAS int* segt = el + 256;
      for (int i = tid; i < 256 * 16; i += NWAVES * 64) pre[i] = counts[i];
      __syncthreads();
      const int col = tid & 15, seg = (tid >> 4) & 15;
      if (tid < 256) { int run = 0; for (int k = 0; k < 16; ++k) { const int rg = seg * 16 + k; const int v = pre[rg * 16 + col]; pre[rg * 16 + col] = run; run += v; } segt[seg * 16 + col] = run; }
      __syncthreads();
      if (tid < 256) { int base = 0; for (int s2 = 0; s2 < seg; ++s2) base += segt[s2 * 16 + col];
          for (int k = 0; k < 16; ++k) pre[(seg * 16 + k) * 16 + col] += base;
          if (seg == 15) pre[256 * 16 + col] = base + segt[15 * 16 + col]; }
      __syncthreads(); }
    if (tid < 2) { int run = 0; for (int e = 0; e < NE; ++e) { off[tid * 8 + e] = run; run += (pre[256 * 16 + tid * 8 + e] + 255) & ~255; }
        if (bx == 0) { tile_e[tid * 256] = run >> 8; for (int e = 0; e < NE; ++e) { const int t0 = off[tid * 8 + e] >> 8, nt = (pre[256 * 16 + tid * 8 + e] + 255) >> 8; for (int t = 0; t < nt; ++t) tile_e[tid * 256 + 1 + t0 + t] = e; } } }
    __syncthreads();
    if (bx == 0) {
        for (int i = tid; i < 16 * 256; i += NWAVES * 64) { const int re = i >> 8, j = i & 255, r = re >> 3; const int tot = pre[256 * 16 + re], padn = ((tot + 255) & ~255) - tot;
            if (j < padn) { slot_tok[r * MOE_ROWS + off[re] + tot + j] = -1; slot_g[r * MOE_ROWS + off[re] + tot + j] = 0.f; } } }
    for (int rg = bx; rg < T / 128; rg += G) {
        if (tid < 256) { const int r = tid >> 7, j = tid & 127; el[r * 128 + j] = tok_e[2 * (rg * 128 + j) + r]; }
        __syncthreads();
        if (tid < 256) { const int r = tid >> 7, j = tid & 127, m = rg * 128 + j, e = el[r * 128 + j]; int loc = 0;
            for (int jj = 0; jj < j; ++jj) loc += (el[r * 128 + jj] == e) ? 1 : 0;
            const int slot = off[r * 8 + e] + pre[rg * 16 + r * 8 + e] + loc;
            slot_tok[r * MOE_ROWS + slot] = m; slot_g[r * MOE_ROWS + slot] = tok_g[2 * m + r]; }
        __syncthreads();
    }
}

__device__ __forceinline__ void prep_tokens(const bf16_t* proj, const float* kvg, const float* cosT, const float* sinT, float* rstdq, bf16_t* klat, bf16_t* krope, int gw, int NGW, int lane) {
    const float g0 = kvg[2 * lane], g1 = kvg[2 * lane + 1];
    constexpr int NT = 4;
    for (int mb = gw; mb < T; mb += NT * NGW) {
        u32x2 cq[NT]; unsigned ck[NT]; unsigned short xa[NT], xb[NT]; float cc[NT], sn[NT];
#pragma unroll
        for (int u = 0; u < NT; ++u) { const int m = mb + u * NGW < T ? mb + u * NGW : mb; const bf16_t* pr = proj + (size_t)m * DINP;
            cq[u] = *(const u32x2*)(pr + COL_CQ + 4 * lane); ck[u] = *(const unsigned*)(pr + COL_CKV + 2 * lane);
            const int pos = m & (SEQ - 1), l5 = lane & 31; xa[u] = pr[COL_KPE + l5]; xb[u] = pr[COL_KPE + 32 + l5]; cc[u] = cosT[pos * 32 + l5]; sn[u] = sinT[pos * 32 + l5]; }
#pragma unroll
        for (int u = 0; u < NT; ++u) { const int m = mb + u * NGW; if (m >= T) break;
            const float a0 = __uint_as_float(cq[u].x << 16), a1 = __uint_as_float(cq[u].x & 0xffff0000u), a2 = __uint_as_float(cq[u].y << 16), a3 = __uint_as_float(cq[u].y & 0xffff0000u);
            const float k0 = __uint_as_float(ck[u] << 16), k1 = __uint_as_float(ck[u] & 0xffff0000u);
            const float sq = wave_sum((a0 * a0 + a1 * a1) + (a2 * a2 + a3 * a3)), sk = wave_sum(k0 * k0 + k1 * k1);
            if (lane == 0) rstdq[m] = 1.0f / sqrtf(sq * (1.f / 256.f) + EPS);
            const float rk = 1.0f / sqrtf(sk * (1.f / 128.f) + EPS);
            *(unsigned*)(klat + (size_t)m * 128 + 2 * lane) = cvt_pk_bf16(k0 * rk * g0, k1 * rk * g1);
            if (lane < 32) { const float x1 = bf2f(xa[u]), x2 = bf2f(xb[u]);
                *(unsigned*)(krope + (size_t)m * 64 + 2 * lane) = cvt_pk_bf16(x1 * cc[u] - x2 * sn[u], x1 * sn[u] + x2 * cc[u]); } }
    }
}

__device__ __forceinline__ void pool_phase(const bf16_t* proj, const float* pw, const float* pscale, bf16_t* ocat, LAS unsigned char* lds, int bx, int G, int tid) {
    constexpr int PP = 264, WP = 72;
    LAS bf16_t* xs = (LAS bf16_t*)lds;
    LAS bf16_t* pl = (LAS bf16_t*)(lds + 40960);
    LAS bf16_t* wt = (LAS bf16_t*)(lds + 40960 + 64 * PP * 2);
    const int lane = tid & 63, wave = tid >> 6, r32 = lane & 31, hi = lane >> 5;
    for (int i = tid; i < 4 * 64 * 64; i += NWAVES * 64) { const int g = i >> 12, c = (i >> 6) & 63, d = i & 63; wt[(g * 64 + d) * WP + c] = f2bf(pw[i]); }
    const int ch = tid & 255, half = tid >> 8, gch = ch >> 6, w = 2 << gch;
    const int g = wave >> 1, tb = wave & 1;
    const float sc0 = pscale[g * 64 + r32], sc1 = pscale[g * 64 + 32 + r32];
    for (int tile = bx; tile < T / 64; tile += G) {
        const int tok0 = tile * 64, pos0 = tok0 & (SEQ - 1);
#pragma unroll
        for (int i = 0; i < 5; ++i) { const int idx = tid + i * 512, r = idx >> 5, c8 = (idx & 31) * 8; u32x4 v = {0u, 0u, 0u, 0u};
            if (pos0 - 16 + r >= 0) v = *(const u32x4*)(proj + (size_t)(tok0 - 16 + r) * DINP + COL_XP + c8);
            *(LAS u32x4*)(xs + r * 256 + c8) = v; }
        __syncthreads();
        { const int t0 = half * 32; float s = 0.f;
          for (int j = 1; j < w; ++j) s += bf2f(xs[(t0 + 16 - j) * 256 + ch]);
          for (int tt = 0; tt < 32; ++tt) { const int t = t0 + tt, r = t + 16; const float xv = bf2f(xs[r * 256 + ch]); s += xv;
              const int pc = pos0 + t + 1; const float cnt = (float)(pc < w ? pc : w);
              pl[t * PP + ch] = f2bf(s / cnt - xv);
              s -= bf2f(xs[(r - w + 1) * 256 + ch]); } }
        __syncthreads();
        { f32x16 acc0 = {}, acc1 = {};
#pragma unroll
          for (int ks = 0; ks < 4; ++ks) { const bf16x8 af = *(const LAS bf16x8*)(pl + (tb * 32 + r32) * PP + g * 64 + ks * 16 + 8 * hi);
              const bf16x8 b0 = *(const LAS bf16x8*)(wt + (g * 64 + r32) * WP + ks * 16 + 8 * hi), b1 = *(const LAS bf16x8*)(wt + (g * 64 + 32 + r32) * WP + ks * 16 + 8 * hi);
              acc0 = __builtin_amdgcn_mfma_f32_32x32x16_bf16(af, b0, acc0, 0, 0, 0); acc1 = __builtin_amdgcn_mfma_f32_32x32x16_bf16(af, b1, acc1, 0, 0, 0); }
          bf16_t* op = ocat + (size_t)(tok0 + tb * 32) * DM + 768 + g * 64 + r32;
#pragma unroll
          for (int i = 0; i < 16; ++i) { const int row = (i & 3) + 8 * (i >> 2) + 4 * hi; const float v0 = acc0[i] * sc0, v1 = acc1[i] * sc1;
              const float n0 = xlane1(v0), n1 = xlane1(v1);
              if ((r32 & 1) == 0) { *(unsigned*)(op + (size_t)row * DM) = cvt_pk_bf16(v0, n0); *(unsigned*)(op + (size_t)row * DM + 32) = cvt_pk_bf16(v1, n1); } } }
        __syncthreads();
    }
}

__device__ __forceinline__ void hg_load16(const bf16_t* p, bf16_t (&z)[16]) {
#pragma unroll
    for (int j = 0; j < 16; ++j) z[j] = p[(size_t)j * DINP];
}
__device__ __forceinline__ void hg_gates(const bf16_t (&zr)[16], const float lb, LAS float* qs, int k, int q, float (&bc)[16], float (&kk)[16], float& blast, float& bmid) {
    const float omlb = 1.f - lb;
    float run = 0.f;
#pragma unroll
    for (int j = 0; j < 16; ++j) { const float z = bf2f(zr[j]);
        const float e = fast_exp(fminf(-z, 80.f)), sg = __builtin_amdgcn_rcpf(1.f + e);
        const float f = lb + omlb * sg; run += __builtin_amdgcn_logf(fmaxf(f, 1e-20f)) * 0.6931471805599453f; bc[j] = run; kk[j] = omlb * e * sg; }
    qs[q * 128 + k] = run;
    __syncthreads();
    const float s0 = qs[k], s1 = qs[128 + k], s2 = qs[256 + k], s3 = qs[384 + k];
    const float base = q == 0 ? 0.f : q == 1 ? s0 : q == 2 ? s0 + s1 : s0 + s1 + s2;
#pragma unroll
    for (int j = 0; j < 16; ++j) bc[j] += base;
    blast = (s0 + s1) + (s2 + s3); bmid = s0 + s1;
}
__device__ __forceinline__ f32x16 mfma32(bf16x8 a, bf16x8 b, f32x16 c) { return __builtin_amdgcn_mfma_f32_32x32x16_bf16(a, b, c, 0, 0, 0); }
constexpr int HG_PK = 136, HG_PS = 72;
#define HG_UNIT(u, b_, h_, tok0_) const int b_ = (u) >> 10, h_ = ((u) >> 8) & 3, tok0_ = b_ * SEQ + ((u) & 255) * 64
__device__ __forceinline__ void hgrn_local(const bf16_t* proj, const float* lbs_l, bf16_t* ubuf, float* dvec, LAS unsigned char* lds, int bx, int G, int tid, int wave, int lane) {
    LAS float* qs = (LAS float*)lds; LAS bf16_t* Kt = (LAS bf16_t*)(lds + 2048); LAS bf16_t* Vt = (LAS bf16_t*)(lds + 2048 + 128 * HG_PS * 2);
    const int k = tid & 127, q = tid >> 7, r32 = lane & 31, hi = lane >> 5, vs = tid >> 3, v0 = (tid & 7) * 8;
    bf16_t zc[16]; bf16x8 vc;
    if (bx < NUNIT) { HG_UNIT(bx, b, h, tok0); hg_load16(proj + (size_t)(tok0 + q * 16) * DINP + COL_HF + h * 128 + k, zc); vc = *(const bf16x8*)(proj + (size_t)(tok0 + vs) * DINP + COL_HI + h * 64 + v0); }
    for (int u = bx; u < NUNIT; u += G) {
        HG_UNIT(u, b, h, tok0); (void)b; (void)tok0;
        const float lb = lbs_l[h * 128 + k];
        bf16_t zn[16]; bf16x8 vn;
        { const int un = (u + G < NUNIT) ? u + G : u; HG_UNIT(un, bn, hn, tokn); (void)bn;
          hg_load16(proj + (size_t)(tokn + q * 16) * DINP + COL_HF + hn * 128 + k, zn); vn = *(const bf16x8*)(proj + (size_t)(tokn + vs) * DINP + COL_HI + hn * 64 + v0); }
        float bc[16], kk[16], blast, bmid;
        hg_gates(zc, lb, qs, k, q, bc, kk, blast, bmid);
        { unsigned w[8];
#pragma unroll
          for (int j = 0; j < 8; ++j) w[j] = cvt_pk_bf16(kk[2 * j] * fast_exp(blast - bc[2 * j]), kk[2 * j + 1] * fast_exp(blast - bc[2 * j + 1]));
          *(LAS u32x4*)(Kt + k * HG_PS + q * 16) = (u32x4){w[0], w[1], w[2], w[3]}; *(LAS u32x4*)(Kt + k * HG_PS + q * 16 + 8) = (u32x4){w[4], w[5], w[6], w[7]}; }
#pragma unroll
        for (int j = 0; j < 8; ++j) Vt[(v0 + j) * HG_PS + vs] = (bf16_t)vc[j];
        if (q == 0) dvec[(size_t)u * 128 + k] = fast_exp(blast);
        __syncthreads();
        { const int vb = wave >> 2, kb = wave & 3; f32x16 acc = {};
#pragma unroll
          for (int ks = 0; ks < 4; ++ks) { const bf16x8 af = *(const LAS bf16x8*)(Vt + (vb * 32 + r32) * HG_PS + ks * 16 + 8 * hi), bfr = *(const LAS bf16x8*)(Kt + (kb * 32 + r32) * HG_PS + ks * 16 + 8 * hi);
              acc = mfma32(af, bfr, acc); }
          bf16_t* up = ubuf + ((size_t)u * 64 + vb * 32) * 128 + kb * 32 + r32;
#pragma unroll
          for (int i = 0; i < 16; ++i) { const float vn = xlane1(acc[i]); if ((r32 & 1) == 0) *(unsigned*)(up + (size_t)((i & 3) + 8 * (i >> 2) + 4 * hi) * 128) = cvt_pk_bf16(acc[i], vn); } }
#pragma unroll
        for (int j = 0; j < 16; ++j) zc[j] = zn[j];
        vc = vn;
        __syncthreads();
    }
}
__device__ __forceinline__ void hgrn_scan(bf16_t* ubuf, const float* dvec, int bx, int G, int tid) {
    for (int j = (G >= 256 ? bx - (G - 128) : bx); j < 128; j += G) {
        if (j < 0 || tid >= 256) continue;
        const int bh = j >> 4, e = (j & 15) * 512 + tid * 2, k = e & 127;
        unsigned* up = (unsigned*)(ubuf + (size_t)bh * 256 * 8192 + e); const f32x2* dp = (const f32x2*)(dvec + (size_t)bh * 256 * 128 + k);
        float S0 = 0.f, S1 = 0.f;
        for (int c = 0; c < NCHUNK; c += 64) { unsigned uv[64]; f32x2 dv[64];
#pragma unroll
            for (int i = 0; i < 64; ++i) { uv[i] = up[(size_t)(c + i) * 4096]; dv[i] = dp[(size_t)(c + i) * 64]; }
#pragma unroll
            for (int i = 0; i < 64; ++i) { up[(size_t)(c + i) * 4096] = cvt_pk_bf16(S0, S1); S0 = dv[i][0] * S0 + __uint_as_float(uv[i] << 16); S1 = dv[i][1] * S1 + __uint_as_float(uv[i] & 0xffff0000u); } }
    }
}
__device__ __forceinline__ void hgrn_out(const bf16_t* proj, const float* lbs_l, const bf16_t* ubuf, const float* onorm, bf16_t* ocat, LAS unsigned char* lds, int bx, int G, int tid, int wave, int lane) {
    LAS float* qs = (LAS float*)lds;
    LAS bf16_t* Qi = (LAS bf16_t*)(lds + 2048); LAS bf16_t* Qp = Qi + 64 * HG_PK; LAS bf16_t* Kp = Qp + 64 * HG_PK; LAS bf16_t* St = Kp + 64 * HG_PK;
    LAS bf16_t* Vt = St + 64 * HG_PK; LAS bf16_t* Aq = Vt + 64 * HG_PS; LAS float* Ol = (LAS float*)(Aq + 64 * HG_PS);
    const int k = tid & 127, q = tid >> 7, r32 = lane & 31, hi = lane >> 5, vs = tid >> 3, v0 = (tid & 7) * 8, k0 = (tid & 7) * 16;
    bf16_t zc[16], qc[16]; bf16x8 vc;
    if (bx < NUNIT) { HG_UNIT(bx, b, h, tok0); hg_load16(proj + (size_t)(tok0 + q * 16) * DINP + COL_HF + h * 128 + k, zc); hg_load16(proj + (size_t)(tok0 + q * 16) * DINP + COL_HQ + h * 128 + k, qc);
        vc = *(const bf16x8*)(proj + (size_t)(tok0 + vs) * DINP + COL_HI + h * 64 + v0); }
    for (int u = bx; u < NUNIT; u += G) {
        HG_UNIT(u, b, h, tok0); (void)b;
        const float lb = lbs_l[h * 128 + k];
        const bf16_t* sp = ubuf + ((size_t)u * 64 + vs) * 128 + k0;
        const u32x4 a0 = *(const u32x4*)sp, a1 = *(const u32x4*)(sp + 8);
        const bf16x8 gg = *(const bf16x8*)(proj + (size_t)(tok0 + vs) * DINP + COL_HG + h * 64 + v0);
        bf16_t zn[16], qn[16]; bf16x8 vn;
        { const int un = (u + G < NUNIT) ? u + G : u; HG_UNIT(un, bn, hn, tokn); (void)bn;
          hg_load16(proj + (size_t)(tokn + q * 16) * DINP + COL_HF + hn * 128 + k, zn); hg_load16(proj + (size_t)(tokn + q * 16) * DINP + COL_HQ + hn * 128 + k, qn);
          vn = *(const bf16x8*)(proj + (size_t)(tokn + vs) * DINP + COL_HI + hn * 64 + v0); }
        float bc[16], kk[16], blast, bmid;
        hg_gates(zc, lb, qs, k, q, bc, kk, blast, bmid);
#pragma unroll
        for (int j = 0; j < 16; ++j) { const int t = q * 16 + j; const float qr = bf2f(qc[j]); const float qf = qr * sigmoidf_(qr);
            Qi[t * HG_PK + k] = f2bf(qf * fast_exp(bc[j])); Qp[t * HG_PK + k] = f2bf(qf * fast_exp(bc[j] - bmid)); Kp[t * HG_PK + k] = f2bf(kk[j] * fast_exp(bmid - bc[j])); }
        *(LAS u32x4*)(St + vs * HG_PK + k0) = a0;
        *(LAS u32x4*)(St + vs * HG_PK + k0 + 8) = a1;
#pragma unroll
        for (int j = 0; j < 8; ++j) Vt[(v0 + j) * HG_PS + vs] = (bf16_t)vc[j];
        __syncthreads();
        f32x16 oacc = {};
        const int tb = (wave >> 1) & 1, vb = wave & 1;
        if (wave < 4) {
#pragma unroll
            for (int kc = 0; kc < 8; ++kc) { const bf16x8 af = *(const LAS bf16x8*)(Qi + (tb * 32 + r32) * HG_PK + kc * 16 + 8 * hi), bfr = *(const LAS bf16x8*)(St + (vb * 32 + r32) * HG_PK + kc * 16 + 8 * hi);
                oacc = mfma32(af, bfr, oacc); }
        } else if (wave < 7) {
            const int tb2 = wave == 4 ? 0 : 1, sb = wave == 6 ? 1 : 0; f32x16 sacc = {};
#pragma unroll
            for (int kc = 0; kc < 8; ++kc) { const bf16x8 af = *(const LAS bf16x8*)(Qp + (tb2 * 32 + r32) * HG_PK + kc * 16 + 8 * hi), bfr = *(const LAS bf16x8*)(Kp + (sb * 32 + r32) * HG_PK + kc * 16 + 8 * hi);
                sacc = mfma32(af, bfr, sacc); }
#pragma unroll
            for (int i = 0; i < 16; ++i) { const int t = tb2 * 32 + (i & 3) + 8 * (i >> 2) + 4 * hi, s = sb * 32 + r32; Aq[t * HG_PS + s] = (s <= t) ? f2bf(sacc[i]) : (bf16_t)0; }
        }
        __syncthreads();
        if (wave < 4) {
            const int nks = tb == 0 ? 2 : 4;
            for (int ks = 0; ks < nks; ++ks) { const bf16x8 af = *(const LAS bf16x8*)(Aq + (tb * 32 + r32) * HG_PS + ks * 16 + 8 * hi), bfr = *(const LAS bf16x8*)(Vt + (vb * 32 + r32) * HG_PS + ks * 16 + 8 * hi);
                oacc = mfma32(af, bfr, oacc); }
#pragma unroll
            for (int i = 0; i < 16; ++i) Ol[(tb * 32 + (i & 3) + 8 * (i >> 2) + 4 * hi) * 68 + vb * 32 + r32] = oacc[i];
        }
        __syncthreads();
        { const int t = vs; const LAS f32x4* op = (const LAS f32x4*)(Ol + t * 68 + v0); const f32x4 o0 = op[0], o1 = op[1];
          float ss = (o0[0] * o0[0] + o0[1] * o0[1]) + (o0[2] * o0[2] + o0[3] * o0[3]) + (o1[0] * o1[0] + o1[1] * o1[1]) + (o1[2] * o1[2] + o1[3] * o1[3]);
          ss = sum8(ss);
          const float rstd = 1.0f / sqrtf(ss * (1.f / 64.f) + EPS);
          const f32x4 n0 = *(const f32x4*)(onorm + h * 64 + v0), n1 = *(const f32x4*)(onorm + h * 64 + v0 + 4);
          float r[8];
#pragma unroll
          for (int j = 0; j < 8; ++j) { const float gv = bf2f((bf16_t)gg[j]); const float ov = j < 4 ? o0[j] : o1[j - 4]; const float nv = j < 4 ? n0[j] : n1[j - 4]; r[j] = ov * rstd * nv * (gv * sigmoidf_(gv)); }
          *(u32x4*)(ocat + (size_t)(tok0 + t) * DM + h * 64 + v0) = (u32x4){cvt_pk_bf16(r[0], r[1]), cvt_pk_bf16(r[2], r[3]), cvt_pk_bf16(r[4], r[5]), cvt_pk_bf16(r[6], r[7])}; }
#pragma unroll
        for (int j = 0; j < 16; ++j) { zc[j] = zn[j]; qc[j] = qn[j]; }
        vc = vn;
        __syncthreads();
    }
}

typedef const Args __attribute__((address_space(4))) * KArgsPtr;
#ifndef ONLY_KIND
#define ONLY_KIND -1
#endif
#ifndef KIND_MASK
#define KIND_MASK 0xFFFFFFFFu
#endif
#define KIND(k) ((ONLY_KIND < 0 || ONLY_KIND == (k)) && ((KIND_MASK >> (k)) & 1u))
#define IN(k) (lo <= (k) && (k) < hi)
#ifndef REPEAT_KIND
#define REPEAT_KIND -1
#endif
#ifndef REPEAT_N
#define REPEAT_N 3
#endif
#define REP(k) for (int rep_ = 0; rep_ < ((REPEAT_KIND) == (k) ? REPEAT_N : 1); ++rep_)
#define SEAM(k) do { if (MK_ONE_LAUNCH && IN(k) && IN((k) + 1)) xcd_barrier(bar, (wave_s * 64 + (int)__builtin_amdgcn_mbcnt_hi(~0u, __builtin_amdgcn_mbcnt_lo(~0u, 0u))) == 0); } while (0)
#define PH_BEGIN() int tid = wave_s * 64 + (int)__builtin_amdgcn_mbcnt_hi(~0u, __builtin_amdgcn_mbcnt_lo(~0u, 0u)); asm volatile("" : "+v"(tid)); const int lane = tid & 63, wave = __builtin_amdgcn_readfirstlane(tid >> 6), gw = bx * NWAVES + wave, gt = bx * (NWAVES * 64) + tid; \
    (void)lane; (void)wave; (void)gw; (void)gt; KArgsPtr ap = (KArgsPtr)__builtin_amdgcn_kernarg_segment_ptr(); asm volatile("" : "+s"(ap)); unsigned char* const ws = ap->ws; (void)ws

template <int l>
__device__ __forceinline__ void layer_body(LAS unsigned char* L, unsigned char* lds, const int lo, const int hi, const XcdBarrier& bar, const int G, const int bx, const int NGW, const int NGT, const int wave_s) {
    constexpr int pb = l == 0 ? 1 : 10;
        if (KIND(1) && IN(l == 0 ? 0 : pb + 0)) REP(1) { PH_BEGIN(); if constexpr (l == 0) norm_to_bf16<false>(ap->in[I_X], nullptr, nullptr, ap->in[I_ATTN_NORM], (bf16_t*)(ws + WS_HN), gw, NGW, lane); }
        if constexpr (l == 0) SEAM(0);
        if (KIND(2) && IN(pb + 1)) REP(2) { PH_BEGIN(); pg8::DenseSched S; S.init(T, DINP, DM, (const bf16_t*)(ws + WS_WIN) + (size_t)l * DINP * DM, G, bx); pg8::EpiBf16 E{(bf16_t*)(ws + WS_PROJ), DINP};
            pg8::gemm_phase<pg8::EpiBf16, pg8::DenseSched, true>(L, (const bf16_t*)(ws + WS_HN), DM, DM, S, E, tid); }
        SEAM(pb + 1);
        if (KIND(3) && IN(pb + 2)) REP(3) {
            { PH_BEGIN(); prep_tokens((const bf16_t*)(ws + WS_PROJ), ap->in[I_KV_NORM] + l * 128, (const float*)(ws + WS_COS), (const float*)(ws + WS_SIN), (float*)(ws + WS_RSTDQ), (bf16_t*)(ws + WS_KLAT), (bf16_t*)(ws + WS_KROPE), gw, NGW, lane); }
            { PH_BEGIN(); pool_phase((const bf16_t*)(ws + WS_PROJ), ap->in[I_POOL_W] + (size_t)l * 4 * 64 * 64, ap->in[I_POOL_SCALE] + l * 256, (bf16_t*)(ws + WS_OCAT), L, bx, G, tid); }
            { PH_BEGIN(); hgrn_local((const bf16_t*)(ws + WS_PROJ), (const float*)(ws + WS_LBS) + l * 512, (bf16_t*)(ws + WS_UBUF), (float*)(ws + WS_DVEC), L, bx, G, tid, wave, lane); }
        }
        SEAM(pb + 2);
        if ((KIND(4) || KIND(16)) && IN(pb + 3)) {
            if (KIND(16)) { PH_BEGIN(); hgrn_scan((bf16_t*)(ws + WS_UBUF), (const float*)(ws + WS_DVEC), bx, G, tid); }
            if (KIND(4)) REP(4) { PH_BEGIN(); pg8::DenseSched S; S.init(T, QW, 256, (const bf16_t*)(ws + WS_WQ) + (size_t)l * QW * 256, G, bx);
                pg8::EpiQ E{(bf16_t*)(ws + WS_Q), (const float*)(ws + WS_RSTDQ), (const float*)(ws + WS_COS), (const float*)(ws + WS_SIN)};
                pg8::gemm_phase<pg8::EpiQ, pg8::DenseSched, true>(L, (const bf16_t*)(ws + WS_PROJ) + COL_CQ, DINP, 256, S, E, tid); }
        }
        SEAM(pb + 3);
        if ((KIND(5) || KIND(15)) && IN(pb + 4)) {
            if (KIND(15)) REP(15) { PH_BEGIN(); hgrn_out((const bf16_t*)(ws + WS_PROJ), (const float*)(ws + WS_LBS) + l * 512, (const bf16_t*)(ws + WS_UBUF), ap->in[I_OUT_NORM] + l * 256, (bf16_t*)(ws + WS_OCAT), L, bx, G, tid, wave, lane); }
            if (KIND(5)) REP(5) { PH_BEGIN();
                for (int item = bx; item < 8 * 32; item += G)
                    for (int ps = 0; ps < 2; ++ps) { const int b = item & 1, h = (item >> 1) & 3, x = item >> 3, qb = ps ? x : 63 - x; att::BlockRef r;
                        r.Q = (const bf16_t*)(ws + WS_Q) + ((size_t)b * SEQ + (size_t)qb * 256) * QW + h * 192; r.Kl = (const bf16_t*)(ws + WS_KLAT) + (size_t)b * SEQ * 128; r.Kr = (const bf16_t*)(ws + WS_KROPE) + (size_t)b * SEQ * 64;
                        r.O = (bf16_t*)(ws + WS_OCAT) + ((size_t)b * SEQ + (size_t)qb * 256) * DM + 256 + h * 128; r.P0 = qb * 256;
                        att::attn_block<0>(r, (char*)lds, tid); }
#if defined(PROBE_ATT_VAR)
                for (int item = bx; item < 8 * 32; item += G)
                    for (int ps = 0; ps < 2; ++ps) { const int bh = item >> 5, x = item & 31, qb = ps ? 63 - x : x, b = bh >> 2, h = bh & 3; att::BlockRef r;
                        r.Q = (const bf16_t*)(ws + WS_Q) + ((size_t)b * SEQ + (size_t)qb * 256) * QW + h * 192; r.Kl = (const bf16_t*)(ws + WS_KLAT) + (size_t)b * SEQ * 128; r.Kr = (const bf16_t*)(ws + WS_KROPE) + (size_t)b * SEQ * 64;
                        r.O = (bf16_t*)(ws + WS_UBUF) + ((size_t)b * SEQ + (size_t)qb * 256) * DM + 256 + h * 128; r.P0 = qb * 256;
                        att::attn_block<PROBE_ATT_VAR>(r, (char*)lds, tid); }
#endif
            }
        }
        SEAM(pb + 4);
        if constexpr (l == 0) {
            if (KIND(6) && IN(pb + 5)) { PH_BEGIN();
                pg8::EpiRmsRes<true> E{(const void*)ap->in[I_X], (bf16_t*)ap->out, (bf16_t*)(ws + WS_HN), ap->in[I_FFN_NORM], (float*)((char*)ap->out + (size_t)T * DM * 2), (unsigned*)(ws + WS_CTL + CW_FUSE_BYTES) + 8192, L + pg8::STAGE_BYTES};
                { pg8::DenseSched S; S.init(T, DM, DM, (const bf16_t*)(ws + WS_WO), G, bx); pg8::gemm_phase<pg8::EpiRmsRes<true>, pg8::DenseSched, true>(L, (const bf16_t*)(ws + WS_OCAT), DM, DM, S, E, tid); } }
        } else {
            if (KIND(6) && IN(pb + 5)) { PH_BEGIN();
                pg8::EpiRmsRes<false> E{(const void*)ap->out, (bf16_t*)ap->out, (bf16_t*)(ws + WS_HN), ap->in[I_FFN_NORM] + DM, (float*)((char*)ap->out + (size_t)T * DM * 2), (unsigned*)(ws + WS_CTL + CW_FUSE_BYTES) + 16384, L + pg8::STAGE_BYTES};
                { pg8::DenseSched S; S.init(T, DM, DM, (const bf16_t*)(ws + WS_WO) + (size_t)DM * DM, G, bx); pg8::gemm_phase<pg8::EpiRmsRes<false>, pg8::DenseSched, true>(L, (const bf16_t*)(ws + WS_OCAT), DM, DM, S, E, tid); } } }
        if (false) { PH_BEGIN(); pg8::DenseSched S; S.init(T, DM, DM, (const bf16_t*)(ws + WS_WO) + (size_t)l * DM * DM, G, bx); pg8::EpiBf16 E{(bf16_t*)(ws + WS_HN), DM};
            pg8::gemm_phase<pg8::EpiBf16, pg8::DenseSched, true>(L, (const bf16_t*)(ws + WS_OCAT), DM, DM, S, E, tid); }
        SEAM(pb + 5);
        if constexpr (l == 0) {
            if (KIND(8) && IN(8)) REP(8) { PH_BEGIN(); pg8::DenseSched S; S.init(T, 2 * DFF, DM, (const bf16_t*)(ws + WS_WGU), G, bx); pg8::EpiSwiGLU E{(bf16_t*)(ws + WS_ACTD), DFF};
                pg8::gemm_phase<pg8::EpiSwiGLU, pg8::DenseSched, true>(L, (const bf16_t*)(ws + WS_HN), DM, DM, S, E, tid); }
            SEAM(8);
            if (KIND(9) && IN(9)) { PH_BEGIN();
                pg8::EpiRmsRes<false> E{(const void*)ap->out, (bf16_t*)ap->out, (bf16_t*)(ws + WS_HN), ap->in[I_ATTN_NORM] + DM, (float*)((char*)ap->out + (size_t)T * DM * 2), (unsigned*)(ws + WS_CTL + CW_FUSE_BYTES), L + pg8::STAGE_BYTES};
                { pg8::DenseSched S; S.init(T, DM, DFF, (const bf16_t*)(ws + WS_WD), G, bx); pg8::gemm_phase<pg8::EpiRmsRes<false>, pg8::DenseSched, true>(L, (const bf16_t*)(ws + WS_ACTD), DFF, DFF, S, E, tid); } }
            SEAM(9);
        } else {
            if (KIND(10) && IN(16)) REP(10) {
                { PH_BEGIN(); norm_router<true>((bf16_t*)ap->out, (const bf16_t*)(ws + WS_HN), ap->in[I_FFN_NORM] + DM, ap->in[I_ROUTER], (bf16_t*)(ws + WS_HN), (int*)(ws + WS_TOKE), (float*)(ws + WS_TOKG), (int*)(ws + WS_CNT), L, bx, G, tid, wave, lane); }
                __syncthreads(); }
            SEAM(16);
            if (KIND(11) && IN(17)) REP(11) { PH_BEGIN(); route_tables((const int*)(ws + WS_TOKE), (const float*)(ws + WS_TOKG), (const int*)(ws + WS_CNT), (int*)(ws + WS_SLOTTOK), (float*)(ws + WS_SLOTG), (int*)(ws + WS_TILEE), L, bx, G, tid); }
            SEAM(17);
            for (int r = 0; r < 2; ++r) {
                if (KIND(12) && IN(18 + 2 * r)) REP(12) { PH_BEGIN(); pg8::MoeSched<true> S; S.init(2 * DFFE, DM, (const bf16_t*)(ws + WS_MOEW), MOEW_E, (const int*)(ws + WS_TILEE) + r * 256, (const int*)(ws + WS_SLOTTOK) + r * MOE_ROWS, G, bx);
                    pg8::EpiSwiGLU E{(bf16_t*)(ws + WS_ACTM), DFFE};
                    pg8::gemm_phase<pg8::EpiSwiGLU, pg8::MoeSched<true>, true>(L, (const bf16_t*)(ws + WS_HN), DM, DM, S, E, tid); }
                SEAM(18 + 2 * r);
                if (KIND(13) && IN(19 + 2 * r)) REP(13) { PH_BEGIN(); pg8::MoeDownSched S; S.init(DM, DFFE, (const bf16_t*)(ws + WS_MOEW) + (size_t)2 * DFFE * DM, MOEW_E, (const int*)(ws + WS_TILEE) + r * 256, G, bx);
                    pg8::EpiMoeDownB E{(const bf16_t*)ap->out, r == 0 ? (bf16_t*)ap->out : (bf16_t*)(ws + WS_HN), (const int*)(ws + WS_SLOTTOK) + r * MOE_ROWS, (const float*)(ws + WS_SLOTG) + r * MOE_ROWS,
                                       (f32x4*)((char*)ap->out + (size_t)T * DM * 2), (unsigned*)(ws + WS_CTL + CW_SPLIT_BYTES) + r * 64};
                    pg8::gemm_phase<pg8::EpiMoeDownB, pg8::MoeDownSched, true>(L, (const bf16_t*)(ws + WS_ACTM), DFFE, DFFE, S, E, tid);
                    moe_down_fixup(S, E, tid); }
                SEAM(19 + 2 * r);
            }
        }
}

__global__ void __launch_bounds__(NWAVES * 64, 2) trunk_fwd(Args args_unused) {
    extern __shared__ __attribute__((aligned(16))) unsigned char lds[];
    LAS unsigned char* L = (LAS unsigned char*)lds;
    const int G = gridDim.x, bx = blockIdx.x, NGW = G * NWAVES, NGT = G * NWAVES * 64;
    const int wave_s = __builtin_amdgcn_readfirstlane((int)threadIdx.x >> 6);
    for (int u = threadIdx.x; u < (LDS_BYTES - RING_BYTES) / 4; u += NWAVES * 64) ((LAS unsigned*)(L + RING_BYTES))[u] = 0u;
    __syncthreads();
    int lo, hi; XcdBarrier bar;
    { KArgsPtr ap0 = (KArgsPtr)__builtin_amdgcn_kernarg_segment_ptr(); lo = ap0->ph_lo; hi = ap0->ph_hi;
      bar.bar = (unsigned*)(ap0->ws + WS_CTL) + CW_BAR; bar.x = 0; bar.st = nullptr;
      if (MK_ONE_LAUNCH) bar = xcd_barrier_post((unsigned*)(ap0->ws + WS_CTL) + CW_BAR, (volatile LAS unsigned*)(L + MISC_OFF) + 8); }
    if (KIND(0) && IN(0)) REP(0) { PH_BEGIN();
        if (wave < 4) p0_stream(ap, L, bx * 4 + wave, G * 4, wave, lane);
        else p0_prologue(ap, L, 0, 1, bx * 256 + (tid - 256), G * 256, wave, lane, 1); }

    layer_body<0>(L, lds, lo, hi, bar, G, bx, NGW, NGT, wave_s);
    layer_body<1>(L, lds, lo, hi, bar, G, bx, NGW, NGT, wave_s);
    if (KIND(14) && IN(22)) REP(14) { PH_BEGIN(); norm_final((const bf16_t*)(ws + WS_HN), ap->out, ap->in[I_FINAL_NORM], gw, NGW, lane); }
#undef IN
#undef SEAM
}

extern "C" void kernel_launch(void* const* d_in, const int* in_sizes, int n_in, void* d_out, int out_size, void* d_ws, size_t ws_size, hipStream_t stream) {
    static int grid = 0;
    if (grid == 0) {
        if (n_in != 21 || in_sizes[0] != T * DM || out_size != T * DM || ws_size < WS_END) {
            fprintf(stderr, "kernel_launch: unexpected shapes (n_in %d, in0 %d, out %d, ws %zu, need %zu); nothing launched\n", n_in, n_in > 0 ? in_sizes[0] : -1, out_size, ws_size, (size_t)WS_END); grid = -1; return; }
        int dev = 0, cus = 0, per_cu = 0;
        if (hipGetDevice(&dev) != hipSuccess || hipDeviceGetAttribute(&cus, hipDeviceAttributeMultiprocessorCount, dev) != hipSuccess) { grid = -1; return; }
        if (hipFuncSetAttribute((const void*)trunk_fwd, hipFuncAttributeMaxDynamicSharedMemorySize, LDS_BYTES) != hipSuccess) { fprintf(stderr, "kernel_launch: hipFuncSetAttribute failed\n"); grid = -1; return; }
        if (hipOccupancyMaxActiveBlocksPerMultiprocessor(&per_cu, (const void*)trunk_fwd, NWAVES * 64, LDS_BYTES) != hipSuccess || per_cu < 1)
            fprintf(stderr, "kernel_launch: note: occupancy query reports %d workgroups per CU\n", per_cu);
        (void)hipGetLastError();
        grid = cus;
    }
    if (grid < 0) return;
    (void)hipMemsetAsync((char*)d_ws + WS_CTL, 0, CTL_ZERO_BYTES, stream);
    Args a{};
    for (int i = 0; i < 21; ++i) a.in[i] = (const float*)d_in[i];
    a.out = (float*)d_out; a.ws = (unsigned char*)d_ws;
#if MK_ONE_LAUNCH
    a.ph_lo = 0; a.ph_hi = NPH;
    hipLaunchKernelGGL(trunk_fwd, dim3(grid), dim3(NWAVES * 64), LDS_BYTES, stream, a);
#else
    for (int p = 0; p < NPH; ++p) { a.ph_lo = p; a.ph_hi = p + 1; hipLaunchKernelGGL(trunk_fwd, dim3(grid), dim3(NWAVES * 64), LDS_BYTES, stream, a); }
#endif
}
```

```cpp
#include <hip/hip_runtime.h>
#include <cstdio>
#include <cstdint>

#ifndef MK_ONE_LAUNCH
#define MK_ONE_LAUNCH 1
#endif

#define LAS __attribute__((address_space(3)))
#define GAS __attribute__((address_space(1)))
typedef unsigned short bf16_t;
typedef short bf16x8 __attribute__((ext_vector_type(8)));
typedef short s16x4 __attribute__((ext_vector_type(4)));
typedef float f32x2 __attribute__((ext_vector_type(2)));
typedef float f32x4 __attribute__((ext_vector_type(4)));
typedef float f32x16 __attribute__((ext_vector_type(16)));
typedef unsigned u32x2 __attribute__((ext_vector_type(2)));
typedef unsigned u32x4 __attribute__((ext_vector_type(4)));

constexpr int BATCH = 2, SEQ = 16384, T = BATCH * SEQ, DM = 1024, DIN = 2240, DINP = 2304;
constexpr int HG_H = 4, HG_DK = 128, HG_DV = 64, HG_C = 64, NCHUNK = SEQ / HG_C, NUNIT = BATCH * HG_H * NCHUNK;
constexpr int COL_HQ = 0, COL_HF = 512, COL_HI = 1024, COL_HG = 1280, COL_CQ = 1536, COL_CKV = 1792, COL_KPE = 1920, COL_XP = 1984;
constexpr int QW = 768;
constexpr int DFF = 2560, NE = 8, DFFE = 3584;
constexpr float EPS = 1e-6f;
constexpr int MOE_ROWS = T + NE * 256;
constexpr int MOE_MAXT = MOE_ROWS / 256;

constexpr size_t MiB = 1u << 20;
constexpr size_t WS_CTL = 0, CTL_ZERO_BYTES = 1 * MiB;
constexpr size_t WS_LBS = 1 * MiB;
constexpr size_t WS_RSTDQ = WS_LBS + 64 * 1024;
constexpr size_t WS_DVEC = WS_RSTDQ + (size_t)T * 4;
constexpr size_t WS_COS = WS_DVEC + (size_t)NUNIT * 128 * 4;
constexpr size_t WS_SIN = WS_COS + (size_t)SEQ * 32 * 4;
constexpr size_t WS_TOKE = WS_SIN + (size_t)SEQ * 32 * 4;
constexpr size_t WS_TOKG = WS_TOKE + (size_t)T * 2 * 4;
constexpr size_t WS_CNT = WS_TOKG + (size_t)T * 2 * 4;
constexpr size_t WS_SLOTTOK = WS_CNT + 256 * 16 * 4;
constexpr size_t WS_SLOTG = WS_SLOTTOK + (size_t)2 * MOE_ROWS * 4;
constexpr size_t WS_TILEE = WS_SLOTG + (size_t)2 * MOE_ROWS * 4;
constexpr size_t WS_WIN = 8 * MiB;
constexpr size_t WS_WQ = WS_WIN + (size_t)2 * DINP * DM * 2;
constexpr size_t WS_WO = WS_WQ + (size_t)2 * QW * 256 * 2;
constexpr size_t WS_WGU = WS_WO + (size_t)2 * DM * DM * 2;
constexpr size_t WS_WD = WS_WGU + (size_t)2 * DFF * DM * 2;
constexpr size_t WS_SMALL_END = WS_WD + (size_t)DM * DFF * 2;
constexpr size_t WS_ACT0 = 40 * MiB;
static_assert(WS_TILEE + 2 * 256 * 4 <= WS_WIN && WS_SMALL_END <= WS_ACT0, "small region");
constexpr size_t WS_HN = WS_ACT0;
constexpr size_t WS_Q = WS_ACT0;
constexpr size_t WS_KLAT = WS_ACT0 + 48 * MiB;
constexpr size_t WS_KROPE = WS_ACT0 + 56 * MiB;
constexpr size_t WS_PROJ = WS_ACT0 + 64 * MiB;
constexpr size_t WS_UBUF = WS_PROJ + 144 * MiB;
constexpr size_t WS_OCAT = WS_UBUF + 32 * MiB;
constexpr size_t WS_MIX_END = WS_OCAT + 64 * MiB;
constexpr size_t WS_ACTD = WS_PROJ;
constexpr size_t WS_MOEW = WS_MIX_END;
constexpr size_t MOEW_E = (size_t)(2 * DFFE * DM + DM * DFFE);
constexpr size_t WS_ACTM = WS_PROJ;
constexpr size_t WS_END = WS_MOEW + (size_t)NE * MOEW_E * 2;
static_assert(WS_END <= 512 * MiB && WS_ACTM + (size_t)MOE_ROWS * DFFE * 2 <= WS_MOEW, "workspace");

constexpr int CW_TMO = 0, CW_BAR = 4096; constexpr size_t CW_FUSE_BYTES = 576 * 1024;
constexpr size_t CW_SPLIT_BYTES = 512 * 1024;

__device__ __forceinline__ float bf2f(bf16_t v) { return __uint_as_float((unsigned)v << 16); }
typedef __bf16 bf16n2 __attribute__((ext_vector_type(2)));
typedef float f32n2 __attribute__((ext_vector_type(2)));
__device__ __forceinline__ unsigned cvt_pk_bf16(float lo, float hi) { const f32n2 v = {lo, hi}; return __builtin_bit_cast(unsigned, __builtin_convertvector(v, bf16n2)); }
__device__ __forceinline__ bf16_t f2bf(float f) { return __builtin_bit_cast(unsigned short, (__bf16)f); }
template <int CTRL> __device__ __forceinline__ float dppf(float v) { return __int_as_float(__builtin_amdgcn_update_dpp(0, __float_as_int(v), CTRL, 0xf, 0xf, true)); }
__device__ __forceinline__ float xlane1(float v) { return dppf<0xB1>(v); }
__device__ __forceinline__ float sum8(float v) { v += dppf<0xB1>(v); v += dppf<0x4E>(v); v += dppf<0x141>(v); return v; }
__device__ __forceinline__ float wave_sum(float v) {
    v = sum8(v); v += dppf<0x140>(v);
    const float r0 = __int_as_float(__builtin_amdgcn_readlane(__float_as_int(v), 0)), r1 = __int_as_float(__builtin_amdgcn_readlane(__float_as_int(v), 16));
    const float r2 = __int_as_float(__builtin_amdgcn_readlane(__float_as_int(v), 32)), r3 = __int_as_float(__builtin_amdgcn_readlane(__float_as_int(v), 48));
    return (r0 + r1) + (r2 + r3);
}
__device__ __forceinline__ float fast_exp(float x) { return __builtin_amdgcn_exp2f(x * 1.4426950408889634f); }
__device__ __forceinline__ float sigmoidf_(float x) { return __builtin_amdgcn_rcpf(1.f + fast_exp(-x)); }
#define LDS_WAIT() asm volatile("s_waitcnt lgkmcnt(0)" ::: "memory")
#define VM_WAIT() asm volatile("s_waitcnt vmcnt(0)" ::: "memory")

namespace pg8 {
constexpr int BM = 256, BK = 64, HALF = 128, HTB = HALF * BK * 2, STAGE_BYTES = 8 * HTB, NXCD = 8, WGM = 8;
__host__ __device__ __forceinline__ int lds_byte(int r, int c) { const int st = (r >> 4) * 2 + (c >> 5), rr = r & 15, cc = c & 31, ob = rr * 64 + cc * 2; return st * 1024 + (ob ^ (((ob >> 9) & 1) << 5)); }
__host__ __device__ __forceinline__ void stage_rc(int b, int& R, int& C) { const int st = b / 1024, sb = b % 1024, swz = sb ^ (((sb >> 9) & 1) << 5); R = (st >> 1) * 16 + swz / 64; C = (st & 1) * 32 + (swz % 64) / 2; }
__host__ __device__ __forceinline__ int perm32(int rho) { const int n = rho >> 4, i = rho & 15; return 8 * (i >> 2) + 4 * n + (i & 3); }

struct Unit { int pm, pn; int k0, nt, role, aux; };

struct OrderBase {
    int nM, nN, nwg, G, c;
    __device__ __forceinline__ void init_order(int nM_, int nN_, int G_, int c_) { nM = nM_; nN = nN_; nwg = nM * nN; G = G_; c = c_; }
    __device__ __forceinline__ void map(int L, Unit& u) const {
        int wgid = L; { const int q = nwg / NXCD, r = nwg % NXCD, xcd = wgid % NXCD, off = wgid / NXCD; wgid = (xcd < r ? xcd * (q + 1) : r * (q + 1) + (xcd - r) * q) + off; }
        const int nig = WGM * nN, gid = wgid / nig, fm = gid * WGM, gsz = (nM - fm) < WGM ? (nM - fm) : WGM;
        u.pm = fm + ((wgid % nig) % gsz); u.pn = (wgid % nig) / gsz;
    }
    __device__ __forceinline__ bool next(int i, Unit& u) const {
        const long L = (long)i * G + c; if (L >= nwg) return false;
        map((int)L, u); return true;
    }
};
struct DenseSched : OrderBase {
    static constexpr bool GATHER = false, SPLITK = false;
    const bf16_t* Bt; int K;
    __device__ __forceinline__ void init(int M, int N, int K_, const bf16_t* Bt_, int G_, int c_) { init_order(M / BM, N / BM, G_, c_); Bt = Bt_; K = K_; }
    __device__ __forceinline__ int arow(const Unit& u, int r) const { return u.pm * BM + r; }
    __device__ __forceinline__ const char* bptr(const Unit& u) const { return (const char*)Bt + (size_t)u.pn * BM * K * 2; }
};
struct SliceSched : OrderBase {
    static constexpr bool GATHER = false, SPLITK = false;
    const bf16_t* Bt; int K, slice;
    __device__ __forceinline__ void init(int M, int N, int K_, const bf16_t* Bt_, int G_, int c_, int slice_) { init_order(M / BM, N / BM, G_, c_); Bt = Bt_; K = K_; slice = slice_; }
    __device__ __forceinline__ bool next(int i, Unit& u) const { const long L = (long)slice * G + c; if (i != 0 || L >= nwg) return false; map((int)L, u); return true; }
    __device__ __forceinline__ int arow(const Unit& u, int r) const { return u.pm * BM + r; }
    __device__ __forceinline__ const char* bptr(const Unit& u) const { return (const char*)Bt + (size_t)u.pn * BM * K * 2; }
};
template <bool GATHER_> struct MoeSched : OrderBase {
    static constexpr bool GATHER = GATHER_, SPLITK = false;
    const bf16_t* W; size_t wstride; int K; const int* tile_e; const int* slot_tok;
    __device__ __forceinline__ void init(int N, int K_, const bf16_t* W_, size_t wstride_, const int* tile_e_, const int* slot_tok_, int G_, int c_) {
        tile_e = tile_e_; slot_tok = slot_tok_; W = W_; wstride = wstride_; K = K_; init_order(tile_e_[0], N / BM, G_, c_); }
    __device__ __forceinline__ int arow(const Unit& u, int r) const { if (GATHER) { const int t = slot_tok[u.pm * BM + r]; return t < 0 ? 0 : t; } return u.pm * BM + r; }
    __device__ __forceinline__ const char* bptr(const Unit& u) const { return (const char*)(W + (size_t)tile_e[1 + u.pm] * wstride) + (size_t)u.pn * BM * K * 2; }
};

constexpr int KCH = 7;
struct MoeDownSched : OrderBase {
    static constexpr bool GATHER = false, SPLITK = true;
    const bf16_t* W; size_t wstride; int K; const int* tile_e; int nfullu, nleft, nchunk;
    __device__ __forceinline__ void init(int N, int K_, const bf16_t* W_, size_t wstride_, const int* tile_e_, int G_, int c_) {
        tile_e = tile_e_; W = W_; wstride = wstride_; K = K_; init_order(tile_e_[0], N / BM, G_, c_);
        nfullu = (nwg / G) * G; nleft = nwg - nfullu; nchunk = nleft * KCH;
        if (nchunk > G) { nfullu = nwg; nleft = 0; nchunk = 0; } }
    __device__ __forceinline__ bool next(int i, Unit& u) const {
        const long L = (long)i * G + c;
        if (L < nfullu) { map((int)L, u); u.k0 = 0; u.nt = K / BK; u.role = 0; u.aux = 0; return true; }
        if (i == nfullu / G && c < nchunk) { const int lu = c / KCH, kc = c - lu * KCH; map(nfullu + lu, u); u.k0 = kc * (K / KCH); u.nt = (K / KCH) / BK; u.role = 1; u.aux = c; return true; }
        return false; }
    __device__ __forceinline__ int arow(const Unit& u, int r) const { return u.pm * BM + r; }
    __device__ __forceinline__ const char* bptr(const Unit& u) const { return (const char*)(W + (size_t)tile_e[1 + u.pm] * wstride) + (size_t)u.pn * BM * K * 2; }
};

struct EpiBf16 {
    static constexpr bool PERM = true;
    bf16_t* O; int ldc;
    __device__ __forceinline__ void operator()(const f32x4 (&acc)[2][2][4][2], const Unit& u, int wr, int wc, int fr, int fq) const {
        const int row0 = u.pm * BM + wr * 64 + fr, col0 = u.pn * BM + wc * 32 + 8 * fq;
#pragma unroll
        for (int ai = 0; ai < 2; ++ai)
#pragma unroll
            for (int m = 0; m < 4; ++m) { bf16_t* rowp = O + (size_t)(row0 + ai * HALF + m * 16) * ldc + col0;
#pragma unroll
                for (int bj = 0; bj < 2; ++bj) { const f32x4 v0 = acc[ai][bj][m][0], v1 = acc[ai][bj][m][1];
                    u32x4 w; w.x = cvt_pk_bf16(v0[0], v0[1]); w.y = cvt_pk_bf16(v0[2], v0[3]); w.z = cvt_pk_bf16(v1[0], v1[1]); w.w = cvt_pk_bf16(v1[2], v1[3]);
                    *(u32x4*)(rowp + bj * HALF) = w; } }
    }
};
template <bool XF32>
struct EpiRmsRes {
    static constexpr bool PERM = true;
    const void* xs; bf16_t* xd; bf16_t* hn; const float* g; float* slots; unsigned* cnt; LAS unsigned char* tab;
    __device__ __forceinline__ void operator()(const f32x4 (&acc)[2][2][4][2], const Unit& u, int wr, int wc, int fr, int fq) const {
        LAS float* P = (LAS float*)tab;
        LAS float* S = (LAS float*)(tab + 16384);
        const int col0 = u.pn * BM + wc * 32 + 8 * fq, rl0 = wr * 64 + fr, lane = fq * 16 + fr, wid = wr * 4 + wc, tid = wid * 64 + lane;
        f32x4 v[2][2][4][2];
#pragma unroll
        for (int ai = 0; ai < 2; ++ai) {
            u32x4 rr[4][2]; f32x4 rf[XF32 ? 4 : 1][2][2];
#pragma unroll
            for (int m = 0; m < 4; ++m) { const size_t off = (size_t)(u.pm * BM + ai * HALF + rl0 + m * 16) * DM + col0;
                if constexpr (XF32) { const float* xp = (const float*)xs + off;
#pragma unroll
                    for (int bj = 0; bj < 2; ++bj) { rf[m][bj][0] = *(const f32x4*)(xp + bj * HALF); rf[m][bj][1] = *(const f32x4*)(xp + bj * HALF + 4); } }
                else { rr[m][0] = *(const u32x4*)((const bf16_t*)xs + off); rr[m][1] = *(const u32x4*)((const bf16_t*)xs + off + HALF); } }
#pragma unroll
            for (int m = 0; m < 4; ++m) { float sq = 0.f;
#pragma unroll
                for (int bj = 0; bj < 2; ++bj) { f32x4 a0 = acc[ai][bj][m][0], a1 = acc[ai][bj][m][1];
                    if constexpr (XF32) { a0 += rf[m][bj][0]; a1 += rf[m][bj][1]; }
                    else { const u32x4 r = rr[m][bj];
                        a0[0] += __uint_as_float(r.x << 16); a0[1] += __uint_as_float(r.x & 0xffff0000u); a0[2] += __uint_as_float(r.y << 16); a0[3] += __uint_as_float(r.y & 0xffff0000u);
                        a1[0] += __uint_as_float(r.z << 16); a1[1] += __uint_as_float(r.z & 0xffff0000u); a1[2] += __uint_as_float(r.w << 16); a1[3] += __uint_as_float(r.w & 0xffff0000u); }
                    v[ai][bj][m][0] = a0; v[ai][bj][m][1] = a1;
                    sq += ((a0[0] * a0[0] + a0[1] * a0[1]) + (a0[2] * a0[2] + a0[3] * a0[3])) + ((a1[0] * a1[0] + a1[1] * a1[1]) + (a1[2] * a1[2] + a1[3] * a1[3])); }
                P[(ai * HALF + rl0 + m * 16) * 16 + wc * 4 + fq] = sq; } }
        asm volatile("s_waitcnt lgkmcnt(0)" ::: "memory"); __builtin_amdgcn_s_barrier(); asm volatile("" ::: "memory");
        if (tid < 256) { const LAS f32x4* pp = (const LAS f32x4*)(P + tid * 16); const f32x4 p0 = pp[0], p1 = pp[1], p2 = pp[2], p3 = pp[3];
            const float tot = (((p0[0] + p0[1]) + (p0[2] + p0[3])) + ((p1[0] + p1[1]) + (p1[2] + p1[3]))) + (((p2[0] + p2[1]) + (p2[2] + p2[3])) + ((p3[0] + p3[1]) + (p3[2] + p3[3])));
            __hip_atomic_store(slots + ((size_t)(u.pm * BM + tid) * 4 + u.pn), tot, __ATOMIC_RELAXED, __HIP_MEMORY_SCOPE_AGENT); }
        asm volatile("s_waitcnt vmcnt(0)" ::: "memory");
        if (lane == 0) (void)__hip_atomic_fetch_add(cnt + 64 * u.pm, 1u, __ATOMIC_RELAXED, __HIP_MEMORY_SCOPE_AGENT);
        if (wid == 0) { unsigned sp = 0;
            while ((unsigned)__builtin_amdgcn_readfirstlane(__hip_atomic_load(cnt + 64 * u.pm, __ATOMIC_RELAXED, __HIP_MEMORY_SCOPE_AGENT)) < 32u) { __builtin_amdgcn_s_sleep(2); if (++sp > (1u << 22)) break; } }
        asm volatile("s_waitcnt vmcnt(0) lgkmcnt(0)" ::: "memory"); __builtin_amdgcn_s_barrier(); asm volatile("" ::: "memory");
        f32x4 gv[2][2];
#pragma unroll
        for (int bj = 0; bj < 2; ++bj) { gv[bj][0] = *(const f32x4*)(g + col0 + bj * HALF); gv[bj][1] = *(const f32x4*)(g + col0 + bj * HALF + 4); }
        float rsv[2][4];
#pragma unroll
        for (int ai = 0; ai < 2; ++ai)
#pragma unroll
            for (int m = 0; m < 4; ++m) { const unsigned long long* sl = (const unsigned long long*)(slots + (size_t)(u.pm * BM + ai * HALF + rl0 + m * 16) * 4);
                const unsigned long long q0 = __hip_atomic_load(sl + 0, __ATOMIC_RELAXED, __HIP_MEMORY_SCOPE_AGENT), q1 = __hip_atomic_load(sl + 1, __ATOMIC_RELAXED, __HIP_MEMORY_SCOPE_AGENT);
                const float s0 = __uint_as_float((unsigned)q0), s1 = __uint_as_float((unsigned)(q0 >> 32)), s2 = __uint_as_float((unsigned)q1), s3 = __uint_as_float((unsigned)(q1 >> 32));
                rsv[ai][m] = 1.0f / sqrtf(((s0 + s1) + (s2 + s3)) * (1.f / DM) + EPS); }
        (void)S;
#pragma unroll
        for (int ai = 0; ai < 2; ++ai)
#pragma unroll
            for (int m = 0; m < 4; ++m) { const int rl = ai * HALF + rl0 + m * 16; const float rs = rsv[ai][m]; const size_t off = (size_t)(u.pm * BM + rl) * DM + col0;
#pragma unroll
                for (int bj = 0; bj < 2; ++bj) { const f32x4 a0 = v[ai][bj][m][0], a1 = v[ai][bj][m][1]; const f32x4 o0 = a0 * rs * gv[bj][0], o1 = a1 * rs * gv[bj][1];
                    u32x4 wx; wx.x = cvt_pk_bf16(a0[0], a0[1]); wx.y = cvt_pk_bf16(a0[2], a0[3]); wx.z = cvt_pk_bf16(a1[0], a1[1]); wx.w = cvt_pk_bf16(a1[2], a1[3]);
                    u32x4 wh; wh.x = cvt_pk_bf16(o0[0], o0[1]); wh.y = cvt_pk_bf16(o0[2], o0[3]); wh.z = cvt_pk_bf16(o1[0], o1[1]); wh.w = cvt_pk_bf16(o1[2], o1[3]);
                    *(u32x4*)(xd + off + bj * HALF) = wx; *(u32x4*)(hn + off + bj * HALF) = wh; } }
    }
};
struct EpiQ {
    static constexpr bool PERM = true;
    bf16_t* Q; const float* rstd; const float* cosT; const float* sinT;
    __device__ __forceinline__ void operator()(const f32x4 (&acc)[2][2][4][2], const Unit& u, int wr, int wc, int fr, int fq) const {
        const int row0 = u.pm * BM + wr * 64 + fr;
        float rsv[2][4];
#pragma unroll
        for (int ai = 0; ai < 2; ++ai)
#pragma unroll
            for (int m = 0; m < 4; ++m) rsv[ai][m] = rstd[row0 + ai * HALF + m * 16];
#pragma unroll
        for (int bj = 0; bj < 2; ++bj) {
            const int col0 = u.pn * BM + bj * HALF + wc * 32 + 8 * fq, within = col0 % 192; const bool rope = within >= 128; const int i0 = (within - 128) >> 1;
#pragma unroll
            for (int ai = 0; ai < 2; ++ai) {
                f32x4 cv[4], sv[4];
                if (rope) {
#pragma unroll
                    for (int m = 0; m < 4; ++m) { const int pos = (row0 + ai * HALF + m * 16) & (SEQ - 1); cv[m] = *(const f32x4*)(cosT + pos * 32 + i0); sv[m] = *(const f32x4*)(sinT + pos * 32 + i0); } }
#pragma unroll
                for (int m = 0; m < 4; ++m) { const int row = row0 + ai * HALF + m * 16; const float rs = rsv[ai][m];
                    f32x4 v0 = acc[ai][bj][m][0] * rs, v1 = acc[ai][bj][m][1] * rs;
                    if (rope) { const f32x4 c4 = cv[m], s4 = sv[m];
                        const f32x4 a = v0, b = v1;
                        v0[0] = a[0] * c4[0] - a[1] * s4[0]; v0[1] = a[0] * s4[0] + a[1] * c4[0]; v0[2] = a[2] * c4[1] - a[3] * s4[1]; v0[3] = a[2] * s4[1] + a[3] * c4[1];
                        v1[0] = b[0] * c4[2] - b[1] * s4[2]; v1[1] = b[0] * s4[2] + b[1] * c4[2]; v1[2] = b[2] * c4[3] - b[3] * s4[3]; v1[3] = b[2] * s4[3] + b[3] * c4[3]; }
                    u32x4 w; w.x = cvt_pk_bf16(v0[0], v0[1]); w.y = cvt_pk_bf16(v0[2], v0[3]); w.z = cvt_pk_bf16(v1[0], v1[1]); w.w = cvt_pk_bf16(v1[2], v1[3]);
                    *(u32x4*)(Q + (size_t)row * QW + col0) = w; asm volatile("" ::: "memory"); } } }
    }
};
struct EpiResid {
    static constexpr bool PERM = false;
    const float* res; float* out;
    __device__ __forceinline__ void operator()(const f32x4 (&acc)[2][2][4][2], const Unit& u, int wr, int wc, int fr, int fq) const {
        const int row0 = u.pm * BM + wr * 64 + fr, col0 = u.pn * BM + wc * 32 + 4 * fq;
#pragma unroll
        for (int ai = 0; ai < 2; ++ai)
#pragma unroll
            for (int m = 0; m < 4; ++m) { const size_t off = (size_t)(row0 + ai * HALF + m * 16) * DM + col0;
#pragma unroll
                for (int bj = 0; bj < 2; ++bj)
#pragma unroll
                    for (int n = 0; n < 2; ++n) { const f32x4 r = *(const f32x4*)(res + off + bj * HALF + n * 16); *(f32x4*)(out + off + bj * HALF + n * 16) = r + acc[ai][bj][m][n]; } }
    }
};
struct EpiSwiGLU {
    static constexpr bool PERM = true;
    bf16_t* O; int ldc;
    __device__ __forceinline__ void operator()(const f32x4 (&acc)[2][2][4][2], const Unit& u, int wr, int wc, int fr, int fq) const {
        const int row0 = u.pm * BM + wr * 64 + fr, col0 = u.pn * HALF + wc * 32 + 8 * fq;
#pragma unroll
        for (int ai = 0; ai < 2; ++ai)
#pragma unroll
            for (int m = 0; m < 4; ++m) { f32x4 h[2];
#pragma unroll
                for (int n = 0; n < 2; ++n) { const f32x4 g = acc[ai][0][m][n], up = acc[ai][1][m][n];
#pragma unroll
                    for (int e = 0; e < 4; ++e) h[n][e] = g[e] * sigmoidf_(g[e]) * up[e]; }
                u32x4 w; w.x = cvt_pk_bf16(h[0][0], h[0][1]); w.y = cvt_pk_bf16(h[0][2], h[0][3]); w.z = cvt_pk_bf16(h[1][0], h[1][1]); w.w = cvt_pk_bf16(h[1][2], h[1][3]);
                *(u32x4*)(O + (size_t)(row0 + ai * HALF + m * 16) * ldc + col0) = w; asm volatile("" ::: "memory"); }
    }
};
struct EpiMoeDown {
    static constexpr bool PERM = false;
    float* x; const int* slot_tok; const float* slot_g;
    __device__ __forceinline__ void operator()(const f32x4 (&acc)[2][2][4][2], const Unit& u, int wr, int wc, int fr, int fq) const {
        const int row0 = u.pm * BM + wr * 64 + fr, col0 = u.pn * BM + wc * 32 + 4 * fq;
#pragma unroll
        for (int ai = 0; ai < 2; ++ai)
#pragma unroll
            for (int m = 0; m < 4; ++m) { const int slot = row0 + ai * HALF + m * 16; const int tok = slot_tok[slot]; const float g = slot_g[slot];
                if (tok >= 0) { const size_t off = (size_t)tok * DM + col0;
#pragma unroll
                    for (int bj = 0; bj < 2; ++bj)
#pragma unroll
                        for (int n = 0; n < 2; ++n) { const f32x4 r = *(const f32x4*)(x + off + bj * HALF + n * 16); *(f32x4*)(x + off + bj * HALF + n * 16) = r + acc[ai][bj][m][n] * g; } } }
    }
};

struct EpiMoeDownB {
    static constexpr bool PERM = true;
    const bf16_t* xs; bf16_t* xd; const int* slot_tok; const float* slot_g; f32x4* part; unsigned* cnt;
    __device__ __forceinline__ void operator()(const f32x4 (&acc)[2][2][4][2], const Unit& u, int wr, int wc, int fr, int fq) const {
        if (u.role == 1) {
            u32x4* p = (u32x4*)part + (size_t)u.aux * (16 * 512) + (wr * 4 + wc) * 64 + fq * 16 + fr;
#pragma unroll
            for (int ai = 0; ai < 2; ++ai)
#pragma unroll
                for (int bj = 0; bj < 2; ++bj)
#pragma unroll
                    for (int m = 0; m < 4; ++m) { const f32x4 v0 = acc[ai][bj][m][0], v1 = acc[ai][bj][m][1];
                        u32x4 w; w.x = cvt_pk_bf16(v0[0], v0[1]); w.y = cvt_pk_bf16(v0[2], v0[3]); w.z = cvt_pk_bf16(v1[0], v1[1]); w.w = cvt_pk_bf16(v1[2], v1[3]);
                        p[(size_t)((ai * 2 + bj) * 4 + m) * 512] = w; }
            return; }
        const int row0 = u.pm * BM + wr * 64 + fr, col0 = u.pn * BM + wc * 32 + 8 * fq;
        int tk[2][4]; float gg[2][4];
#pragma unroll
        for (int ai = 0; ai < 2; ++ai)
#pragma unroll
            for (int m = 0; m < 4; ++m) { tk[ai][m] = slot_tok[row0 + ai * HALF + m * 16]; gg[ai][m] = slot_g[row0 + ai * HALF + m * 16]; }
#pragma unroll
        for (int ai = 0; ai < 2; ++ai)
#pragma unroll
            for (int m = 0; m < 4; ++m) if (tk[ai][m] >= 0) { const size_t off = (size_t)tk[ai][m] * DM + col0; const float g = gg[ai][m];
                const u32x4 r0 = *(const u32x4*)(xs + off), r1 = *(const u32x4*)(xs + off + HALF);
#pragma unroll
                for (int bj = 0; bj < 2; ++bj) { const u32x4 r = bj ? r1 : r0; const f32x4 v0 = acc[ai][bj][m][0] * g, v1 = acc[ai][bj][m][1] * g;
                    u32x4 w; w.x = cvt_pk_bf16(__uint_as_float(r.x << 16) + v0[0], __uint_as_float(r.x & 0xffff0000u) + v0[1]); w.y = cvt_pk_bf16(__uint_as_float(r.y << 16) + v0[2], __uint_as_float(r.y & 0xffff0000u) + v0[3]);
                    w.z = cvt_pk_bf16(__uint_as_float(r.z << 16) + v1[0], __uint_as_float(r.z & 0xffff0000u) + v1[1]); w.w = cvt_pk_bf16(__uint_as_float(r.w << 16) + v1[2], __uint_as_float(r.w & 0xffff0000u) + v1[3]);
                    *(u32x4*)(xd + off + bj * HALF) = w; } }
    }
};
struct EpiMoeDelta {
    static constexpr bool PERM = true;
    bf16_t* d1; const int* slot_tok; const float* slot_g;
    __device__ __forceinline__ void operator()(const f32x4 (&acc)[2][2][4][2], const Unit& u, int wr, int wc, int fr, int fq) const {
        const int row0 = u.pm * BM + wr * 64 + fr, col0 = u.pn * BM + wc * 32 + 8 * fq;
        int tk[2][4]; float gg[2][4];
#pragma unroll
        for (int ai = 0; ai < 2; ++ai)
#pragma unroll
            for (int m = 0; m < 4; ++m) { tk[ai][m] = slot_tok[row0 + ai * HALF + m * 16]; gg[ai][m] = slot_g[row0 + ai * HALF + m * 16]; }
#pragma unroll
        for (int ai = 0; ai < 2; ++ai)
#pragma unroll
            for (int m = 0; m < 4; ++m) if (tk[ai][m] >= 0) { bf16_t* rowp = d1 + (size_t)tk[ai][m] * DM + col0; const float g = gg[ai][m];
#pragma unroll
                for (int bj = 0; bj < 2; ++bj) { const f32x4 v0 = acc[ai][bj][m][0] * g, v1 = acc[ai][bj][m][1] * g;
                    u32x4 w; w.x = cvt_pk_bf16(v0[0], v0[1]); w.y = cvt_pk_bf16(v0[2], v0[3]); w.z = cvt_pk_bf16(v1[0], v1[1]); w.w = cvt_pk_bf16(v1[2], v1[3]);
                    *(u32x4*)(rowp + bj * HALF) = w; } }
    }
};
__device__ __forceinline__ void glds16_s(const void* sbase, unsigned voff, unsigned lds_dst) { unsigned keep;
    asm volatile("s_mov_b32 %0, m0\n\ts_mov_b32 m0, %3\n\ts_nop 0\n\tglobal_load_lds_dwordx4 %2, %1\n\ts_mov_b32 m0, %0" : "=&s"(keep) : "s"(sbase), "v"(voff), "s"(lds_dst) : "memory"); }
template <class Epi, class Sched, bool ALIGN_EPI>
__device__ __forceinline__ void gemm_phase(LAS unsigned char* lds, const bf16_t* Aptr, const int lda, const int K, const Sched& S, const Epi& E, int tid) {
    asm volatile("" : "+v"(tid));
    const int wid = __builtin_amdgcn_readfirstlane(tid >> 6), lane = tid & 63, wr = wid >> 2, wc = wid & 3, fr = lane & 15, fq = lane >> 4;
    const int nt = K / BK;
    int RA[2]; unsigned CA2[2], voffB[2];
#pragma unroll
    for (int i = 0; i < 2; ++i) { int R, C; stage_rc(tid * 16 + i * 8192, R, C); const int Rb = Epi::PERM ? ((R & ~31) + perm32(R & 31)) : R;
        RA[i] = R; CA2[i] = (unsigned)C * 2u; voffB[i] = (unsigned)(Rb * K + C) * 2u; }
    const size_t kstep = (size_t)(BK * 2);
    const size_t hstep = (size_t)HALF * K * 2;
    const unsigned ldsb = (unsigned)(uintptr_t)lds + (unsigned)wid * 1024u;
    const int aoff = lds_byte(wr * 64 + fr, fq * 8), boff = lds_byte(wc * 32 + fr, fq * 8);
#define PG8_SA(b, h) (((b) * 2 + (h)) * HTB)
#define PG8_SB(b, h) ((4 + (b) * 2 + (h)) * HTB)
#define PG8_STAGE(bufoff, gbase, voff) do { _Pragma("unroll") for (int _i = 0; _i < 2; ++_i) \
        glds16_s((const void*)(gbase), (voff)[_i], ldsb + (unsigned)((bufoff) + _i * 8192)); } while (0)
#define PG8_LDA(dst, b, h) do { _Pragma("unroll") for (int m = 0; m < 4; ++m) _Pragma("unroll") for (int k = 0; k < 2; ++k) dst[m][k] = *(const LAS bf16x8*)(lds + PG8_SA(b, h) + aoff + m * 2048 + k * 1024); } while (0)
#define PG8_LDB(dst, b, h) do { _Pragma("unroll") for (int n = 0; n < 2; ++n) _Pragma("unroll") for (int k = 0; k < 2; ++k) dst[n][k] = *(const LAS bf16x8*)(lds + PG8_SB(b, h) + boff + n * 2048 + k * 1024); } while (0)
#define PG8_MMA(ai, bj, At, Bt) do { __builtin_amdgcn_s_setprio(1); _Pragma("unroll") for (int m = 0; m < 4; ++m) _Pragma("unroll") for (int n = 0; n < 2; ++n) _Pragma("unroll") for (int k = 0; k < 2; ++k) \
        acc[ai][bj][m][n] = __builtin_amdgcn_mfma_f32_16x16x32_bf16(Bt[n][k], At[m][k], acc[ai][bj][m][n], 0, 0, 0); __builtin_amdgcn_s_setprio(0); } while (0)
#define PG8_WAIT_V(n) asm volatile("s_waitcnt vmcnt(" #n ")" ::: "memory")
#define PG8_WAIT_L(n) asm volatile("s_waitcnt lgkmcnt(" #n ")" ::: "memory")
#define PG8_BAR __builtin_amdgcn_s_barrier()
#define PG8_SCHED __builtin_amdgcn_sched_barrier(0)
#define PG8_MKOFF(dst, u) do { _Pragma("unroll") for (int _h = 0; _h < 2; ++_h) _Pragma("unroll") for (int _i = 0; _i < 2; ++_i) \
        dst[_h][_i] = (unsigned)S.arow(u, _h * HALF + RA[_i]) * (unsigned)(lda * 2) + CA2[_i]; } while (0)
    Unit cur, nxt; int ui = 0;
    if (!S.next(0, cur)) return;
    constexpr bool SK = Sched::SPLITK;
    f32x4 acc[2][2][4][2];
#pragma unroll
    for (int a = 0; a < 2; ++a)
#pragma unroll
        for (int b = 0; b < 2; ++b)
#pragma unroll
            for (int m = 0; m < 4; ++m)
#pragma unroll
                for (int n = 0; n < 2; ++n) acc[a][b][m][n] = (f32x4){0.f, 0.f, 0.f, 0.f};
    bf16x8 At[4][2], B0[2][2], B1[2][2];
    constexpr bool GA = Sched::GATHER;
    unsigned ca[2][2], na[2][2];
    const char* const Ab = (const char*)Aptr;
    const size_t tstepA = (size_t)BM * lda * 2;
    const char* cAp = Ab;
    if constexpr (GA) { PG8_MKOFF(ca, cur); }
    else { cAp = Ab + (size_t)cur.pm * tstepA + (SK ? (size_t)cur.k0 * 2 : (size_t)0);
#pragma unroll
        for (int h = 0; h < 2; ++h)
#pragma unroll
            for (int i = 0; i < 2; ++i) { ca[h][i] = (unsigned)((h * HALF + RA[i]) * lda) * 2u + CA2[i]; na[h][i] = ca[h][i]; } }
    const char* cB = S.bptr(cur) + (SK ? (size_t)cur.k0 * 2 : (size_t)0);
    PG8_STAGE(PG8_SB(0, 0), cB, voffB); PG8_STAGE(PG8_SB(0, 1), cB + hstep, voffB); PG8_STAGE(PG8_SA(0, 0), cAp, ca[0]); PG8_STAGE(PG8_SA(0, 1), cAp, ca[1]);
    if (wr == 1) PG8_BAR;
    PG8_WAIT_V(2); PG8_BAR;
    PG8_STAGE(PG8_SB(1, 0), cB + kstep, voffB); PG8_STAGE(PG8_SA(1, 0), cAp + kstep, ca[0]); PG8_STAGE(PG8_SB(1, 1), cB + hstep + kstep, voffB);
    PG8_WAIT_V(6); PG8_BAR;
    for (;;) {
        const bool has_next = S.next(ui + 1, nxt);
        const char* nB = cB; const char* nAp = cAp;
        if (has_next) { nB = S.bptr(nxt) + (SK ? (size_t)nxt.k0 * 2 : (size_t)0); if constexpr (GA) { PG8_MKOFF(na, nxt); } else nAp = Ab + (size_t)nxt.pm * tstepA + (SK ? (size_t)nxt.k0 * 2 : (size_t)0); }
        else if constexpr (GA) {
#pragma unroll
            for (int h = 0; h < 2; ++h)
#pragma unroll
                for (int i = 0; i < 2; ++i) na[h][i] = ca[h][i]; }
        const int cnt_t = SK ? __builtin_amdgcn_readfirstlane(cur.nt) : nt;
        for (int t = 0; t < cnt_t; t += 2) {
            const bool last = (t == cnt_t - 2);
            const char* a1 = cAp + (size_t)(t + 1) * kstep;
            const char* a2 = last ? nAp : cAp + (size_t)(t + 2) * kstep; const char* b2 = last ? nB : cB + (size_t)(t + 2) * kstep;
            const char* a3 = a2 + kstep; const char* b3 = b2 + kstep;
            unsigned o2[2][2];
#pragma unroll
            for (int h = 0; h < 2; ++h)
#pragma unroll
                for (int i = 0; i < 2; ++i) o2[h][i] = (GA && last) ? na[h][i] : ca[h][i];
            PG8_LDB(B0, 0, 0); PG8_LDB(B1, 0, 1); PG8_SCHED; PG8_LDA(At, 0, 0); PG8_STAGE(PG8_SA(1, 1), a1, ca[1]);
            PG8_WAIT_V(8); PG8_WAIT_L(0); PG8_BAR; PG8_MMA(0, 0, At, B0); PG8_MMA(0, 1, At, B1); PG8_BAR; PG8_SCHED;
            PG8_LDA(At, 0, 1); PG8_STAGE(PG8_SB(0, 0), b2, voffB); PG8_STAGE(PG8_SB(0, 1), b2 + hstep, voffB); PG8_STAGE(PG8_SA(0, 0), a2, o2[0]);
            PG8_WAIT_V(8); PG8_WAIT_L(0); PG8_BAR; PG8_MMA(1, 0, At, B0); PG8_MMA(1, 1, At, B1); PG8_BAR; PG8_SCHED;
            PG8_LDB(B0, 1, 0); PG8_LDB(B1, 1, 1); PG8_SCHED; PG8_LDA(At, 1, 0); PG8_STAGE(PG8_SA(0, 1), a2, o2[1]);
            PG8_WAIT_V(8); PG8_WAIT_L(0); PG8_BAR; PG8_MMA(0, 0, At, B0); PG8_MMA(0, 1, At, B1); PG8_BAR; PG8_SCHED;
            PG8_LDA(At, 1, 1); PG8_STAGE(PG8_SB(1, 0), b3, voffB); PG8_STAGE(PG8_SB(1, 1), b3 + hstep, voffB); PG8_STAGE(PG8_SA(1, 0), a3, o2[0]);
            PG8_WAIT_V(8); PG8_WAIT_L(0); PG8_BAR; PG8_MMA(1, 0, At, B0); PG8_MMA(1, 1, At, B1); PG8_BAR; PG8_SCHED;
        }
        if constexpr (ALIGN_EPI) { if (wr == 0) PG8_BAR; }
        E(acc, cur, wr, wc, fr, fq);
        if (!has_next) break;
#pragma unroll
        for (int a = 0; a < 2; ++a)
#pragma unroll
            for (int b = 0; b < 2; ++b)
#pragma unroll
                for (int m = 0; m < 4; ++m)
#pragma unroll
                    for (int n = 0; n < 2; ++n) acc[a][b][m][n] = (f32x4){0.f, 0.f, 0.f, 0.f};
        cur = nxt; cB = nB; cAp = nAp; ++ui;
        if constexpr (GA) {
#pragma unroll
            for (int h = 0; h < 2; ++h)
#pragma unroll
                for (int i = 0; i < 2; ++i) ca[h][i] = na[h][i]; }
        if constexpr (ALIGN_EPI) { if (wr == 1) PG8_BAR; }
    }
    PG8_WAIT_V(0);
    if constexpr (!ALIGN_EPI) { if (wr == 0) PG8_BAR; }
    PG8_BAR;
#undef PG8_SA
#undef PG8_SB
#undef PG8_STAGE
#undef PG8_LDA
#undef PG8_LDB
#undef PG8_MMA
#undef PG8_WAIT_V
#undef PG8_WAIT_L
#undef PG8_BAR
#undef PG8_SCHED
#undef PG8_MKOFF
}
}

__device__ __forceinline__ void moe_down_fixup(const pg8::MoeDownSched& S, const pg8::EpiMoeDownB& E, int tid) {
    if (S.c >= S.nchunk) return;
    const int lu = S.c / pg8::KCH, kc = S.c - lu * pg8::KCH;
    if (tid == 0) {
        __builtin_amdgcn_fence(__ATOMIC_RELEASE, "agent"); asm volatile("s_waitcnt vmcnt(0)" ::: "memory");
        (void)__hip_atomic_fetch_add(E.cnt + lu, 1u, __ATOMIC_RELAXED, __HIP_MEMORY_SCOPE_AGENT);
        unsigned sp = 0;
        while (__hip_atomic_load(E.cnt + lu, __ATOMIC_RELAXED, __HIP_MEMORY_SCOPE_AGENT) < (unsigned)pg8::KCH) { __builtin_amdgcn_s_sleep(1); if (++sp > (1u << 22)) break; }
        __builtin_amdgcn_fence(__ATOMIC_ACQUIRE, "agent"); asm volatile("s_waitcnt vmcnt(0)" ::: "memory"); }
    __syncthreads();
    const int wid = tid >> 6, lane = tid & 63, wr = wid >> 2, wc = wid & 3, fr = lane & 15, fq = lane >> 4;
    const u32x4* p = (const u32x4*)E.part + (size_t)(lu * pg8::KCH) * (16 * 512) + tid;
    pg8::Unit u; S.map(S.nfullu + lu, u);
    const int row0 = u.pm * pg8::BM + wr * 64 + fr, col0 = u.pn * pg8::BM + wc * 32 + 8 * fq;
#pragma unroll 1
    for (int am = kc; am < 8; am += pg8::KCH) { const int ai = am >> 2, m = am & 3; f32x4 v[2][2];
#pragma unroll
        for (int bj = 0; bj < 2; ++bj) { const int idx = (ai * 2 + bj) * 4 + m; f32x4 a0 = {0.f, 0.f, 0.f, 0.f}, a1 = {0.f, 0.f, 0.f, 0.f};
#pragma unroll
            for (int q = 0; q < pg8::KCH; ++q) { const u32x4 w = p[(size_t)q * (16 * 512) + (size_t)idx * 512];
                a0[0] += __uint_as_float(w.x << 16); a0[1] += __uint_as_float(w.x & 0xffff0000u); a0[2] += __uint_as_float(w.y << 16); a0[3] += __uint_as_float(w.y & 0xffff0000u);
                a1[0] += __uint_as_float(w.z << 16); a1[1] += __uint_as_float(w.z & 0xffff0000u); a1[2] += __uint_as_float(w.w << 16); a1[3] += __uint_as_float(w.w & 0xffff0000u); }
            v[bj][0] = a0; v[bj][1] = a1; }
        const int slot = row0 + ai * pg8::HALF + m * 16; const int tok = E.slot_tok[slot]; const float g = E.slot_g[slot];
        if (tok >= 0) { const size_t off = (size_t)tok * DM + col0;
#pragma unroll
            for (int bj = 0; bj < 2; ++bj) { const u32x4 r = *(const u32x4*)(E.xs + off + bj * pg8::HALF); const f32x4 v0 = v[bj][0] * g, v1 = v[bj][1] * g;
                u32x4 w; w.x = cvt_pk_bf16(__uint_as_float(r.x << 16) + v0[0], __uint_as_float(r.x & 0xffff0000u) + v0[1]); w.y = cvt_pk_bf16(__uint_as_float(r.y << 16) + v0[2], __uint_as_float(r.y & 0xffff0000u) + v0[3]);
                w.z = cvt_pk_bf16(__uint_as_float(r.z << 16) + v1[0], __uint_as_float(r.z & 0xffff0000u) + v1[1]); w.w = cvt_pk_bf16(__uint_as_float(r.w << 16) + v1[2], __uint_as_float(r.w & 0xffff0000u) + v1[3]);
                *(u32x4*)(E.xd + off + bj * pg8::HALF) = w; } } }
}

namespace att {
constexpr int NW = 8, QBLK = 32, KVBLK = 64, QB = NW * QBLK;
constexpr int SHM_V = 16384, SHM_K = 16384, SHM_R = 8192;
constexpr int NBUF = 3;
constexpr int OFF_K = 0, OFF_R = OFF_K + NBUF * SHM_K, OFF_WS = OFF_R + NBUF * SHM_R, OFF_V = OFF_WS + NW * 64 * 4, LDS_BYTES = OFF_V + NBUF * SHM_V;
constexpr float THR_L2 = 11.5f;
#define KSWZ(row, colB) ((row) * 256 + ((colB) ^ (((row) & 7) << 4)))
#define RSWZ(row, colB) (((row) >> 1) * 256 + (((((row) & 1) << 7) | (colB)) ^ ((((row) >> 1) & 7) << 4)))
#define SBAR() __builtin_amdgcn_sched_barrier(0)
__device__ __forceinline__ int v_st(int k, int c) { const int kk = (k & ~0xC) | ((k & 4) << 1) | ((k & 8) >> 1); return ((kk >> 3) * 4 + (c >> 5)) * 512 + ((kk & 7) * 32 + (c & 31)) * 2; }
__device__ __forceinline__ int v_rd_base(int lane) { return ((lane & 3) << 3) | (((lane >> 2) & 3) << 6) | (((lane >> 4) & 1) << 5) | (((lane >> 5) & 1) << 8); }
constexpr int v_rd_off(int d0, int ks, int half) { return d0 * 512 + ks * 4096 + half * 2048; }
__device__ __forceinline__ int crow(int r, int hi) { return (r & 3) + 8 * (r >> 2) + 4 * hi; }
__device__ __forceinline__ void mask_tile(f32x16& p0, f32x16& p1, int dq) {
    const float NEG = -__builtin_inff();
#pragma unroll
    for (int r = 0; r < 16; ++r) {
        const int c = (r & 3) + 8 * (r >> 2);
        if (dq - c < 0) p0[r] = NEG;
        if (dq - c - 32 < 0) p1[r] = NEG;
    }
}
__device__ __forceinline__ void partialSM(f32x16& p0, f32x16& p1, float& m_reg, float& mn, float& alpha) {
    float pmax = p0[0];
#pragma unroll
    for (int r = 1; r < 16; ++r) pmax = fmaxf(pmax, p0[r]);
#pragma unroll
    for (int r = 0; r < 16; ++r) pmax = fmaxf(pmax, p1[r]);
    { auto rr = __builtin_amdgcn_permlane32_swap(__float_as_uint(pmax), __float_as_uint(pmax), false, false);
      pmax = fmaxf(__uint_as_float(rr[0]), __uint_as_float(rr[1])); }
    if (__builtin_expect(__all((pmax - m_reg) <= THR_L2), 1)) { mn = m_reg; alpha = 1.f; }
    else { mn = fmaxf(m_reg, pmax); alpha = __builtin_amdgcn_exp2f(m_reg - mn); m_reg = mn; }
#pragma unroll
    for (int r = 0; r < 16; ++r) p0[r] = p0[r] - mn;
#pragma unroll
    for (int r = 0; r < 16; ++r) p1[r] = p1[r] - mn;
#pragma unroll
    for (int r = 0; r < 16; ++r) p0[r] = __builtin_amdgcn_exp2f(p0[r]);
}
__device__ __forceinline__ void finishSM(f32x16& p0, f32x16& p1, float alpha, float& l_reg, bf16x8& pa0, bf16x8& pa1, bf16x8& pa2, bf16x8& pa3) {
#pragma unroll
    for (int r = 0; r < 16; ++r) p1[r] = __builtin_amdgcn_exp2f(p1[r]);
    float ps = 0;
#pragma unroll
    for (int r = 0; r < 16; ++r) ps += p0[r];
#pragma unroll
    for (int r = 0; r < 16; ++r) ps += p1[r];
    { auto rr = __builtin_amdgcn_permlane32_swap(__float_as_uint(ps), __float_as_uint(ps), false, false);
      ps = __uint_as_float(rr[0]) + __uint_as_float(rr[1]); }
    l_reg = l_reg * alpha + ps;
#define PK4(P, B_, OUT) do { unsigned a0 = cvt_pk_bf16(P[B_+0], P[B_+1]), a1 = cvt_pk_bf16(P[B_+2], P[B_+3]);                          \
        unsigned b0 = cvt_pk_bf16(P[B_+4], P[B_+5]), b1 = cvt_pk_bf16(P[B_+6], P[B_+7]);                                             \
        auto r0 = __builtin_amdgcn_permlane32_swap(a0, b0, false, false); auto r1 = __builtin_amdgcn_permlane32_swap(a1, b1, false, false); \
        u32x4 w = {r0[0], r1[0], r0[1], r1[1]}; OUT = *reinterpret_cast<bf16x8*>(&w); } while (0)
    PK4(p0, 0, pa0); PK4(p0, 8, pa1); PK4(p1, 0, pa2); PK4(p1, 8, pa3);
#undef PK4
}
__device__ __forceinline__ void qkt(f32x16& p0, f32x16& p1, const char* lbk, const char* lbrk, const bf16x8* qr) {
    p0 = f32x16{}; p1 = f32x16{};
    bf16x8 F0[4], F1[4];
#define KLD(F, g) do { if ((g) < 4) { F[0] = *reinterpret_cast<const bf16x8*>(lbk + (2 * (g)) * 1024); F[1] = *reinterpret_cast<const bf16x8*>(lbk + (2 * (g)) * 1024 + 8192); \
                                      F[2] = *reinterpret_cast<const bf16x8*>(lbk + (2 * (g) + 1) * 1024); F[3] = *reinterpret_cast<const bf16x8*>(lbk + (2 * (g) + 1) * 1024 + 8192); } \
                       else { F[0] = *reinterpret_cast<const bf16x8*>(lbrk + (2 * (g) - 8) * 1024); F[1] = *reinterpret_cast<const bf16x8*>(lbrk + (2 * (g) - 8) * 1024 + 4096); \
                              F[2] = *reinterpret_cast<const bf16x8*>(lbrk + (2 * (g) - 7) * 1024); F[3] = *reinterpret_cast<const bf16x8*>(lbrk + (2 * (g) - 7) * 1024 + 4096); } } while (0)
#define KMM(F, g) do { p0 = __builtin_amdgcn_mfma_f32_32x32x16_bf16(F[0], qr[2 * (g)], p0, 0, 0, 0); p1 = __builtin_amdgcn_mfma_f32_32x32x16_bf16(F[1], qr[2 * (g)], p1, 0, 0, 0); \
                       p0 = __builtin_amdgcn_mfma_f32_32x32x16_bf16(F[2], qr[2 * (g) + 1], p0, 0, 0, 0); p1 = __builtin_amdgcn_mfma_f32_32x32x16_bf16(F[3], qr[2 * (g) + 1], p1, 0, 0, 0); } while (0)
    KLD(F0, 0); KLD(F1, 1); SBAR();
    KMM(F0, 0); SBAR(); KLD(F0, 2); SBAR();
    KMM(F1, 1); SBAR(); KLD(F1, 3); SBAR();
    KMM(F0, 2); SBAR(); KLD(F0, 4); SBAR();
    KMM(F1, 3); SBAR(); KLD(F1, 5); SBAR();
    KMM(F0, 4); SBAR();
    KMM(F1, 5); SBAR();
#undef KLD
#undef KMM
}
__device__ __forceinline__ void pv_tile(f32x16* o, int vbt, bf16x8 pa0, bf16x8 pa1, bf16x8 pa2, bf16x8 pa3) {
#define TRRD(dst, off) asm volatile("ds_read_b64_tr_b16 %0, %1 offset:%2" : "=&v"(dst) : "v"(vbt), "i"(off) : "memory")
#define TRRD8(L, d0) do { constexpr int b_ = v_rd_off(d0, 0, 0); TRRD(L[0], b_); TRRD(L[1], b_ + 2048); TRRD(L[2], b_ + 4096); TRRD(L[3], b_ + 6144); TRRD(L[4], b_ + 8192); TRRD(L[5], b_ + 10240); TRRD(L[6], b_ + 12288); TRRD(L[7], b_ + 14336); } while (0)
#define PVMM(L, d0) do { \
        o[d0] = __builtin_amdgcn_mfma_f32_32x32x16_bf16(pa0, (bf16x8){L[0][0], L[0][1], L[0][2], L[0][3], L[1][0], L[1][1], L[1][2], L[1][3]}, o[d0], 0, 0, 0);   \
        o[d0] = __builtin_amdgcn_mfma_f32_32x32x16_bf16(pa1, (bf16x8){L[2][0], L[2][1], L[2][2], L[2][3], L[3][0], L[3][1], L[3][2], L[3][3]}, o[d0], 0, 0, 0);   \
        o[d0] = __builtin_amdgcn_mfma_f32_32x32x16_bf16(pa2, (bf16x8){L[4][0], L[4][1], L[4][2], L[4][3], L[5][0], L[5][1], L[5][2], L[5][3]}, o[d0], 0, 0, 0);   \
        o[d0] = __builtin_amdgcn_mfma_f32_32x32x16_bf16(pa3, (bf16x8){L[6][0], L[6][1], L[6][2], L[6][3], L[7][0], L[7][1], L[7][2], L[7][3]}, o[d0], 0, 0, 0); } while (0)
#define WAITL(n) asm volatile("s_waitcnt lgkmcnt(" #n ")" ::: "memory")
    s16x4 La[8], Lb[8];
    TRRD8(La, 0); TRRD8(Lb, 1);
    WAITL(8); SBAR(); PVMM(La, 0); SBAR(); TRRD8(La, 2);
    WAITL(8); SBAR(); PVMM(Lb, 1); SBAR(); TRRD8(Lb, 3);
    WAITL(8); SBAR(); PVMM(La, 2); SBAR();
    WAITL(0); SBAR(); PVMM(Lb, 3); SBAR();
#undef TRRD
#undef TRRD8
#undef PVMM
#undef WAITL
}

struct BlockRef { const bf16_t* Q; const bf16_t* Kl; const bf16_t* Kr; bf16_t* O; int P0; };
#define VMW() asm volatile("s_waitcnt vmcnt(0)" ::: "memory")
#define SLOAD(k0) do { const bf16_t* kp_ = cur.Kl + (size_t)((k0) + srow) * 128 + cc * 8; st_k0 = *(const bf16x8*)kp_; st_k1 = *(const bf16x8*)(kp_ + 64); \
                       st_r = *(const bf16x8*)(cur.Kr + (size_t)((k0) + srow) * 64 + cc * 8); } while (0)
#define SWRITE_K(bf) do { char* kd_ = lds + OFF_K + (bf) * SHM_K + kws; *(bf16x8*)kd_ = st_k0; *(bf16x8*)(kd_ + 4096) = st_k1; *(bf16x8*)(lds + OFF_R + (bf) * SHM_R + rws) = st_r; } while (0)
#define SWRITE_V(bf) do { char* vd_ = lds + OFF_V + (bf) * SHM_V + vst0; *(bf16x8*)vd_ = st_k0; *(bf16x8*)(vd_ + 1024) = st_k1; } while (0)
#define ABAR() asm volatile("s_waitcnt lgkmcnt(0)\n\ts_barrier" ::: "memory")
template <int VAR>
__device__ __forceinline__ void attn_block(const BlockRef& cur, char* lds, int tid) {
    asm volatile("" : "+v"(tid));
    const int wid = __builtin_amdgcn_readfirstlane(tid >> 6), lane = tid & 63, r32 = lane & 31, hi = lane >> 5, grp = wid >> 2;
    const int NT = (cur.P0 + QB - 1) / KVBLK + 1;
    const int qlo = cur.P0 + wid * QBLK, qm = qlo + r32 - 4 * hi;
    float* ws = (float*)(lds + OFF_WS) + wid * 64; float* li_l = ws, * al_l = ws + 32;
    float m_reg = -1e30f, l_reg = 0; f32x16 o[4] = {};
    const int srow = wid * 8 + (lane & 7), cc = lane >> 3;
    const int kws = (srow >> 5) * 8192 + (cc >> 1) * 1024 + ((cc & 1) * 32 + (srow & 31)) * 16, rws = (srow >> 5) * 4096 + (cc >> 1) * 1024 + ((cc & 1) * 32 + (srow & 31)) * 16, vst0 = v_st(srow, cc * 8);
    const int vb0 = (int)(uintptr_t)lds + OFF_V + v_rd_base(lane);
    const char* lb = lds + OFF_K + lane * 16;
    int lbr_i = (int)(uintptr_t)lds + OFF_R + lane * 16; asm volatile("" : "+v"(lbr_i));
    const char* lbr = (const char*)(const LAS char*)(uintptr_t)(unsigned)lbr_i;
    bf16x8 qr[12], st_k0, st_k1, st_r;
    { const bf16_t* qp = cur.Q + (size_t)(wid * QBLK + r32) * QW + hi * 8;
#pragma unroll
      for (int d0 = 0; d0 < 12; ++d0) qr[d0] = *(const bf16x8*)(qp + d0 * 16); }
#define RESC(a) do { if (__any((a) < 1.f)) { if (hi == 0) al_l[r32] = (a); asm volatile("s_waitcnt lgkmcnt(0)" ::: "memory");              \
                     _Pragma("unroll") for (int d_ = 0; d_ < 4; ++d_) _Pragma("unroll") for (int r = 0; r < 16; ++r) o[d_][r] *= al_l[crow(r, hi)]; } } while (0)
#define KBASE(t) ((t) * KVBLK)
#define MASKT(P0_, P1_, t) do { const int kb_ = KBASE(t); if (kb_ + KVBLK - 1 > qlo) mask_tile(P0_, P1_, qm - kb_); } while (0)
    f32x16 p0 = {}, p1 = {}; float mn, al = 1.f; bf16x8 pa0 = {}, pa1 = {}, pa2 = {}, pa3 = {};
    const int dist = 1 + grp;
    SLOAD(0); VMW(); SWRITE_K(0); SWRITE_V(0);
    if (grp) { SLOAD(KBASE(1)); VMW(); SWRITE_K(1); SWRITE_V(1); }
    SLOAD(KBASE(dist));
    ABAR();
    if (grp) ABAR();
    int bt = 0;
    for (int t = 0; t < NT; ++t) {
        if (VAR != 2) { SBAR(); qkt(p0, p1, lb + bt * SHM_K, lbr + bt * SHM_R, qr);
        if (t > 0) pv_tile(o, vb0 + (bt == 0 ? 2 : bt - 1) * SHM_V, pa0, pa1, pa2, pa3); }
        SBAR(); ABAR();
        if (VAR != 1) { MASKT(p0, p1, t); partialSM(p0, p1, m_reg, mn, al); finishSM(p0, p1, al, l_reg, pa0, pa1, pa2, pa3); RESC(al); }
        else { asm volatile("" : "+v"(p0), "+v"(p1), "+v"(pa0), "+v"(pa1), "+v"(pa2), "+v"(pa3)); }
        { const int td = t + dist; if (td < NT) { int wbi = bt + dist; wbi = wbi >= 3 ? wbi - 3 : wbi; VMW(); SWRITE_K(wbi); SWRITE_V(wbi); if (td + 1 < NT) SLOAD(KBASE(td + 1)); } }
        bt = bt == 2 ? 0 : bt + 1;
        SBAR(); ABAR();
    }
    pv_tile(o, vb0 + (bt == 0 ? 2 : bt - 1) * SHM_V, pa0, pa1, pa2, pa3);
    if (hi == 0) li_l[r32] = l_reg; asm volatile("s_waitcnt lgkmcnt(0)" ::: "memory");
    float rli[16];
#pragma unroll
    for (int r = 0; r < 16; ++r) rli[r] = __builtin_amdgcn_rcpf(li_l[crow(r, hi)]);
    bf16_t* Ow = cur.O + (size_t)(wid * QBLK) * DM;
#pragma unroll
    for (int r = 0; r < 16; ++r) { const int orow = crow(r, hi);
#pragma unroll
        for (int d0 = 0; d0 < 4; ++d0) { const float v = o[d0][r] * rli[r];
            const float vn = xlane1(v);
            if ((r32 & 1) == 0) *(unsigned*)(Ow + (size_t)orow * DM + d0 * 32 + r32) = cvt_pk_bf16(v, vn); } }
    if (!grp) ABAR();
    ABAR();
#undef RESC
#undef KBASE
#undef MASKT
}
#undef ABAR
#undef VMW
#undef SLOAD
#undef SWRITE_K
#undef SWRITE_V
}

constexpr int NWAVES = 8;
constexpr int RING_BYTES = 157696, MISC_OFF = RING_BYTES + 64, LDS_BYTES = 158720;
static_assert(att::LDS_BYTES <= RING_BYTES && pg8::STAGE_BYTES <= RING_BYTES, "phase scratch fits the ring region");
#define RLX_AGENT __ATOMIC_RELAXED, __HIP_MEMORY_SCOPE_AGENT

#define XB_TMO      128
#define XB_XCNT(j)  (256  + 64 * (j))
#define XB_XSUB(j)  (1280 + 64 * (j))
#define XB_XGEN(j)  (2304 + 64 * (j))
#define XB_TOP      3328
#define XB_TOPGEN   3392
#define XCD_BAR_WORDS 3456
#define XB_SPIN_CAP (1u << 18)
__device__ __forceinline__ unsigned xb_ld(unsigned* p)              { return __hip_atomic_load(p, __ATOMIC_RELAXED, __HIP_MEMORY_SCOPE_AGENT); }
__device__ __forceinline__ unsigned xb_add(unsigned* p, unsigned v) { return __hip_atomic_fetch_add(p, v, __ATOMIC_RELAXED, __HIP_MEMORY_SCOPE_AGENT); }
__device__ __forceinline__ unsigned xb_xcc_id() { return (unsigned)__builtin_amdgcn_s_getreg((3 << 11) | 20) & 0xFu; }
#define XB_SPIN(cond, bar) do { unsigned _sp = 0; while (cond) { __builtin_amdgcn_s_sleep(1); \
    if ((++_sp & 255u) == 0u) { if (xb_ld(&(bar)[XB_TMO])) break; if (_sp > XB_SPIN_CAP) { atomicAdd(&(bar)[XB_TMO], 1u); break; } } } } while (0)
struct XcdBarrier { unsigned* bar; unsigned x; volatile LAS unsigned* st; };
__device__ __forceinline__ XcdBarrier xcd_barrier_post(unsigned* bar, volatile LAS unsigned* st) {
    XcdBarrier b; b.bar = bar; b.x = xb_xcc_id(); b.st = st;
    if (threadIdx.x == 0) (void)xb_add(&bar[XB_XCNT(b.x)], 1u);
    return b;
}
__device__ __forceinline__ void xcd_barrier_complete(unsigned* bar, unsigned x, unsigned& nloc, unsigned& nx) {
    const unsigned G = gridDim.x * gridDim.y * gridDim.z;
    unsigned sum, cnt, mine, sp = 0u;
    for (;;) {
        sum = 0u; cnt = 0u; mine = 0u;
#pragma unroll
        for (unsigned j = 0; j < 16; ++j) { const unsigned c = xb_ld(&bar[XB_XCNT(j)]); sum += c; cnt += (c > 0u) ? 1u : 0u; mine = (j == x) ? c : mine; }
        if (sum == G) break;
        __builtin_amdgcn_s_sleep(1);
        if ((++sp & 255u) == 0u) { if (xb_ld(&bar[XB_TMO])) break; if (sp > XB_SPIN_CAP) { atomicAdd(&bar[XB_TMO], 1u); break; } }
    }
    nloc = mine > 0u ? mine : 1u; nx = cnt > 0u ? cnt : 1u;
}
__device__ __forceinline__ void xcd_barrier(const XcdBarrier& b, const bool leader  ) {
    asm volatile("s_waitcnt vmcnt(0)" ::: "memory");
    __syncthreads();
    if (leader) {
        unsigned* bar = b.bar;
        __builtin_amdgcn_s_waitcnt(0);
        unsigned nloc = b.st[0], nx = b.st[1];
        if (nloc == 0u) { xcd_barrier_complete(bar, b.x, nloc, nx); b.st[0] = nloc; b.st[1] = nx; }
        const unsigned old = xb_add(&bar[XB_XSUB(b.x)], 1u);
        const unsigned gen = old / nloc;
        if (old + 1u == (gen + 1u) * nloc) {
            __builtin_amdgcn_fence(__ATOMIC_RELEASE, "agent");
            asm volatile("s_waitcnt vmcnt(0)" ::: "memory");
            const unsigned og = xb_add(&bar[XB_TOP], 1u);
            const unsigned tg = og / nx;
            if (og + 1u == (tg + 1u) * nx) xb_add(&bar[XB_TOPGEN], 1u);
            else XB_SPIN(xb_ld(&bar[XB_TOPGEN]) == tg, bar);
            __builtin_amdgcn_fence(__ATOMIC_ACQUIRE, "agent");
            xb_add(&bar[XB_XGEN(b.x)], 1u);
            asm volatile("s_waitcnt vmcnt(0)" ::: "memory");
        } else {
            XB_SPIN(xb_ld(&bar[XB_XGEN(b.x)]) == gen, bar);
            __builtin_amdgcn_fence(__ATOMIC_ACQUIRE, "agent");
            asm volatile("s_waitcnt vmcnt(0)" ::: "memory");
        }
    }
    __syncthreads();
}

__device__ const double ROPE_INVF[32] = {1.0, 0.7498942093324559, 0.5623413251903491, 0.4216965034285822, 0.31622776601683794, 0.23713737056616552, 0.1778279410038923, 0.1333521432163324, 0.1,
    0.07498942093324558, 0.05623413251903491, 0.042169650342858224, 0.03162277660168379, 0.023713737056616554, 0.01778279410038923, 0.01333521432163324, 0.01, 0.007498942093324558,
    0.005623413251903491, 0.004216965034285823, 0.0031622776601683794, 0.0023713737056616554, 0.0017782794100389228, 0.001333521432163324, 0.001, 0.0007498942093324559, 0.0005623413251903491,
    0.00042169650342858224, 0.00031622776601683794, 0.00023713737056616554, 0.00017782794100389227, 0.0001333521432163324};
__device__ __forceinline__ void sincos_d(double a, float& s_out, float& c_out) {
    const double kq = __builtin_rint(a * 0.6366197723675814);
    double r = a - kq * 1.570796325802803; r -= kq * 9.920935796805404e-10;
    const double r2 = r * r;
    double sp = -1.0 / 1307674368000.0; sp = sp * r2 + 1.0 / 6227020800.0; sp = sp * r2 - 1.0 / 39916800.0; sp = sp * r2 + 1.0 / 362880.0; sp = sp * r2 - 1.0 / 5040.0; sp = sp * r2 + 1.0 / 120.0; sp = sp * r2 - 1.0 / 6.0; sp = sp * r2 + 1.0;
    const double sn = sp * r;
    double cp = 1.0 / 20922789888000.0; cp = cp * r2 - 1.0 / 87178291200.0; cp = cp * r2 + 1.0 / 479001600.0; cp = cp * r2 - 1.0 / 3628800.0; cp = cp * r2 + 1.0 / 40320.0; cp = cp * r2 - 1.0 / 720.0; cp = cp * r2 + 1.0 / 24.0; cp = cp * r2 - 0.5; cp = cp * r2 + 1.0;
    const int q = ((int)kq) & 3;
    const double s = (q == 0) ? sn : (q == 1) ? cp : (q == 2) ? -sn : -cp;
    const double c = (q == 0) ? cp : (q == 1) ? -sn : (q == 2) ? -cp : sn;
    s_out = (float)s; c_out = (float)c;
}
struct TrItem { const float* W; bf16_t* dst; int N, k0, n0, drow0, ldd, kofs; };
__device__ __forceinline__ void tr_load(const TrItem& t, float (&tv)[32], int lane) {
#pragma unroll
    for (int i = 0; i < 32; ++i) tv[i] = t.W[(size_t)(t.k0 + 2 * i + (lane >> 5)) * t.N + t.n0 + (lane & 31)];
}
__device__ __forceinline__ void tr_store(const TrItem& t, const float (&tv)[32], LAS float* scr, int lane) {
#pragma unroll
    for (int i = 0; i < 32; ++i) scr[(2 * i + (lane >> 5)) * 33 + (lane & 31)] = tv[i];
    LDS_WAIT(); asm volatile("" ::: "memory");
    const int c = lane & 7;
#pragma unroll
    for (int j = 0; j < 4; ++j) { const int n = (lane >> 3) + 8 * j; const LAS float* s = scr + (8 * c) * 33 + n;
        u32x4 o; o.x = cvt_pk_bf16(s[0 * 33], s[1 * 33]); o.y = cvt_pk_bf16(s[2 * 33], s[3 * 33]); o.z = cvt_pk_bf16(s[4 * 33], s[5 * 33]); o.w = cvt_pk_bf16(s[6 * 33], s[7 * 33]);
        *(u32x4*)(t.dst + (size_t)(t.drow0 + n) * t.ldd + t.kofs + 8 * c) = o; }
    LDS_WAIT(); asm volatile("" ::: "memory");
}
template <class Dec>
__device__ __forceinline__ void tr_run(const Dec& dec, int nit, int gw, int NGW, LAS float* scr, int lane) {
    float ta[32], tb[32]; TrItem A, B;
    int it = gw; if (it < nit) { A = dec(it); tr_load(A, ta, lane); }
    while (it < nit) {
        const int it1 = it + NGW; if (it1 < nit) { B = dec(it1); tr_load(B, tb, lane); }
        tr_store(A, ta, scr, lane);
        const int it2 = it1 + NGW; if (it2 < nit) { A = dec(it2); tr_load(A, ta, lane); }
        if (it1 < nit) tr_store(B, tb, scr, lane);
        it = it2;
    }
}

struct Args { const float* in[21]; float* out; unsigned char* ws; int ph_lo, ph_hi; };
typedef const Args __attribute__((address_space(4))) * KArgsP;
enum { I_X = 0, I_ATTN_NORM, I_W_IN, I_LB, I_OUT_NORM, I_Q_NORM, I_W_UQ, I_KV_NORM, I_W_UKV, I_POOL_W, I_POOL_SCALE, I_W_O, I_FFN_NORM, I_DG, I_DU, I_DD, I_ROUTER, I_MG, I_MU, I_MD, I_FINAL_NORM };
constexpr int NPH = 23;

constexpr int P0_I_WIN = 16 * 70, P0_I_WOP = 8 * 32, P0_I_DGU = 16 * 80, P0_I_DDN = 40 * 32, P0_NIT = 2 * P0_I_WIN + 2 * P0_I_WOP + 2 * P0_I_DGU + P0_I_DDN;
struct DenseDec { KArgsP ap_; unsigned char* ws;
    __device__ __forceinline__ TrItem operator()(int it) const { constexpr int I_WIN = P0_I_WIN, I_WOP = P0_I_WOP, I_DGU = P0_I_DGU; int r = it; TrItem t;
        if (r < 2 * I_WIN) { const int l = r / I_WIN; r -= l * I_WIN; const int kb = r / 70, nb = r % 70;
            t.W = ap_->in[I_W_IN] + (size_t)l * DM * DIN; t.N = DIN; t.k0 = kb * 64; t.n0 = nb * 32; t.dst = (bf16_t*)(ws + WS_WIN) + (size_t)l * DINP * DM; t.drow0 = nb * 32; t.ldd = DM; t.kofs = kb * 64; return t; }
        r -= 2 * I_WIN;
        if (r < 2 * I_WOP) { const int l = r / I_WOP; r -= l * I_WOP; const int kq = r / 32, nb = r % 32; const int kb = kq < 4 ? kq : kq + 8;
            t.W = ap_->in[I_W_O] + (size_t)l * DM * DM; t.N = DM; t.k0 = kb * 64; t.n0 = nb * 32; t.dst = (bf16_t*)(ws + WS_WO) + (size_t)l * DM * DM; t.drow0 = nb * 32; t.ldd = DM; t.kofs = kb * 64; return t; }
        r -= 2 * I_WOP;
        if (r < 2 * I_DGU) { const int up = r / I_DGU; r -= up * I_DGU; const int kb = r / 80, nb = r % 80; const int n0 = nb * 32;
            t.W = ap_->in[up ? I_DU : I_DG]; t.N = DFF; t.k0 = kb * 64; t.n0 = n0; t.dst = (bf16_t*)(ws + WS_WGU); t.drow0 = (n0 >> 7) * 256 + up * 128 + (n0 & 127); t.ldd = DM; t.kofs = kb * 64; return t; }
        r -= 2 * I_DGU;
        { const int kb = r / 32, nb = r % 32; t.W = ap_->in[I_DD]; t.N = DM; t.k0 = kb * 64; t.n0 = nb * 32; t.dst = (bf16_t*)(ws + WS_WD); t.drow0 = nb * 32; t.ldd = DFF; t.kofs = kb * 64; return t; } } };
constexpr int MOE_I_GU = 16 * 112, MOE_I_DN = 56 * 32, MOE_I_E = 2 * MOE_I_GU + MOE_I_DN;
struct MoeDec { const float* mg; const float* mu; const float* md; unsigned char* wsp;
    __device__ __forceinline__ TrItem operator()(int it) const { constexpr int I_GU = MOE_I_GU, I_E = MOE_I_E; const int e = it / I_E; int r = it % I_E; bf16_t* we = (bf16_t*)(wsp + WS_MOEW) + (size_t)e * MOEW_E; TrItem t;
        if (r < 2 * I_GU) { const int up = r / I_GU; r -= up * I_GU; const int kb = r / 112, nb = r % 112, n0 = nb * 32;
            t.W = (up ? mu : mg) + (size_t)e * DM * DFFE; t.N = DFFE; t.k0 = kb * 64; t.n0 = n0; t.dst = we; t.drow0 = (n0 >> 7) * 256 + up * 128 + (n0 & 127); t.ldd = DM; t.kofs = kb * 64; }
        else { r -= 2 * I_GU; const int kb = r / 32, nb = r % 32;
            t.W = md + (size_t)e * DFFE * DM; t.N = DM; t.k0 = kb * 64; t.n0 = nb * 32; t.dst = we + (size_t)2 * DFFE * DM; t.drow0 = nb * 32; t.ldd = DFFE; t.kofs = kb * 64; }
        return t; } };
struct P0StreamDec { DenseDec d; MoeDec m; __device__ __forceinline__ TrItem operator()(int it) const { if (it < P0_NIT) return d(it); return m(it - P0_NIT); } };
__device__ __forceinline__ void p0_stream(KArgsP ap_, LAS unsigned char* lds, int gw, int NGW, int wave, int lane) {
    LAS float* scr = (LAS float*)(lds + wave * 16384);
    P0StreamDec dec{DenseDec{ap_, ap_->ws}, MoeDec{ap_->in[I_MG], ap_->in[I_MU], ap_->in[I_MD], ap_->ws}};
    tr_run(dec, P0_NIT + NE * MOE_I_E, gw, NGW, scr, lane);
}

__device__ __forceinline__ void p0_prologue(KArgsP ap_, LAS unsigned char* lds, int gw, int NGW, int gt, int NGT, int wave, int lane, const int part) {
    unsigned char* ws = ap_->ws;
    LAS float* scr = (LAS float*)(lds + wave * 16384);
    for (int i = gt; i < 2 * 64 * DM / 8; i += NGT) { const int l = i / (64 * DM / 8), r = i % (64 * DM / 8);
        *(u32x4*)((bf16_t*)(ws + WS_WIN) + ((size_t)l * DINP + DIN) * DM + (size_t)r * 8) = (u32x4){0u, 0u, 0u, 0u}; }
    const float qscale = 0.07216878364870322f * 1.4426950408889634f;
    for (int i = gt; i < 2 * 4 * 16 * 256; i += NGT) { const int c = i & 255, jg = (i >> 8) & 15, h = (i >> 12) & 3, l = i >> 14, j0 = jg * 8;
        const float* wuq = ap_->in[I_W_UQ] + (size_t)l * 256 * QW + (size_t)c * QW + h * 192; const float* wk = ap_->in[I_W_UKV] + (size_t)l * 128 * 1024 + (size_t)j0 * 1024 + h * 256;
        float acc[8];
#pragma unroll
        for (int q = 0; q < 8; ++q) acc[q] = 0.f;
#pragma unroll 4
        for (int d = 0; d < 128; d += 4) { const f32x4 x = *(const f32x4*)(wuq + d);
#pragma unroll
            for (int q = 0; q < 8; ++q) { const f32x4 y = *(const f32x4*)(wk + (size_t)q * 1024 + d); acc[q] += (x[0] * y[0] + x[1] * y[1]) + (x[2] * y[2] + x[3] * y[3]); } }
        const float gsc = ap_->in[I_Q_NORM][l * 256 + c] * qscale;
#pragma unroll
        for (int q = 0; q < 8; ++q) ((bf16_t*)(ws + WS_WQ))[((size_t)l * QW + h * 192 + j0 + q) * 256 + c] = f2bf(acc[q] * gsc); }
    for (int i = gt; i < 2 * 4 * 64 * 256; i += NGT) { const int c = i & 255, jj = (i >> 8) & 63, h = (i >> 14) & 3, l = i >> 16;
        const float v = ap_->in[I_W_UQ][(size_t)l * 256 * QW + (size_t)c * QW + h * 192 + 128 + (jj >> 1) + 32 * (jj & 1)];
        ((bf16_t*)(ws + WS_WQ))[((size_t)l * QW + h * 192 + 128 + jj) * 256 + c] = f2bf(v * ap_->in[I_Q_NORM][l * 256 + c] * qscale); }
    for (int i = gt; i < 2 * DM * 64; i += NGT) { const int n = i & 1023, g = (i >> 10) & 63, l = i >> 16, kk0 = g * 8, h = kk0 >> 7, r0 = kk0 & 127;
        const float* wv = ap_->in[I_W_UKV] + (size_t)l * 128 * 1024 + (size_t)r0 * 1024 + h * 256 + 128; const float* wo = ap_->in[I_W_O] + (size_t)l * DM * DM + (size_t)(256 + h * 128) * DM + n;
        float acc[8];
#pragma unroll
        for (int j = 0; j < 8; ++j) acc[j] = 0.f;
#pragma unroll 4
        for (int e = 0; e < 128; e += 4) { const float w0 = wo[(size_t)e * DM], w1 = wo[(size_t)(e + 1) * DM], w2 = wo[(size_t)(e + 2) * DM], w3 = wo[(size_t)(e + 3) * DM];
#pragma unroll
            for (int j = 0; j < 8; ++j) { const f32x4 x = *(const f32x4*)(wv + (size_t)j * 1024 + e); acc[j] += (x[0] * w0 + x[1] * w1) + (x[2] * w2 + x[3] * w3); } }
        *(u32x4*)((bf16_t*)(ws + WS_WO) + (size_t)l * DM * DM + (size_t)n * DM + 256 + kk0) = (u32x4){cvt_pk_bf16(acc[0], acc[1]), cvt_pk_bf16(acc[2], acc[3]), cvt_pk_bf16(acc[4], acc[5]), cvt_pk_bf16(acc[6], acc[7])}; }
    for (int i = gt; i < SEQ * 32; i += NGT) { const int pos = i >> 5, f = i & 31; float s, c; sincos_d((double)pos * ROPE_INVF[f], s, c); ((float*)(ws + WS_COS))[i] = c; ((float*)(ws + WS_SIN))[i] = s; }
    for (int i = gt; i < 512; i += NGT) { const float x0 = ap_->in[I_LB][i], x1 = ap_->in[I_LB][512 + i]; ((float*)(ws + WS_LBS))[i] = 0.f; ((float*)(ws + WS_LBS))[512 + i] = 1.f / (1.f + expf(x0 - x1)); }
}
__device__ __forceinline__ void unpack4(const u32x2 w, f32x4& v) { v[0] = __uint_as_float(w.x << 16); v[1] = __uint_as_float(w.x & 0xffff0000u); v[2] = __uint_as_float(w.y << 16); v[3] = __uint_as_float(w.y & 0xffff0000u); }
template <bool XB16>
__device__ __forceinline__ void norm_to_bf16(const void* xs_, const bf16_t* dl, bf16_t* xd, const float* g, bf16_t* hn, int gw, int NGW, int lane) {
    f32x4 gv[4];
#pragma unroll
    for (int j = 0; j < 4; ++j) gv[j] = *(const f32x4*)(g + 4 * lane + 256 * j);
    for (int m0 = gw; m0 < T; m0 += 2 * NGW) {
        const int m1 = m0 + NGW < T ? m0 + NGW : m0; f32x4 v[2][4]; u32x2 xw[2][4], dw[2][4];
#pragma unroll
        for (int u = 0; u < 2; ++u) { const int m = u ? m1 : m0;
            if (XB16) { const u32x2* xr = (const u32x2*)((const bf16_t*)xs_ + (size_t)m * DM) + lane;
#pragma unroll
                for (int j = 0; j < 4; ++j) xw[u][j] = xr[64 * j]; }
            else { const f32x4* xr = (const f32x4*)((const float*)xs_ + (size_t)m * DM) + lane;
#pragma unroll
                for (int j = 0; j < 4; ++j) v[u][j] = xr[64 * j]; }
            if (dl) { const u32x2* dr = (const u32x2*)(dl + (size_t)m * DM) + lane;
#pragma unroll
                for (int j = 0; j < 4; ++j) dw[u][j] = dr[64 * j]; } }
#pragma unroll
        for (int u = 0; u < 2; ++u) { const int m = u ? m1 : m0; if (u && m1 == m0) break; float s = 0.f;
            if (XB16) {
#pragma unroll
                for (int j = 0; j < 4; ++j) unpack4(xw[u][j], v[u][j]); }
            if (dl) {
#pragma unroll
                for (int j = 0; j < 4; ++j) { f32x4 d; unpack4(dw[u][j], d); v[u][j] += d;
                    u32x2 w; w.x = cvt_pk_bf16(v[u][j][0], v[u][j][1]); w.y = cvt_pk_bf16(v[u][j][2], v[u][j][3]); *(u32x2*)(xd + (size_t)m * DM + 4 * lane + 256 * j) = w; } }
#pragma unroll
            for (int j = 0; j < 4; ++j) s += (v[u][j][0] * v[u][j][0] + v[u][j][1] * v[u][j][1]) + (v[u][j][2] * v[u][j][2] + v[u][j][3] * v[u][j][3]);
            const float rstd = 1.0f / sqrtf(wave_sum(s) * (1.f / DM) + EPS);
#pragma unroll
            for (int j = 0; j < 4; ++j) { const f32x4 o = v[u][j] * rstd * gv[j]; u32x2 w; w.x = cvt_pk_bf16(o[0], o[1]); w.y = cvt_pk_bf16(o[2], o[3]); *(u32x2*)(hn + (size_t)m * DM + 4 * lane + 256 * j) = w; } }
    }
}
__device__ __forceinline__ void norm_final(const bf16_t* x, float* out, const float* g, int gw, int NGW, int lane) {
    f32x4 gv[4];
#pragma unroll
    for (int j = 0; j < 4; ++j) gv[j] = *(const f32x4*)(g + 4 * lane + 256 * j);
    for (int m0 = gw; m0 < T; m0 += 2 * NGW) {
        const int m1 = m0 + NGW < T ? m0 + NGW : m0; u32x2 xw[2][4];
#pragma unroll
        for (int u = 0; u < 2; ++u) { const int m = u ? m1 : m0; const u32x2* xr = (const u32x2*)(x + (size_t)m * DM) + lane;
#pragma unroll
            for (int j = 0; j < 4; ++j) xw[u][j] = xr[64 * j]; }
#pragma unroll
        for (int u = 0; u < 2; ++u) { const int m = u ? m1 : m0; if (u && m1 == m0) break; float s = 0.f; f32x4 v[4];
#pragma unroll
            for (int j = 0; j < 4; ++j) { unpack4(xw[u][j], v[j]); s += (v[j][0] * v[j][0] + v[j][1] * v[j][1]) + (v[j][2] * v[j][2] + v[j][3] * v[j][3]); }
            const float rstd = 1.0f / sqrtf(wave_sum(s) * (1.f / DM) + EPS);
            f32x4* xw4 = (f32x4*)(out + (size_t)m * DM) + lane;
#pragma unroll
            for (int j = 0; j < 4; ++j) xw4[64 * j] = v[j] * rstd * gv[j]; }
    }
}
template <bool SLIM>
__device__ __forceinline__ void norm_router(bf16_t* x, const bf16_t* dl, const float* g, const float* router, bf16_t* hn, int* tok_e, float* tok_g, int* counts, LAS unsigned char* lds, int bx, int G, int tid, int wave, int lane) {
    LAS float* rl = (LAS float*)lds;
    LAS int* cl = (LAS int*)(lds + 32768);
    for (int i = tid; i < DM * NE; i += NWAVES * 64) rl[i] = router[i];
    f32x4 gv[4];
#pragma unroll
    for (int j = 0; j < 4; ++j) gv[j] = *(const f32x4*)(g + 4 * lane + 256 * j);
    for (int rg = bx; rg < T / 128; rg += G) {
        if (tid < 16) cl[tid] = 0;
        __syncthreads();
        u32x2 dwn[4], xwn[4];
        { const int m = rg * 128 + wave * 16; const u32x2* xr = (const u32x2*)(x + (size_t)m * DM) + lane; const u32x2* dr = (const u32x2*)(dl + (size_t)m * DM) + lane;
#pragma unroll
          for (int j = 0; j < 4; ++j) { if constexpr (!SLIM) dwn[j] = dr[64 * j]; xwn[j] = xr[64 * j]; } }
        for (int rr = 0; rr < 16; ++rr) { const int m = rg * 128 + wave * 16 + rr;
            u32x2* xr = (u32x2*)(x + (size_t)m * DM) + lane; f32x4 v[4]; u32x2 dw[4], xw[4]; float s = 0.f;
#pragma unroll
            for (int j = 0; j < 4; ++j) { dw[j] = dwn[j]; xw[j] = xwn[j]; }
            if (rr + 1 < 16) { const u32x2* xq = (const u32x2*)(x + (size_t)(m + 1) * DM) + lane; const u32x2* dq = (const u32x2*)(dl + (size_t)(m + 1) * DM) + lane;
#pragma unroll
                for (int j = 0; j < 4; ++j) { if constexpr (!SLIM) dwn[j] = dq[64 * j]; xwn[j] = xq[64 * j]; } }
#pragma unroll
            for (int j = 0; j < 4; ++j) { unpack4(xw[j], v[j]);
                if constexpr (!SLIM) { f32x4 d; unpack4(dw[j], d); v[j] += d; u32x2 w; w.x = cvt_pk_bf16(v[j][0], v[j][1]); w.y = cvt_pk_bf16(v[j][2], v[j][3]); xr[64 * j] = w; }
                s += (v[j][0] * v[j][0] + v[j][1] * v[j][1]) + (v[j][2] * v[j][2] + v[j][3] * v[j][3]); }
            const float rstd = 1.0f / sqrtf(wave_sum(s) * (1.f / DM) + EPS);
            float lg[NE];
#pragma unroll
            for (int e = 0; e < NE; ++e) lg[e] = 0.f;
#pragma unroll
            for (int j = 0; j < 4; ++j) { const f32x4 o = v[j] * rstd * gv[j]; if constexpr (!SLIM) { u32x2 w; w.x = cvt_pk_bf16(o[0], o[1]); w.y = cvt_pk_bf16(o[2], o[3]); *(u32x2*)(hn + (size_t)m * DM + 4 * lane + 256 * j) = w; }
#pragma unroll
                for (int i = 0; i < 4; ++i) { const LAS f32x4* rp = (const LAS f32x4*)(rl + (size_t)(4 * lane + 256 * j + i) * NE); const f32x4 r0 = rp[0], r1 = rp[1];
                    lg[0] += o[i] * r0[0]; lg[1] += o[i] * r0[1]; lg[2] += o[i] * r0[2]; lg[3] += o[i] * r0[3]; lg[4] += o[i] * r1[0]; lg[5] += o[i] * r1[1]; lg[6] += o[i] * r1[2]; lg[7] += o[i] * r1[3]; } }
#pragma unroll
            for (int e = 0; e < NE; ++e) lg[e] = wave_sum(lg[e]);
            int i1 = 0; float v1 = lg[0];
#pragma unroll
            for (int e = 1; e < NE; ++e) if (lg[e] > v1) { v1 = lg[e]; i1 = e; }
            int i2 = -1; float v2 = -3.0e38f;
#pragma unroll
            for (int e = 0; e < NE; ++e) if (e != i1 && lg[e] > v2) { v2 = lg[e]; i2 = e; }
            const float ex = expf(v2 - v1), g1 = 1.f / (1.f + ex), g2 = ex * g1;
            if (lane == 0) { tok_e[2 * m] = i1; tok_e[2 * m + 1] = i2; tok_g[2 * m] = g1; tok_g[2 * m + 1] = g2; atomicAdd((int*)&cl[i1], 1); atomicAdd((int*)&cl[8 + i2], 1); }
        }
        __syncthreads();
        if (tid < 16) counts[rg * 16 + tid] = cl[tid];
        __syncthreads();
    }
}
__device__ __forceinline__ void route_tables(const int* tok_e, const float* tok_g, const int* counts, int* slot_tok, float* slot_g, int* tile_e, LAS unsigned char* lds, int bx, int G, int tid) {
    LAS int* pre = (LAS int*)lds;
    LAS int* off = (LAS int*)(lds + 257 * 16 * 4);
    LAS int* el = off + 16;
    { LAS int* segt = el + 256;
      for (int i = tid; i < 256 * 16; i += NWAVES * 64) pre[i] = counts[i];
      __syncthreads();
      const int col = tid & 15, seg = (tid >> 4) & 15;
      if (tid < 256) { int run = 0; for (int k = 0; k < 16; ++k) { const int rg = seg * 16 + k; const int v = pre[rg * 16 + col]; pre[rg * 16 + col] = run; run += v; } segt[seg * 16 + col] = run; }
      __syncthreads();
      if (tid < 256) { int base = 0; for (int s2 = 0; s2 < seg; ++s2) base += segt[s2 * 16 + col];
          for (int k = 0; k < 16; ++k) pre[(seg * 16 + k) * 16 + col] += base;
          if (seg == 15) pre[256 * 16 + col] = base + segt[15 * 16 + col]; }
      __syncthreads(); }
    if (tid < 2) { int run = 0; for (int e = 0; e < NE; ++e) { off[tid * 8 + e] = run; run += (pre[256 * 16 + tid * 8 + e] + 255) & ~255; }
        if (bx == 0) { tile_e[tid * 256] = run >> 8; for (int e = 0; e < NE; ++e) { const int t0 = off[tid * 8 + e] >> 8, nt = (pre[256 * 16 + tid * 8 + e] + 255) >> 8; for (int t = 0; t < nt; ++t) tile_e[tid * 256 + 1 + t0 + t] = e; } } }
    __syncthreads();
    if (bx == 0) {
        for (int i = tid; i < 16 * 256; i += NWAVES * 64) { const int re = i >> 8, j = i & 255, r = re >> 3; const int tot = pre[256 * 16 + re], padn = ((tot + 255) & ~255) - tot;
            if (j < padn) { slot_tok[r * MOE_ROWS + off[re] + tot + j] = -1; slot_g[r * MOE_ROWS + off[re] + tot + j] = 0.f; } } }
    for (int rg = bx; rg < T / 128; rg += G) {
        if (tid < 256) { const int r = tid >> 7, j = tid & 127; el[r * 128 + j] = tok_e[2 * (rg * 128 + j) + r]; }
        __syncthreads();
        if (tid < 256) { const int r = tid >> 7, j = tid & 127, m = rg * 128 + j, e = el[r * 128 + j]; int loc = 0;
            for (int jj = 0; jj < j; ++jj) loc += (el[r * 128 + jj] == e) ? 1 : 0;
            const int slot = off[r * 8 + e] + pre[rg * 16 + r * 8 + e] + loc;
            slot_tok[r * MOE_ROWS + slot] = m; slot_g[r * MOE_ROWS + slot] = tok_g[2 * m + r]; }
        __syncthreads();
    }
}

__device__ __forceinline__ void prep_tokens(const bf16_t* proj, const float* kvg, const float* cosT, const float* sinT, float* rstdq, bf16_t* klat, bf16_t* krope, int gw, int NGW, int lane) {
    const float g0 = kvg[2 * lane], g1 = kvg[2 * lane + 1];
    constexpr int NT = 4;
    for (int mb = gw; mb < T; mb += NT * NGW) {
        u32x2 cq[NT]; unsigned ck[NT]; unsigned short xa[NT], xb[NT]; float cc[NT], sn[NT];
#pragma unroll
        for (int u = 0; u < NT; ++u) { const int m = mb + u * NGW < T ? mb + u * NGW : mb; const bf16_t* pr = proj + (size_t)m * DINP;
            cq[u] = *(const u32x2*)(pr + COL_CQ + 4 * lane); ck[u] = *(const unsigned*)(pr + COL_CKV + 2 * lane);
            const int pos = m & (SEQ - 1), l5 = lane & 31; xa[u] = pr[COL_KPE + l5]; xb[u] = pr[COL_KPE + 32 + l5]; cc[u] = cosT[pos * 32 + l5]; sn[u] = sinT[pos * 32 + l5]; }
#pragma unroll
        for (int u = 0; u < NT; ++u) { const int m = mb + u * NGW; if (m >= T) break;
            const float a0 = __uint_as_float(cq[u].x << 16), a1 = __uint_as_float(cq[u].x & 0xffff0000u), a2 = __uint_as_float(cq[u].y << 16), a3 = __uint_as_float(cq[u].y & 0xffff0000u);
            const float k0 = __uint_as_float(ck[u] << 16), k1 = __uint_as_float(ck[u] & 0xffff0000u);
            const float sq = wave_sum((a0 * a0 + a1 * a1) + (a2 * a2 + a3 * a3)), sk = wave_sum(k0 * k0 + k1 * k1);
            if (lane == 0) rstdq[m] = 1.0f / sqrtf(sq * (1.f / 256.f) + EPS);
            const float rk = 1.0f / sqrtf(sk * (1.f / 128.f) + EPS);
            *(unsigned*)(klat + (size_t)m * 128 + 2 * lane) = cvt_pk_bf16(k0 * rk * g0, k1 * rk * g1);
            if (lane < 32) { const float x1 = bf2f(xa[u]), x2 = bf2f(xb[u]);
                *(unsigned*)(krope + (size_t)m * 64 + 2 * lane) = cvt_pk_bf16(x1 * cc[u] - x2 * sn[u], x1 * sn[u] + x2 * cc[u]); } }
    }
}

__device__ __forceinline__ void pool_phase(const bf16_t* proj, const float* pw, const float* pscale, bf16_t* ocat, LAS unsigned char* lds, int bx, int G, int tid) {
    constexpr int PP = 264, WP = 72;
    LAS bf16_t* xs = (LAS bf16_t*)lds;
    LAS bf16_t* pl = (LAS bf16_t*)(lds + 40960);
    LAS bf16_t* wt = (LAS bf16_t*)(lds + 40960 + 64 * PP * 2);
    const int lane = tid & 63, wave = tid >> 6, r32 = lane & 31, hi = lane >> 5;
    for (int i = tid; i < 4 * 64 * 64; i += NWAVES * 64) { const int g = i >> 12, c = (i >> 6) & 63, d = i & 63; wt[(g * 64 + d) * WP + c] = f2bf(pw[i]); }
    const int ch = tid & 255, half = tid >> 8, gch = ch >> 6, w = 2 << gch;
    const int g = wave >> 1, tb = wave & 1;
    const float sc0 = pscale[g * 64 + r32], sc1 = pscale[g * 64 + 32 + r32];
    for (int tile = bx; tile < T / 64; tile += G) {
        const int tok0 = tile * 64, pos0 = tok0 & (SEQ - 1);
#pragma unroll
        for (int i = 0; i < 5; ++i) { const int idx = tid + i * 512, r = idx >> 5, c8 = (idx & 31) * 8; u32x4 v = {0u, 0u, 0u, 0u};
            if (pos0 - 16 + r >= 0) v = *(const u32x4*)(proj + (size_t)(tok0 - 16 + r) * DINP + COL_XP + c8);
            *(LAS u32x4*)(xs + r * 256 + c8) = v; }
        __syncthreads();
        { const int t0 = half * 32; float s = 0.f;
          for (int j = 1; j < w; ++j) s += bf2f(xs[(t0 + 16 - j) * 256 + ch]);
          for (int tt = 0; tt < 32; ++tt) { const int t = t0 + tt, r = t + 16; const float xv = bf2f(xs[r * 256 + ch]); s += xv;
              const int pc = pos0 + t + 1; const float cnt = (float)(pc < w ? pc : w);
              pl[t * PP + ch] = f2bf(s / cnt - xv);
              s -= bf2f(xs[(r - w + 1) * 256 + ch]); } }
        __syncthreads();
        { f32x16 acc0 = {}, acc1 = {};
#pragma unroll
          for (int ks = 0; ks < 4; ++ks) { const bf16x8 af = *(const LAS bf16x8*)(pl + (tb * 32 + r32) * PP + g * 64 + ks * 16 + 8 * hi);
              const bf16x8 b0 = *(const LAS bf16x8*)(wt + (g * 64 + r32) * WP + ks * 16 + 8 * hi), b1 = *(const LAS bf16x8*)(wt + (g * 64 + 32 + r32) * WP + ks * 16 + 8 * hi);
              acc0 = __builtin_amdgcn_mfma_f32_32x32x16_bf16(af, b0, acc0, 0, 0, 0); acc1 = __builtin_amdgcn_mfma_f32_32x32x16_bf16(af, b1, acc1, 0, 0, 0); }
          bf16_t* op = ocat + (size_t)(tok0 + tb * 32) * DM + 768 + g * 64 + r32;
#pragma unroll
          for (int i = 0; i < 16; ++i) { const int row = (i & 3) + 8 * (i >> 2) + 4 * hi; const float v0 = acc0[i] * sc0, v1 = acc1[i] * sc1;
              const float n0 = xlane1(v0), n1 = xlane1(v1);
              if ((r32 & 1) == 0) { *(unsigned*)(op + (size_t)row * DM) = cvt_pk_bf16(v0, n0); *(unsigned*)(op + (size_t)row * DM + 32) = cvt_pk_bf16(v1, n1); } } }
        __syncthreads();
    }
}

__device__ __forceinline__ void hg_load16(const bf16_t* p, bf16_t (&z)[16]) {
#pragma unroll
    for (int j = 0; j < 16; ++j) z[j] = p[(size_t)j * DINP];
}
__device__ __forceinline__ void hg_gates(const bf16_t (&zr)[16], const float lb, LAS float* qs, int k, int q, float (&bc)[16], float (&kk)[16], float& blast, float& bmid) {
    const float omlb = 1.f - lb;
    float run = 0.f;
#pragma unroll
    for (int j = 0; j < 16; ++j) { const float z = bf2f(zr[j]);
        const float e = fast_exp(fminf(-z, 80.f)), sg = __builtin_amdgcn_rcpf(1.f + e);
        const float f = lb + omlb * sg; run += __builtin_amdgcn_logf(fmaxf(f, 1e-20f)) * 0.6931471805599453f; bc[j] = run; kk[j] = omlb * e * sg; }
    qs[q * 128 + k] = run;
    __syncthreads();
    const float s0 = qs[k], s1 = qs[128 + k], s2 = qs[256 + k], s3 = qs[384 + k];
    const float base = q == 0 ? 0.f : q == 1 ? s0 : q == 2 ? s0 + s1 : s0 + s1 + s2;
#pragma unroll
    for (int j = 0; j < 16; ++j) bc[j] += base;
    blast = (s0 + s1) + (s2 + s3); bmid = s0 + s1;
}
__device__ __forceinline__ f32x16 mfma32(bf16x8 a, bf16x8 b, f32x16 c) { return __builtin_amdgcn_mfma_f32_32x32x16_bf16(a, b, c, 0, 0, 0); }
constexpr int HG_PK = 136, HG_PS = 72;
#define HG_UNIT(u, b_, h_, tok0_) const int b_ = (u) >> 10, h_ = ((u) >> 8) & 3, tok0_ = b_ * SEQ + ((u) & 255) * 64
__device__ __forceinline__ void hgrn_local(const bf16_t* proj, const float* lbs_l, bf16_t* ubuf, float* dvec, LAS unsigned char* lds, int bx, int G, int tid, int wave, int lane) {
    LAS float* qs = (LAS float*)lds; LAS bf16_t* Kt = (LAS bf16_t*)(lds + 2048); LAS bf16_t* Vt = (LAS bf16_t*)(lds + 2048 + 128 * HG_PS * 2);
    const int k = tid & 127, q = tid >> 7, r32 = lane & 31, hi = lane >> 5, vs = tid >> 3, v0 = (tid & 7) * 8;
    bf16_t zc[16]; bf16x8 vc;
    if (bx < NUNIT) { HG_UNIT(bx, b, h, tok0); hg_load16(proj + (size_t)(tok0 + q * 16) * DINP + COL_HF + h * 128 + k, zc); vc = *(const bf16x8*)(proj + (size_t)(tok0 + vs) * DINP + COL_HI + h * 64 + v0); }
    for (int u = bx; u < NUNIT; u += G) {
        HG_UNIT(u, b, h, tok0); (void)b; (void)tok0;
        const float lb = lbs_l[h * 128 + k];
        bf16_t zn[16]; bf16x8 vn;
        { const int un = (u + G < NUNIT) ? u + G : u; HG_UNIT(un, bn, hn, tokn); (void)bn;
          hg_load16(proj + (size_t)(tokn + q * 16) * DINP + COL_HF + hn * 128 + k, zn); vn = *(const bf16x8*)(proj + (size_t)(tokn + vs) * DINP + COL_HI + hn * 64 + v0); }
        float bc[16], kk[16], blast, bmid;
        hg_gates(zc, lb, qs, k, q, bc, kk, blast, bmid);
        { unsigned w[8];
#pragma unroll
          for (int j = 0; j < 8; ++j) w[j] = cvt_pk_bf16(kk[2 * j] * fast_exp(blast - bc[2 * j]), kk[2 * j + 1] * fast_exp(blast - bc[2 * j + 1]));
          *(LAS u32x4*)(Kt + k * HG_PS + q * 16) = (u32x4){w[0], w[1], w[2], w[3]}; *(LAS u32x4*)(Kt + k * HG_PS + q * 16 + 8) = (u32x4){w[4], w[5], w[6], w[7]}; }
#pragma unroll
        for (int j = 0; j < 8; ++j) Vt[(v0 + j) * HG_PS + vs] = (bf16_t)vc[j];
        if (q == 0) dvec[(size_t)u * 128 + k] = fast_exp(blast);
        __syncthreads();
        { const int vb = wave >> 2, kb = wave & 3; f32x16 acc = {};
#pragma unroll
          for (int ks = 0; ks < 4; ++ks) { const bf16x8 af = *(const LAS bf16x8*)(Vt + (vb * 32 + r32) * HG_PS + ks * 16 + 8 * hi), bfr = *(const LAS bf16x8*)(Kt + (kb * 32 + r32) * HG_PS + ks * 16 + 8 * hi);
              acc = mfma32(af, bfr, acc); }
          bf16_t* up = ubuf + ((size_t)u * 64 + vb * 32) * 128 + kb * 32 + r32;
#pragma unroll
          for (int i = 0; i < 16; ++i) { const float vn = xlane1(acc[i]); if ((r32 & 1) == 0) *(unsigned*)(up + (size_t)((i & 3) + 8 * (i >> 2) + 4 * hi) * 128) = cvt_pk_bf16(acc[i], vn); } }
#pragma unroll
        for (int j = 0; j < 16; ++j) zc[j] = zn[j];
        vc = vn;
        __syncthreads();
    }
}
__device__ __forceinline__ void hgrn_scan(bf16_t* ubuf, const float* dvec, int bx, int G, int tid) {
    for (int j = (G >= 256 ? bx - (G - 128) : bx); j < 128; j += G) {
        if (j < 0 || tid >= 256) continue;
        const int bh = j >> 4, e = (j & 15) * 512 + tid * 2, k = e & 127;
        unsigned* up = (unsigned*)(ubuf + (size_t)bh * 256 * 8192 + e); const f32x2* dp = (const f32x2*)(dvec + (size_t)bh * 256 * 128 + k);
        float S0 = 0.f, S1 = 0.f;
        for (int c = 0; c < NCHUNK; c += 64) { unsigned uv[64]; f32x2 dv[64];
#pragma unroll
            for (int i = 0; i < 64; ++i) { uv[i] = up[(size_t)(c + i) * 4096]; dv[i] = dp[(size_t)(c + i) * 64]; }
#pragma unroll
            for (int i = 0; i < 64; ++i) { up[(size_t)(c + i) * 4096] = cvt_pk_bf16(S0, S1); S0 = dv[i][0] * S0 + __uint_as_float(uv[i] << 16); S1 = dv[i][1] * S1 + __uint_as_float(uv[i] & 0xffff0000u); } }
    }
}
__device__ __forceinline__ void hgrn_out(const bf16_t* proj, const float* lbs_l, const bf16_t* ubuf, const float* onorm, bf16_t* ocat, LAS unsigned char* lds, int bx, int G, int tid, int wave, int lane) {
    LAS float* qs = (LAS float*)lds;
    LAS bf16_t* Qi = (LAS bf16_t*)(lds + 2048); LAS bf16_t* Qp = Qi + 64 * HG_PK; LAS bf16_t* Kp = Qp + 64 * HG_PK; LAS bf16_t* St = Kp + 64 * HG_PK;
    LAS bf16_t* Vt = St + 64 * HG_PK; LAS bf16_t* Aq = Vt + 64 * HG_PS; LAS float* Ol = (LAS float*)(Aq + 64 * HG_PS);
    const int k = tid & 127, q = tid >> 7, r32 = lane & 31, hi = lane >> 5, vs = tid >> 3, v0 = (tid & 7) * 8, k0 = (tid & 7) * 16;
    bf16_t zc[16], qc[16]; bf16x8 vc;
    if (bx < NUNIT) { HG_UNIT(bx, b, h, tok0); hg_load16(proj + (size_t)(tok0 + q * 16) * DINP + COL_HF + h * 128 + k, zc); hg_load16(proj + (size_t)(tok0 + q * 16) * DINP + COL_HQ + h * 128 + k, qc);
        vc = *(const bf16x8*)(proj + (size_t)(tok0 + vs) * DINP + COL_HI + h * 64 + v0); }
    for (int u = bx; u < NUNIT; u += G) {
        HG_UNIT(u, b, h, tok0); (void)b;
        const float lb = lbs_l[h * 128 + k];
        const bf16_t* sp = ubuf + ((size_t)u * 64 + vs) * 128 + k0;
        const u32x4 a0 = *(const u32x4*)sp, a1 = *(const u32x4*)(sp + 8);
        const bf16x8 gg = *(const bf16x8*)(proj + (size_t)(tok0 + vs) * DINP + COL_HG + h * 64 + v0);
        bf16_t zn[16], qn[16]; bf16x8 vn;
        { const int un = (u + G < NUNIT) ? u + G : u; HG_UNIT(un, bn, hn, tokn); (void)bn;
          hg_load16(proj + (size_t)(tokn + q * 16) * DINP + COL_HF + hn * 128 + k, zn); hg_load16(proj + (size_t)(tokn + q * 16) * DINP + COL_HQ + hn * 128 + k, qn);
          vn = *(const bf16x8*)(proj + (size_t)(tokn + vs) * DINP + COL_HI + hn * 64 + v0); }
        float bc[16], kk[16], blast, bmid;
        hg_gates(zc, lb, qs, k, q, bc, kk, blast, bmid);
#pragma unroll
        for (int j = 0; j < 16; ++j) { const int t = q * 16 + j; const float qr = bf2f(qc[j]); const float qf = qr * sigmoidf_(qr);
            Qi[t * HG_PK + k] = f2bf(qf * fast_exp(bc[j])); Qp[t * HG_PK + k] = f2bf(qf * fast_exp(bc[j] - bmid)); Kp[t * HG_PK + k] = f2bf(kk[j] * fast_exp(bmid - bc[j])); }
        *(LAS u32x4*)(St + vs * HG_PK + k0) = a0;
        *(LAS u32x4*)(St + vs * HG_PK + k0 + 8) = a1;
#pragma unroll
        for (int j = 0; j < 8; ++j) Vt[(v0 + j) * HG_PS + vs] = (bf16_t)vc[j];
        __syncthreads();
        f32x16 oacc = {};
        const int tb = (wave >> 1) & 1, vb = wave & 1;
        if (wave < 4) {
#pragma unroll
            for (int kc = 0; kc < 8; ++kc) { const bf16x8 af = *(const LAS bf16x8*)(Qi + (tb * 32 + r32) * HG_PK + kc * 16 + 8 * hi), bfr = *(const LAS bf16x8*)(St + (vb * 32 + r32) * HG_PK + kc * 16 + 8 * hi);
                oacc = mfma32(af, bfr, oacc); }
        } else if (wave < 7) {
            const int tb2 = wave == 4 ? 0 : 1, sb = wave == 6 ? 1 : 0; f32x16 sacc = {};
#pragma unroll
            for (int kc = 0; kc < 8; ++kc) { const bf16x8 af = *(const LAS bf16x8*)(Qp + (tb2 * 32 + r32) * HG_PK + kc * 16 + 8 * hi), bfr = *(const LAS bf16x8*)(Kp + (sb * 32 + r32) * HG_PK + kc * 16 + 8 * hi);
                sacc = mfma32(af, bfr, sacc); }
#pragma unroll
            for (int i = 0; i < 16; ++i) { const int t = tb2 * 32 + (i & 3) + 8 * (i >> 2) + 4 * hi, s = sb * 32 + r32; Aq[t * HG_PS + s] = (s <= t) ? f2bf(sacc[i]) : (bf16_t)0; }
        }
        __syncthreads();
        if (wave < 4) {
            const int nks = tb == 0 ? 2 : 4;
            for (int ks = 0; ks < nks; ++ks) { const bf16x8 af = *(const LAS bf16x8*)(Aq + (tb * 32 + r32) * HG_PS + ks * 16 + 8 * hi), bfr = *(const LAS bf16x8*)(Vt + (vb * 32 + r32) * HG_PS + ks * 16 + 8 * hi);
                oacc = mfma32(af, bfr, oacc); }
#pragma unroll
            for (int i = 0; i < 16; ++i) Ol[(tb * 32 + (i & 3) + 8 * (i >> 2) + 4 * hi) * 68 + vb * 32 + r32] = oacc[i];
        }
        __syncthreads();
        { const int t = vs; const LAS f32x4* op = (const LAS f32x4*)(Ol + t * 68 + v0); const f32x4 o0 = op[0], o1 = op[1];
          float ss = (o0[0] * o0[0] + o0[1] * o0[1]) + (o0[2] * o0[2] + o0[3] * o0[3]) + (o1[0] * o1[0] + o1[1] * o1[1]) + (o1[2] * o1[2] + o1[3] * o1[3]);
          ss = sum8(ss);
          const float rstd = 1.0f / sqrtf(ss * (1.f / 64.f) + EPS);
          const f32x4 n0 = *(const f32x4*)(onorm + h * 64 + v0), n1 = *(const f32x4*)(onorm + h * 64 + v0 + 4);
          float r[8];
#pragma unroll
          for (int j = 0; j < 8; ++j) { const float gv = bf2f((bf16_t)gg[j]); const float ov = j < 4 ? o0[j] : o1[j - 4]; const float nv = j < 4 ? n0[j] : n1[j - 4]; r[j] = ov * rstd * nv * (gv * sigmoidf_(gv)); }
          *(u32x4*)(ocat + (size_t)(tok0 + t) * DM + h * 64 + v0) = (u32x4){cvt_pk_bf16(r[0], r[1]), cvt_pk_bf16(r[2], r[3]), cvt_pk_bf16(r[4], r[5]), cvt_pk_bf16(r[6], r[7])}; }
#pragma unroll
        for (int j = 0; j < 16; ++j) { zc[j] = zn[j]; qc[j] = qn[j]; }
        vc = vn;
        __syncthreads();
    }
}

typedef const Args __attribute__((address_space(4))) * KArgsPtr;
#ifndef ONLY_KIND
#define ONLY_KIND -1
#endif
#ifndef KIND_MASK
#define KIND_MASK 0xFFFFFFFFu
#endif
#define KIND(k) ((ONLY_KIND < 0 || ONLY_KIND == (k)) && ((KIND_MASK >> (k)) & 1u))
#define IN(k) (lo <= (k) && (k) < hi)
#ifndef REPEAT_KIND
#define REPEAT_KIND -1
#endif
#ifndef REPEAT_N
#define REPEAT_N 3
#endif
#define REP(k) for (int rep_ = 0; rep_ < ((REPEAT_KIND) == (k) ? REPEAT_N : 1); ++rep_)
#define SEAM(k) do { if (MK_ONE_LAUNCH && IN(k) && IN((k) + 1)) xcd_barrier(bar, (wave_s * 64 + (int)__builtin_amdgcn_mbcnt_hi(~0u, __builtin_amdgcn_mbcnt_lo(~0u, 0u))) == 0); } while (0)
#define PH_BEGIN() int tid = wave_s * 64 + (int)__builtin_amdgcn_mbcnt_hi(~0u, __builtin_amdgcn_mbcnt_lo(~0u, 0u)); asm volatile("" : "+v"(tid)); const int lane = tid & 63, wave = __builtin_amdgcn_readfirstlane(tid >> 6), gw = bx * NWAVES + wave, gt = bx * (NWAVES * 64) + tid; \
    (void)lane; (void)wave; (void)gw; (void)gt; KArgsPtr ap = (KArgsPtr)__builtin_amdgcn_kernarg_segment_ptr(); asm volatile("" : "+s"(ap)); unsigned char* const ws = ap->ws; (void)ws

template <int l>
__device__ __forceinline__ void layer_body(LAS unsigned char* L, unsigned char* lds, const int lo, const int hi, const XcdBarrier& bar, const int G, const int bx, const int NGW, const int NGT, const int wave_s) {
    constexpr int pb = l == 0 ? 1 : 10;
        if (KIND(1) && IN(l == 0 ? 0 : pb + 0)) REP(1) { PH_BEGIN(); if constexpr (l == 0) norm_to_bf16<false>(ap->in[I_X], nullptr, nullptr, ap->in[I_ATTN_NORM], (bf16_t*)(ws + WS_HN), gw, NGW, lane); }
        if constexpr (l == 0) SEAM(0);
        if (KIND(2) && IN(pb + 1)) REP(2) { PH_BEGIN(); pg8::DenseSched S; S.init(T, DINP, DM, (const bf16_t*)(ws + WS_WIN) + (size_t)l * DINP * DM, G, bx); pg8::EpiBf16 E{(bf16_t*)(ws + WS_PROJ), DINP};
            pg8::gemm_phase<pg8::EpiBf16, pg8::DenseSched, true>(L, (const bf16_t*)(ws + WS_HN), DM, DM, S, E, tid); }
        SEAM(pb + 1);
        if (KIND(3) && IN(pb + 2)) REP(3) {
            { PH_BEGIN(); prep_tokens((const bf16_t*)(ws + WS_PROJ), ap->in[I_KV_NORM] + l * 128, (const float*)(ws + WS_COS), (const float*)(ws + WS_SIN), (float*)(ws + WS_RSTDQ), (bf16_t*)(ws + WS_KLAT), (bf16_t*)(ws + WS_KROPE), gw, NGW, lane); }
            { PH_BEGIN(); pool_phase((const bf16_t*)(ws + WS_PROJ), ap->in[I_POOL_W] + (size_t)l * 4 * 64 * 64, ap->in[I_POOL_SCALE] + l * 256, (bf16_t*)(ws + WS_OCAT), L, bx, G, tid); }
            { PH_BEGIN(); hgrn_local((const bf16_t*)(ws + WS_PROJ), (const float*)(ws + WS_LBS) + l * 512, (bf16_t*)(ws + WS_UBUF), (float*)(ws + WS_DVEC), L, bx, G, tid, wave, lane); }
        }
        SEAM(pb + 2);
        if ((KIND(4) || KIND(16)) && IN(pb + 3)) {
            if (KIND(16)) { PH_BEGIN(); hgrn_scan((bf16_t*)(ws + WS_UBUF), (const float*)(ws + WS_DVEC), bx, G, tid); }
            if (KIND(4)) REP(4) { PH_BEGIN(); pg8::DenseSched S; S.init(T, QW, 256, (const bf16_t*)(ws + WS_WQ) + (size_t)l * QW * 256, G, bx);
                pg8::EpiQ E{(bf16_t*)(ws + WS_Q), (const float*)(ws + WS_RSTDQ), (const float*)(ws + WS_COS), (const float*)(ws + WS_SIN)};
                pg8::gemm_phase<pg8::EpiQ, pg8::DenseSched, true>(L, (const bf16_t*)(ws + WS_PROJ) + COL_CQ, DINP, 256, S, E, tid); }
        }
        SEAM(pb + 3);
        if ((KIND(5) || KIND(15)) && IN(pb + 4)) {
            if (KIND(15)) REP(15) { PH_BEGIN(); hgrn_out((const bf16_t*)(ws + WS_PROJ), (const float*)(ws + WS_LBS) + l * 512, (const bf16_t*)(ws + WS_UBUF), ap->in[I_OUT_NORM] + l * 256, (bf16_t*)(ws + WS_OCAT), L, bx, G, tid, wave, lane); }
            if (KIND(5)) REP(5) { PH_BEGIN();
                for (int item = bx; item < 8 * 32; item += G)
                    for (int ps = 0; ps < 2; ++ps) { const int b = item & 1, h = (item >> 1) & 3, x = item >> 3, qb = ps ? x : 63 - x; att::BlockRef r;
                        r.Q = (const bf16_t*)(ws + WS_Q) + ((size_t)b * SEQ + (size_t)qb * 256) * QW + h * 192; r.Kl = (const bf16_t*)(ws + WS_KLAT) + (size_t)b * SEQ * 128; r.Kr = (const bf16_t*)(ws + WS_KROPE) + (size_t)b * SEQ * 64;
                        r.O = (bf16_t*)(ws + WS_OCAT) + ((size_t)b * SEQ + (size_t)qb * 256) * DM + 256 + h * 128; r.P0 = qb * 256;
                        att::attn_block<0>(r, (char*)lds, tid); }
#if defined(PROBE_ATT_VAR)
                for (int item = bx; item < 8 * 32; item += G)
                    for (int ps = 0; ps < 2; ++ps) { const int bh = item >> 5, x = item & 31, qb = ps ? 63 - x : x, b = bh >> 2, h = bh & 3; att::BlockRef r;
                        r.Q = (const bf16_t*)(ws + WS_Q) + ((size_t)b * SEQ + (size_t)qb * 256) * QW + h * 192; r.Kl = (const bf16_t*)(ws + WS_KLAT) + (size_t)b * SEQ * 128; r.Kr = (const bf16_t*)(ws + WS_KROPE) + (size_t)b * SEQ * 64;
                        r.O = (bf16_t*)(ws + WS_UBUF) + ((size_t)b * SEQ + (size_t)qb * 256) * DM + 256 + h * 128; r.P0 = qb * 256;
                        att::attn_block<PROBE_ATT_VAR>(r, (char*)lds, tid); }
#endif
            }
        }
        SEAM(pb + 4);
        if constexpr (l == 0) {
            if (KIND(6) && IN(pb + 5)) { PH_BEGIN();
                pg8::EpiRmsRes<true> E{(const void*)ap->in[I_X], (bf16_t*)ap->out, (bf16_t*)(ws + WS_HN), ap->in[I_FFN_NORM], (float*)((char*)ap->out + (size_t)T * DM * 2), (unsigned*)(ws + WS_CTL + CW_FUSE_BYTES) + 8192, L + pg8::STAGE_BYTES};
                { pg8::DenseSched S; S.init(T, DM, DM, (const bf16_t*)(ws + WS_WO), G, bx); pg8::gemm_phase<pg8::EpiRmsRes<true>, pg8::DenseSched, true>(L, (const bf16_t*)(ws + WS_OCAT), DM, DM, S, E, tid); } }
        } else {
            if (KIND(6) && IN(pb + 5)) { PH_BEGIN();
                pg8::EpiRmsRes<false> E{(const void*)ap->out, (bf16_t*)ap->out, (bf16_t*)(ws + WS_HN), ap->in[I_FFN_NORM] + DM, (float*)((char*)ap->out + (size_t)T * DM * 2), (unsigned*)(ws + WS_CTL + CW_FUSE_BYTES) + 16384, L + pg8::STAGE_BYTES};
                { pg8::DenseSched S; S.init(T, DM, DM, (const bf16_t*)(ws + WS_WO) + (size_t)DM * DM, G, bx); pg8::gemm_phase<pg8::EpiRmsRes<false>, pg8::DenseSched, true>(L, (const bf16_t*)(ws + WS_OCAT), DM, DM, S, E, tid); } } }
        if (false) { PH_BEGIN(); pg8::DenseSched S; S.init(T, DM, DM, (const bf16_t*)(ws + WS_WO) + (size_t)l * DM * DM, G, bx); pg8::EpiBf16 E{(bf16_t*)(ws + WS_HN), DM};
            pg8::gemm_phase<pg8::EpiBf16, pg8::DenseSched, true>(L, (const bf16_t*)(ws + WS_OCAT), DM, DM, S, E, tid); }
        SEAM(pb + 5);
        if constexpr (l == 0) {
            if (KIND(8) && IN(8)) REP(8) { PH_BEGIN(); pg8::DenseSched S; S.init(T, 2 * DFF, DM, (const bf16_t*)(ws + WS_WGU), G, bx); pg8::EpiSwiGLU E{(bf16_t*)(ws + WS_ACTD), DFF};
                pg8::gemm_phase<pg8::EpiSwiGLU, pg8::DenseSched, true>(L, (const bf16_t*)(ws + WS_HN), DM, DM, S, E, tid); }
            SEAM(8);
            if (KIND(9) && IN(9)) { PH_BEGIN();
                pg8::EpiRmsRes<false> E{(const void*)ap->out, (bf16_t*)ap->out, (bf16_t*)(ws + WS_HN), ap->in[I_ATTN_NORM] + DM, (float*)((char*)ap->out + (size_t)T * DM * 2), (unsigned*)(ws + WS_CTL + CW_FUSE_BYTES), L + pg8::STAGE_BYTES};
                { pg8::DenseSched S; S.init(T, DM, DFF, (const bf16_t*)(ws + WS_WD), G, bx); pg8::gemm_phase<pg8::EpiRmsRes<false>, pg8::DenseSched, true>(L, (const bf16_t*)(ws + WS_ACTD), DFF, DFF, S, E, tid); } }
            SEAM(9);
        } else {
            if (KIND(10) && IN(16)) REP(10) {
                { PH_BEGIN(); norm_router<true>((bf16_t*)ap->out, (const bf16_t*)(ws + WS_HN), ap->in[I_FFN_NORM] + DM, ap->in[I_ROUTER], (bf16_t*)(ws + WS_HN), (int*)(ws + WS_TOKE), (float*)(ws + WS_TOKG), (int*)(ws + WS_CNT), L, bx, G, tid, wave, lane); }
                __syncthreads(); }
            SEAM(16);
            if (KIND(11) && IN(17)) REP(11) { PH_BEGIN(); route_tables((const int*)(ws + WS_TOKE), (const float*)(ws + WS_TOKG), (const int*)(ws + WS_CNT), (int*)(ws + WS_SLOTTOK), (float*)(ws + WS_SLOTG), (int*)(ws + WS_TILEE), L, bx, G, tid); }
            SEAM(17);
            for (int r = 0; r < 2; ++r) {
                if (KIND(12) && IN(18 + 2 * r)) REP(12) { PH_BEGIN(); pg8::MoeSched<true> S; S.init(2 * DFFE, DM, (const bf16_t*)(ws + WS_MOEW), MOEW_E, (const int*)(ws + WS_TILEE) + r * 256, (const int*)(ws + WS_SLOTTOK) + r * MOE_ROWS, G, bx);
                    pg8::EpiSwiGLU E{(bf16_t*)(ws + WS_ACTM), DFFE};
                    pg8::gemm_phase<pg8::EpiSwiGLU, pg8::MoeSched<true>, true>(L, (const bf16_t*)(ws + WS_HN), DM, DM, S, E, tid); }
                SEAM(18 + 2 * r);
                if (KIND(13) && IN(19 + 2 * r)) REP(13) { PH_BEGIN(); pg8::MoeDownSched S; S.init(DM, DFFE, (const bf16_t*)(ws + WS_MOEW) + (size_t)2 * DFFE * DM, MOEW_E, (const int*)(ws + WS_TILEE) + r * 256, G, bx);
                    pg8::EpiMoeDownB E{(const bf16_t*)ap->out, r == 0 ? (bf16_t*)ap->out : (bf16_t*)(ws + WS_HN), (const int*)(ws + WS_SLOTTOK) + r * MOE_ROWS, (const float*)(ws + WS_SLOTG) + r * MOE_ROWS,
                                       (f32x4*)((char*)ap->out + (size_t)T * DM * 2), (unsigned*)(ws + WS_CTL + CW_SPLIT_BYTES) + r * 64};
                    pg8::gemm_phase<pg8::EpiMoeDownB, pg8::MoeDownSched, true>(L, (const bf16_t*)(ws + WS_ACTM), DFFE, DFFE, S, E, tid);
                    moe_down_fixup(S, E, tid); }
                SEAM(19 + 2 * r);
            }
        }
}

__global__ void __launch_bounds__(NWAVES * 64, 2) trunk_fwd(Args args_unused) {
    extern __shared__ __attribute__((aligned(16))) unsigned char lds[];
    LAS unsigned char* L = (LAS unsigned char*)lds;
    const int G = gridDim.x, bx = blockIdx.x, NGW = G * NWAVES, NGT = G * NWAVES * 64;
    const int wave_s = __builtin_amdgcn_readfirstlane((int)threadIdx.x >> 6);
    for (int u = threadIdx.x; u < (LDS_BYTES - RING_BYTES) / 4; u += NWAVES * 64) ((LAS unsigned*)(L + RING_BYTES))[u] = 0u;
    __syncthreads();
    int lo, hi; XcdBarrier bar;
    { KArgsPtr ap0 = (KArgsPtr)__builtin_amdgcn_kernarg_segment_ptr(); lo = ap0->ph_lo; hi = ap0->ph_hi;
      bar.bar = (unsigned*)(ap0->ws + WS_CTL) + CW_BAR; bar.x = 0; bar.st = nullptr;
      if (MK_ONE_LAUNCH) bar = xcd_barrier_post((unsigned*)(ap0->ws + WS_CTL) + CW_BAR, (volatile LAS unsigned*)(L + MISC_OFF) + 8); }
    if (KIND(0) && IN(0)) REP(0) { PH_BEGIN();
        if (wave < 4) p0_stream(ap, L, bx * 4 + wave, G * 4, wave, lane);
        else p0_prologue(ap, L, 0, 1, bx * 256 + (tid - 256), G * 256, wave, lane, 1); }

    layer_body<0>(L, lds, lo, hi, bar, G, bx, NGW, NGT, wave_s);
    layer_body<1>(L, lds, lo, hi, bar, G, bx, NGW, NGT, wave_s);
    if (KIND(14) && IN(22)) REP(14) { PH_BEGIN(); norm_final((const bf16_t*)(ws + WS_HN), ap->out, ap->in[I_FINAL_NORM], gw, NGW, lane); }
#undef IN
#undef SEAM
}

extern "C" void kernel_launch(void* const* d_in, const int* in_sizes, int n_in, void* d_out, int out_size, void* d_ws, size_t ws_size, hipStream_t stream) {
    static int grid = 0;
    if (grid == 0) {
        if (n_in != 21 || in_sizes[0] != T * DM || out_size != T * DM || ws_size < WS_END) {
            fprintf(stderr, "kernel_launch: unexpected shapes (n_in %d, in0 %d, out %d, ws %zu, need %zu); nothing launched\n", n_in, n_in > 0 ? in_sizes[0] : -1, out_size, ws_size, (size_t)WS_END); grid = -1; return; }
        int dev = 0, cus = 0, per_cu = 0;
        if (hipGetDevice(&dev) != hipSuccess || hipDeviceGetAttribute(&cus, hipDeviceAttributeMultiprocessorCount, dev) != hipSuccess) { grid = -1; return; }
        if (hipFuncSetAttribute((const void*)trunk_fwd, hipFuncAttributeMaxDynamicSharedMemorySize, LDS_BYTES) != hipSuccess) { fprintf(stderr, "kernel_launch: hipFuncSetAttribute failed\n"); grid = -1; return; }
        if (hipOccupancyMaxActiveBlocksPerMultiprocessor(&per_cu, (const void*)trunk_fwd, NWAVES * 64, LDS_BYTES) != hipSuccess || per_cu < 1)
            fprintf(stderr, "kernel_launch: note: occupancy query reports %d workgroups per CU\n", per_cu);
        (void)hipGetLastError();
        grid = cus;
    }
    if (grid < 0) return;
    (void)hipMemsetAsync((char*)d_ws + WS_CTL, 0, CTL_ZERO_BYTES, stream);
    Args a{};
    for (int i = 0; i < 21; ++i) a.in[i] = (const float*)d_in[i];
    a.out = (float*)d_out; a.ws = (unsigned char*)d_ws;
#if MK_ONE_LAUNCH
    a.ph_lo = 0; a.ph_hi = NPH;
    hipLaunchKernelGGL(trunk_fwd, dim3(grid), dim3(NWAVES * 64), LDS_BYTES, stream, a);
#else
    for (int p = 0; p < NPH; ++p) { a.ph_lo = p; a.ph_hi = p + 1; hipLaunchKernelGGL(trunk_fwd, dim3(grid), dim3(NWAVES * 64), LDS_BYTES, stream, a); }
#endif
}
```

```cpp
#include <hip/hip_runtime.h>
#include <cstdio>
#include <cstdint>

#ifndef MK_ONE_LAUNCH
#define MK_ONE_LAUNCH 1
#endif

#define LAS __attribute__((address_space(3)))
#define GAS __attribute__((address_space(1)))
typedef unsigned short bf16_t;
typedef short bf16x8 __attribute__((ext_vector_type(8)));
typedef short s16x4 __attribute__((ext_vector_type(4)));
typedef float f32x2 __attribute__((ext_vector_type(2)));
typedef float f32x4 __attribute__((ext_vector_type(4)));
typedef float f32x16 __attribute__((ext_vector_type(16)));
typedef unsigned u32x2 __attribute__((ext_vector_type(2)));
typedef unsigned u32x4 __attribute__((ext_vector_type(4)));

constexpr int BATCH = 2, SEQ = 16384, T = BATCH * SEQ, DM = 1024, DIN = 2240, DINP = 2304;
constexpr int HG_H = 4, HG_DK = 128, HG_DV = 64, HG_C = 64, NCHUNK = SEQ / HG_C, NUNIT = BATCH * HG_H * NCHUNK;
constexpr int COL_HQ = 0, COL_HF = 512, COL_HI = 1024, COL_HG = 1280, COL_CQ = 1536, COL_CKV = 1792, COL_KPE = 1920, COL_XP = 1984;
constexpr int QW = 768;
constexpr int DFF = 2560, NE = 8, DFFE = 3584;
constexpr float EPS = 1e-6f;
constexpr int MOE_ROWS = T + NE * 256;
constexpr int MOE_MAXT = MOE_ROWS / 256;

constexpr size_t MiB = 1u << 20;
constexpr size_t WS_CTL = 0, CTL_ZERO_BYTES = 1 * MiB;
constexpr size_t WS_LBS = 1 * MiB;
constexpr size_t WS_RSTDQ = WS_LBS + 64 * 1024;
constexpr size_t WS_DVEC = WS_RSTDQ + (size_t)T * 4;
constexpr size_t WS_COS = WS_DVEC + (size_t)NUNIT * 128 * 4;
constexpr size_t WS_SIN = WS_COS + (size_t)SEQ * 32 * 4;
constexpr size_t WS_TOKE = WS_SIN + (size_t)SEQ * 32 * 4;
constexpr size_t WS_TOKG = WS_TOKE + (size_t)T * 2 * 4;
constexpr size_t WS_CNT = WS_TOKG + (size_t)T * 2 * 4;
constexpr size_t WS_SLOTTOK = WS_CNT + 256 * 16 * 4;
constexpr size_t WS_SLOTG = WS_SLOTTOK + (size_t)2 * MOE_ROWS * 4;
constexpr size_t WS_TILEE = WS_SLOTG + (size_t)2 * MOE_ROWS * 4;
constexpr size_t WS_WIN = 8 * MiB;
constexpr size_t WS_WQ = WS_WIN + (size_t)2 * DINP * DM * 2;
constexpr size_t WS_WO = WS_WQ + (size_t)2 * QW * 256 * 2;
constexpr size_t WS_WGU = WS_WO + (size_t)2 * DM * DM * 2;
constexpr size_t WS_WD = WS_WGU + (size_t)2 * DFF * DM * 2;
constexpr size_t WS_SMALL_END = WS_WD + (size_t)DM * DFF * 2;
constexpr size_t WS_ACT0 = 40 * MiB;
static_assert(WS_TILEE + 2 * 256 * 4 <= WS_WIN && WS_SMALL_END <= WS_ACT0, "small region");
constexpr size_t WS_HN = WS_ACT0;
constexpr size_t WS_Q = WS_ACT0;
constexpr size_t WS_KLAT = WS_ACT0 + 48 * MiB;
constexpr size_t WS_KROPE = WS_ACT0 + 56 * MiB;
constexpr size_t WS_PROJ = WS_ACT0 + 64 * MiB;
constexpr size_t WS_UBUF = WS_PROJ + 144 * MiB;
constexpr size_t WS_OCAT = WS_UBUF + 32 * MiB;
constexpr size_t WS_MIX_END = WS_OCAT + 64 * MiB;
constexpr size_t WS_ACTD = WS_PROJ;
constexpr size_t WS_MOEW = WS_MIX_END;
constexpr size_t MOEW_E = (size_t)(2 * DFFE * DM + DM * DFFE);
constexpr size_t WS_ACTM = WS_PROJ;
constexpr size_t WS_END = WS_MOEW + (size_t)NE * MOEW_E * 2;
static_assert(WS_END <= 512 * MiB && WS_ACTM + (size_t)MOE_ROWS * DFFE * 2 <= WS_MOEW, "workspace");

constexpr int CW_TMO = 0, CW_BAR = 4096; constexpr size_t CW_FUSE_BYTES = 576 * 1024;
constexpr size_t CW_SPLIT_BYTES = 512 * 1024;

__device__ __forceinline__ float bf2f(bf16_t v) { return __uint_as_float((unsigned)v << 16); }
typedef __bf16 bf16n2 __attribute__((ext_vector_type(2)));
typedef float f32n2 __attribute__((ext_vector_type(2)));
__device__ __forceinline__ unsigned cvt_pk_bf16(float lo, float hi) { const f32n2 v = {lo, hi}; return __builtin_bit_cast(unsigned, __builtin_convertvector(v, bf16n2)); }
__device__ __forceinline__ bf16_t f2bf(float f) { return __builtin_bit_cast(unsigned short, (__bf16)f); }
template <int CTRL> __device__ __forceinline__ float dppf(float v) { return __int_as_float(__builtin_amdgcn_update_dpp(0, __float_as_int(v), CTRL, 0xf, 0xf, true)); }
__device__ __forceinline__ float xlane1(float v) { return dppf<0xB1>(v); }
__device__ __forceinline__ float sum8(float v) { v += dppf<0xB1>(v); v += dppf<0x4E>(v); v += dppf<0x141>(v); return v; }
__device__ __forceinline__ float wave_sum(float v) {
    v = sum8(v); v += dppf<0x140>(v);
    const float r0 = __int_as_float(__builtin_amdgcn_readlane(__float_as_int(v), 0)), r1 = __int_as_float(__builtin_amdgcn_readlane(__float_as_int(v), 16));
    const float r2 = __int_as_float(__builtin_amdgcn_readlane(__float_as_int(v), 32)), r3 = __int_as_float(__builtin_amdgcn_readlane(__float_as_int(v), 48));
    return (r0 + r1) + (r2 + r3);
}
__device__ __forceinline__ float fast_exp(float x) { return __builtin_amdgcn_exp2f(x * 1.4426950408889634f); }
__device__ __forceinline__ float sigmoidf_(float x) { return __builtin_amdgcn_rcpf(1.f + fast_exp(-x)); }
#define LDS_WAIT() asm volatile("s_waitcnt lgkmcnt(0)" ::: "memory")
#define VM_WAIT() asm volatile("s_waitcnt vmcnt(0)" ::: "memory")

namespace pg8 {
constexpr int BM = 256, BK = 64, HALF = 128, HTB = HALF * BK * 2, STAGE_BYTES = 8 * HTB, NXCD = 8, WGM = 8;
__host__ __device__ __forceinline__ int lds_byte(int r, int c) { const int st = (r >> 4) * 2 + (c >> 5), rr = r & 15, cc = c & 31, ob = rr * 64 + cc * 2; return st * 1024 + (ob ^ (((ob >> 9) & 1) << 5)); }
__host__ __device__ __forceinline__ void stage_rc(int b, int& R, int& C) { const int st = b / 1024, sb = b % 1024, swz = sb ^ (((sb >> 9) & 1) << 5); R = (st >> 1) * 16 + swz / 64; C = (st & 1) * 32 + (swz % 64) / 2; }
__host__ __device__ __forceinline__ int perm32(int rho) { const int n = rho >> 4, i = rho & 15; return 8 * (i >> 2) + 4 * n + (i & 3); }

struct Unit { int pm, pn; int k0, nt, role, aux; };

struct OrderBase {
    int nM, nN, nwg, G, c;
    __device__ __forceinline__ void init_order(int nM_, int nN_, int G_, int c_) { nM = nM_; nN = nN_; nwg = nM * nN; G = G_; c = c_; }
    __device__ __forceinline__ void map(int L, Unit& u) const {
        int wgid = L; { const int q = nwg / NXCD, r = nwg % NXCD, xcd = wgid % NXCD, off = wgid / NXCD; wgid = (xcd < r ? xcd * (q + 1) : r * (q + 1) + (xcd - r) * q) + off; }
        const int nig = WGM * nN, gid = wgid / nig, fm = gid * WGM, gsz = (nM - fm) < WGM ? (nM - fm) : WGM;
        u.pm = fm + ((wgid % nig) % gsz); u.pn = (wgid % nig) / gsz;
    }
    __device__ __forceinline__ bool next(int i, Unit& u) const {
        const long L = (long)i * G + c; if (L >= nwg) return false;
        map((int)L, u); return true;
    }
};
struct DenseSched : OrderBase {
    static constexpr bool GATHER = false, SPLITK = false;
    const bf16_t* Bt; int K;
    __device__ __forceinline__ void init(int M, int N, int K_, const bf16_t* Bt_, int G_, int c_) { init_order(M / BM, N / BM, G_, c_); Bt = Bt_; K = K_; }
    __device__ __forceinline__ int arow(const Unit& u, int r) const { return u.pm * BM + r; }
    __device__ __forceinline__ const char* bptr(const Unit& u) const { return (const char*)Bt + (size_t)u.pn * BM * K * 2; }
};
struct SliceSched : OrderBase {
    static constexpr bool GATHER = false, SPLITK = false;
    const bf16_t* Bt; int K, slice;
    __device__ __forceinline__ void init(int M, int N, int K_, const bf16_t* Bt_, int G_, int c_, int slice_) { init_order(M / BM, N / BM, G_, c_); Bt = Bt_; K = K_; slice = slice_; }
    __device__ __forceinline__ bool next(int i, Unit& u) const { const long L = (long)slice * G + c; if (i != 0 || L >= nwg) return false; map((int)L, u); return true; }
    __device__ __forceinline__ int arow(const Unit& u, int r) const { return u.pm * BM + r; }
    __device__ __forceinline__ const char* bptr(const Unit& u) const { return (const char*)Bt + (size_t)u.pn * BM * K * 2; }
};
template <bool GATHER_> struct MoeSched : OrderBase {
    static constexpr bool GATHER = GATHER_, SPLITK = false;
    const bf16_t* W; size_t wstride; int K; const int* tile_e; const int* slot_tok;
    __device__ __forceinline__ void init(int N, int K_, const bf16_t* W_, size_t wstride_, const int* tile_e_, const int* slot_tok_, int G_, int c_) {
        tile_e = tile_e_; slot_tok = slot_tok_; W = W_; wstride = wstride_; K = K_; init_order(tile_e_[0], N / BM, G_, c_); }
    __device__ __forceinline__ int arow(const Unit& u, int r) const { if (GATHER) { const int t = slot_tok[u.pm * BM + r]; return t < 0 ? 0 : t; } return u.pm * BM + r; }
    __device__ __forceinline__ const char* bptr(const Unit& u) const { return (const char*)(W + (size_t)tile_e[1 + u.pm] * wstride) + (size_t)u.pn * BM * K * 2; }
};

constexpr int KCH = 7;
struct MoeDownSched : OrderBase {
    static constexpr bool GATHER = false, SPLITK = true;
    const bf16_t* W; size_t wstride; int K; const int* tile_e; int nfullu, nleft, nchunk;
    __device__ __forceinline__ void init(int N, int K_, const bf16_t* W_, size_t wstride_, const int* tile_e_, int G_, int c_) {
        tile_e = tile_e_; W = W_; wstride = wstride_; K = K_; init_order(tile_e_[0], N / BM, G_, c_);
        nfullu = (nwg / G) * G; nleft = nwg - nfullu; nchunk = nleft * KCH;
        if (nchunk > G) { nfullu = nwg; nleft = 0; nchunk = 0; } }
    __device__ __forceinline__ bool next(int i, Unit& u) const {
        const long L = (long)i * G + c;
        if (L < nfullu) { map((int)L, u); u.k0 = 0; u.nt = K / BK; u.role = 0; u.aux = 0; return true; }
        if (i == nfullu / G && c < nchunk) { const int lu = c / KCH, kc = c - lu * KCH; map(nfullu + lu, u); u.k0 = kc * (K / KCH); u.nt = (K / KCH) / BK; u.role = 1; u.aux = c; return true; }
        return false; }
    __device__ __forceinline__ int arow(const Unit& u, int r) const { return u.pm * BM + r; }
    __device__ __forceinline__ const char* bptr(const Unit& u) const { return (const char*)(W + (size_t)tile_e[1 + u.pm] * wstride) + (size_t)u.pn * BM * K * 2; }
};

struct EpiBf16 {
    static constexpr bool PERM = true;
    bf16_t* O; int ldc;
    __device__ __forceinline__ void operator()(const f32x4 (&acc)[2][2][4][2], const Unit& u, int wr, int wc, int fr, int fq) const {
        const int row0 = u.pm * BM + wr * 64 + fr, col0 = u.pn * BM + wc * 32 + 8 * fq;
#pragma unroll
        for (int ai = 0; ai < 2; ++ai)
#pragma unroll
            for (int m = 0; m < 4; ++m) { bf16_t* rowp = O + (size_t)(row0 + ai * HALF + m * 16) * ldc + col0;
#pragma unroll
                for (int bj = 0; bj < 2; ++bj) { const f32x4 v0 = acc[ai][bj][m][0], v1 = acc[ai][bj][m][1];
                    u32x4 w; w.x = cvt_pk_bf16(v0[0], v0[1]); w.y = cvt_pk_bf16(v0[2], v0[3]); w.z = cvt_pk_bf16(v1[0], v1[1]); w.w = cvt_pk_bf16(v1[2], v1[3]);
                    *(u32x4*)(rowp + bj * HALF) = w; } }
    }
};
template <bool XF32>
struct EpiRmsRes {
    static constexpr bool PERM = true;
    const void* xs; bf16_t* xd; bf16_t* hn; const float* g; float* slots; unsigned* cnt; LAS unsigned char* tab;
    __device__ __forceinline__ void operator()(const f32x4 (&acc)[2][2][4][2], const Unit& u, int wr, int wc, int fr, int fq) const {
        LAS float* P = (LAS float*)tab;
        LAS float* S = (LAS float*)(tab + 16384);
        const int col0 = u.pn * BM + wc * 32 + 8 * fq, rl0 = wr * 64 + fr, lane = fq * 16 + fr, wid = wr * 4 + wc, tid = wid * 64 + lane;
        f32x4 gv[2][2];
#pragma unroll
        for (int bj = 0; bj < 2; ++bj) { gv[bj][0] = *(const f32x4*)(g + col0 + bj * HALF); gv[bj][1] = *(const f32x4*)(g + col0 + bj * HALF + 4); }
        f32x4 v[2][2][4][2];
#pragma unroll
        for (int ai = 0; ai < 2; ++ai) {
            u32x4 rr[4][2]; f32x4 rf[XF32 ? 4 : 1][2][2];
#pragma unroll
            for (int m = 0; m < 4; ++m) { const size_t off = (size_t)(u.pm * BM + ai * HALF + rl0 + m * 16) * DM + col0;
                if constexpr (XF32) { const float* xp = (const float*)xs + off;
#pragma unroll
                    for (int bj = 0; bj < 2; ++bj) { rf[m][bj][0] = *(const f32x4*)(xp + bj * HALF); rf[m][bj][1] = *(const f32x4*)(xp + bj * HALF + 4); } }
                else { rr[m][0] = *(const u32x4*)((const bf16_t*)xs + off); rr[m][1] = *(const u32x4*)((const bf16_t*)xs + off + HALF); } }
#pragma unroll
            for (int m = 0; m < 4; ++m) { float sq = 0.f;
#pragma unroll
                for (int bj = 0; bj < 2; ++bj) { f32x4 a0 = acc[ai][bj][m][0], a1 = acc[ai][bj][m][1];
                    if constexpr (XF32) { a0 += rf[m][bj][0]; a1 += rf[m][bj][1]; }
                    else { const u32x4 r = rr[m][bj];
                        a0[0] += __uint_as_float(r.x << 16); a0[1] += __uint_as_float(r.x & 0xffff0000u); a0[2] += __uint_as_float(r.y << 16); a0[3] += __uint_as_float(r.y & 0xffff0000u);
                        a1[0] += __uint_as_float(r.z << 16); a1[1] += __uint_as_float(r.z & 0xffff0000u); a1[2] += __uint_as_float(r.w << 16); a1[3] += __uint_as_float(r.w & 0xffff0000u); }
                    v[ai][bj][m][0] = a0; v[ai][bj][m][1] = a1;
                    sq += ((a0[0] * a0[0] + a0[1] * a0[1]) + (a0[2] * a0[2] + a0[3] * a0[3])) + ((a1[0] * a1[0] + a1[1] * a1[1]) + (a1[2] * a1[2] + a1[3] * a1[3])); }
                P[(ai * HALF + rl0 + m * 16) * 16 + wc * 4 + fq] = sq; } }
        asm volatile("s_waitcnt lgkmcnt(0)" ::: "memory"); __builtin_amdgcn_s_barrier(); asm volatile("" ::: "memory");
        if (tid < 256) { const LAS f32x4* pp = (const LAS f32x4*)(P + tid * 16); const f32x4 p0 = pp[0], p1 = pp[1], p2 = pp[2], p3 = pp[3];
            const float tot = (((p0[0] + p0[1]) + (p0[2] + p0[3])) + ((p1[0] + p1[1]) + (p1[2] + p1[3]))) + (((p2[0] + p2[1]) + (p2[2] + p2[3])) + ((p3[0] + p3[1]) + (p3[2] + p3[3])));
            __hip_atomic_store(slots + ((size_t)(u.pm * BM + tid) * 4 + u.pn), tot, __ATOMIC_RELAXED, __HIP_MEMORY_SCOPE_AGENT); }
        asm volatile("s_waitcnt vmcnt(0)" ::: "memory");
        if (lane == 0) (void)__hip_atomic_fetch_add(cnt + 64 * u.pm, 1u, __ATOMIC_RELAXED, __HIP_MEMORY_SCOPE_AGENT);
        if (wid == 0) { unsigned sp = 0;
            while ((unsigned)__builtin_amdgcn_readfirstlane(__hip_atomic_load(cnt + 64 * u.pm, __ATOMIC_RELAXED, __HIP_MEMORY_SCOPE_AGENT)) < 32u) { __builtin_amdgcn_s_sleep(2); if (++sp > (1u << 22)) break; } }
        asm volatile("s_waitcnt vmcnt(0) lgkmcnt(0)" ::: "memory"); __builtin_amdgcn_s_barrier(); asm volatile("" ::: "memory");
        if (tid < 256) { const float* sl = slots + (size_t)(u.pm * BM + tid) * 4;
            const float s0 = __hip_atomic_load(sl + 0, __ATOMIC_RELAXED, __HIP_MEMORY_SCOPE_AGENT), s1 = __hip_atomic_load(sl + 1, __ATOMIC_RELAXED, __HIP_MEMORY_SCOPE_AGENT);
            const float s2 = __hip_atomic_load(sl + 2, __ATOMIC_RELAXED, __HIP_MEMORY_SCOPE_AGENT), s3 = __hip_atomic_load(sl + 3, __ATOMIC_RELAXED, __HIP_MEMORY_SCOPE_AGENT);
            S[tid] = 1.0f / sqrtf(((s0 + s1) + (s2 + s3)) * (1.f / DM) + EPS); }
        asm volatile("s_waitcnt vmcnt(0) lgkmcnt(0)" ::: "memory"); __builtin_amdgcn_s_barrier(); asm volatile("" ::: "memory");
#pragma unroll
        for (int ai = 0; ai < 2; ++ai)
#pragma unroll
            for (int m = 0; m < 4; ++m) { const int rl = ai * HALF + rl0 + m * 16; const float rs = S[rl]; const size_t off = (size_t)(u.pm * BM + rl) * DM + col0;
#pragma unroll
                for (int bj = 0; bj < 2; ++bj) { const f32x4 a0 = v[ai][bj][m][0], a1 = v[ai][bj][m][1]; const f32x4 o0 = a0 * rs * gv[bj][0], o1 = a1 * rs * gv[bj][1];
                    u32x4 wx; wx.x = cvt_pk_bf16(a0[0], a0[1]); wx.y = cvt_pk_bf16(a0[2], a0[3]); wx.z = cvt_pk_bf16(a1[0], a1[1]); wx.w = cvt_pk_bf16(a1[2], a1[3]);
                    u32x4 wh; wh.x = cvt_pk_bf16(o0[0], o0[1]); wh.y = cvt_pk_bf16(o0[2], o0[3]); wh.z = cvt_pk_bf16(o1[0], o1[1]); wh.w = cvt_pk_bf16(o1[2], o1[3]);
                    *(u32x4*)(xd + off + bj * HALF) = wx; *(u32x4*)(hn + off + bj * HALF) = wh; } }
    }
};
struct EpiQ {
    static constexpr bool PERM = true;
    bf16_t* Q; const float* rstd; const float* cosT; const float* sinT;
    __device__ __forceinline__ void operator()(const f32x4 (&acc)[2][2][4][2], const Unit& u, int wr, int wc, int fr, int fq) const {
        const int row0 = u.pm * BM + wr * 64 + fr;
        float rsv[2][4];
#pragma unroll
        for (int ai = 0; ai < 2; ++ai)
#pragma unroll
            for (int m = 0; m < 4; ++m) rsv[ai][m] = rstd[row0 + ai * HALF + m * 16];
#pragma unroll
        for (int bj = 0; bj < 2; ++bj) {
            const int col0 = u.pn * BM + bj * HALF + wc * 32 + 8 * fq, within = col0 % 192; const bool rope = within >= 128; const int i0 = (within - 128) >> 1;
#pragma unroll
            for (int ai = 0; ai < 2; ++ai) {
                f32x4 cv[4], sv[4];
                if (rope) {
#pragma unroll
                    for (int m = 0; m < 4; ++m) { const int pos = (row0 + ai * HALF + m * 16) & (SEQ - 1); cv[m] = *(const f32x4*)(cosT + pos * 32 + i0); sv[m] = *(const f32x4*)(sinT + pos * 32 + i0); } }
#pragma unroll
                for (int m = 0; m < 4; ++m) { const int row = row0 + ai * HALF + m * 16; const float rs = rsv[ai][m];
                    f32x4 v0 = acc[ai][bj][m][0] * rs, v1 = acc[ai][bj][m][1] * rs;
                    if (rope) { const f32x4 c4 = cv[m], s4 = sv[m];
                        const f32x4 a = v0, b = v1;
                        v0[0] = a[0] * c4[0] - a[1] * s4[0]; v0[1] = a[0] * s4[0] + a[1] * c4[0]; v0[2] = a[2] * c4[1] - a[3] * s4[1]; v0[3] = a[2] * s4[1] + a[3] * c4[1];
                        v1[0] = b[0] * c4[2] - b[1] * s4[2]; v1[1] = b[0] * s4[2] + b[1] * c4[2]; v1[2] = b[2] * c4[3] - b[3] * s4[3]; v1[3] = b[2] * s4[3] + b[3] * c4[3]; }
                    u32x4 w; w.x = cvt_pk_bf16(v0[0], v0[1]); w.y = cvt_pk_bf16(v0[2], v0[3]); w.z = cvt_pk_bf16(v1[0], v1[1]); w.w = cvt_pk_bf16(v1[2], v1[3]);
                    *(u32x4*)(Q + (size_t)row * QW + col0) = w; asm volatile("" ::: "memory"); } } }
    }
};
struct EpiResid {
    static constexpr bool PERM = false;
    const float* res; float* out;
    __device__ __forceinline__ void operator()(const f32x4 (&acc)[2][2][4][2], const Unit& u, int wr, int wc, int fr, int fq) const {
        const int row0 = u.pm * BM + wr * 64 + fr, col0 = u.pn * BM + wc * 32 + 4 * fq;
#pragma unroll
        for (int ai = 0; ai < 2; ++ai)
#pragma unroll
            for (int m = 0; m < 4; ++m) { const size_t off = (size_t)(row0 + ai * HALF + m * 16) * DM + col0;
#pragma unroll
                for (int bj = 0; bj < 2; ++bj)
#pragma unroll
                    for (int n = 0; n < 2; ++n) { const f32x4 r = *(const f32x4*)(res + off + bj * HALF + n * 16); *(f32x4*)(out + off + bj * HALF + n * 16) = r + acc[ai][bj][m][n]; } }
    }
};
struct EpiSwiGLU {
    static constexpr bool PERM = true;
    bf16_t* O; int ldc;
    __device__ __forceinline__ void operator()(const f32x4 (&acc)[2][2][4][2], const Unit& u, int wr, int wc, int fr, int fq) const {
        const int row0 = u.pm * BM + wr * 64 + fr, col0 = u.pn * HALF + wc * 32 + 8 * fq;
#pragma unroll
        for (int ai = 0; ai < 2; ++ai)
#pragma unroll
            for (int m = 0; m < 4; ++m) { f32x4 h[2];
#pragma unroll
                for (int n = 0; n < 2; ++n) { const f32x4 g = acc[ai][0][m][n], up = acc[ai][1][m][n];
#pragma unroll
                    for (int e = 0; e < 4; ++e) h[n][e] = g[e] * sigmoidf_(g[e]) * up[e]; }
                u32x4 w; w.x = cvt_pk_bf16(h[0][0], h[0][1]); w.y = cvt_pk_bf16(h[0][2], h[0][3]); w.z = cvt_pk_bf16(h[1][0], h[1][1]); w.w = cvt_pk_bf16(h[1][2], h[1][3]);
                *(u32x4*)(O + (size_t)(row0 + ai * HALF + m * 16) * ldc + col0) = w; asm volatile("" ::: "memory"); }
    }
};
struct EpiMoeDown {
    static constexpr bool PERM = false;
    float* x; const int* slot_tok; const float* slot_g;
    __device__ __forceinline__ void operator()(const f32x4 (&acc)[2][2][4][2], const Unit& u, int wr, int wc, int fr, int fq) const {
        const int row0 = u.pm * BM + wr * 64 + fr, col0 = u.pn * BM + wc * 32 + 4 * fq;
#pragma unroll
        for (int ai = 0; ai < 2; ++ai)
#pragma unroll
            for (int m = 0; m < 4; ++m) { const int slot = row0 + ai * HALF + m * 16; const int tok = slot_tok[slot]; const float g = slot_g[slot];
                if (tok >= 0) { const size_t off = (size_t)tok * DM + col0;
#pragma unroll
                    for (int bj = 0; bj < 2; ++bj)
#pragma unroll
                        for (int n = 0; n < 2; ++n) { const f32x4 r = *(const f32x4*)(x + off + bj * HALF + n * 16); *(f32x4*)(x + off + bj * HALF + n * 16) = r + acc[ai][bj][m][n] * g; } } }
    }
};

struct EpiMoeDownB {
    static constexpr bool PERM = true;
    const bf16_t* xs; bf16_t* xd; const int* slot_tok; const float* slot_g; f32x4* part; unsigned* cnt;
    __device__ __forceinline__ void operator()(const f32x4 (&acc)[2][2][4][2], const Unit& u, int wr, int wc, int fr, int fq) const {
        if (u.role == 1) {
            u32x4* p = (u32x4*)part + (size_t)u.aux * (16 * 512) + (wr * 4 + wc) * 64 + fq * 16 + fr;
#pragma unroll
            for (int ai = 0; ai < 2; ++ai)
#pragma unroll
                for (int bj = 0; bj < 2; ++bj)
#pragma unroll
                    for (int m = 0; m < 4; ++m) { const f32x4 v0 = acc[ai][bj][m][0], v1 = acc[ai][bj][m][1];
                        u32x4 w; w.x = cvt_pk_bf16(v0[0], v0[1]); w.y = cvt_pk_bf16(v0[2], v0[3]); w.z = cvt_pk_bf16(v1[0], v1[1]); w.w = cvt_pk_bf16(v1[2], v1[3]);
                        p[(size_t)((ai * 2 + bj) * 4 + m) * 512] = w; }
            return; }
        const int row0 = u.pm * BM + wr * 64 + fr, col0 = u.pn * BM + wc * 32 + 8 * fq;
        int tk[2][4]; float gg[2][4];
#pragma unroll
        for (int ai = 0; ai < 2; ++ai)
#pragma unroll
            for (int m = 0; m < 4; ++m) { tk[ai][m] = slot_tok[row0 + ai * HALF + m * 16]; gg[ai][m] = slot_g[row0 + ai * HALF + m * 16]; }
#pragma unroll
        for (int ai = 0; ai < 2; ++ai)
#pragma unroll
            for (int m = 0; m < 4; ++m) if (tk[ai][m] >= 0) { const size_t off = (size_t)tk[ai][m] * DM + col0; const float g = gg[ai][m];
                const u32x4 r0 = *(const u32x4*)(xs + off), r1 = *(const u32x4*)(xs + off + HALF);
#pragma unroll
                for (int bj = 0; bj < 2; ++bj) { const u32x4 r = bj ? r1 : r0; const f32x4 v0 = acc[ai][bj][m][0] * g, v1 = acc[ai][bj][m][1] * g;
                    u32x4 w; w.x = cvt_pk_bf16(__uint_as_float(r.x << 16) + v0[0], __uint_as_float(r.x & 0xffff0000u) + v0[1]); w.y = cvt_pk_bf16(__uint_as_float(r.y << 16) + v0[2], __uint_as_float(r.y & 0xffff0000u) + v0[3]);
                    w.z = cvt_pk_bf16(__uint_as_float(r.z << 16) + v1[0], __uint_as_float(r.z & 0xffff0000u) + v1[1]); w.w = cvt_pk_bf16(__uint_as_float(r.w << 16) + v1[2], __uint_as_float(r.w & 0xffff0000u) + v1[3]);
                    *(u32x4*)(xd + off + bj * HALF) = w; } }
    }
};
struct EpiMoeDelta {
    static constexpr bool PERM = true;
    bf16_t* d1; const int* slot_tok; const float* slot_g;
    __device__ __forceinline__ void operator()(const f32x4 (&acc)[2][2][4][2], const Unit& u, int wr, int wc, int fr, int fq) const {
        const int row0 = u.pm * BM + wr * 64 + fr, col0 = u.pn * BM + wc * 32 + 8 * fq;
        int tk[2][4]; float gg[2][4];
#pragma unroll
        for (int ai = 0; ai < 2; ++ai)
#pragma unroll
            for (int m = 0; m < 4; ++m) { tk[ai][m] = slot_tok[row0 + ai * HALF + m * 16]; gg[ai][m] = slot_g[row0 + ai * HALF + m * 16]; }
#pragma unroll
        for (int ai = 0; ai < 2; ++ai)
#pragma unroll
            for (int m = 0; m < 4; ++m) if (tk[ai][m] >= 0) { bf16_t* rowp = d1 + (size_t)tk[ai][m] * DM + col0; const float g = gg[ai][m];
#pragma unroll
                for (int bj = 0; bj < 2; ++bj) { const f32x4 v0 = acc[ai][bj][m][0] * g, v1 = acc[ai][bj][m][1] * g;
                    u32x4 w; w.x = cvt_pk_bf16(v0[0], v0[1]); w.y = cvt_pk_bf16(v0[2], v0[3]); w.z = cvt_pk_bf16(v1[0], v1[1]); w.w = cvt_pk_bf16(v1[2], v1[3]);
                    *(u32x4*)(rowp + bj * HALF) = w; } }
    }
};
__device__ __forceinline__ void glds16_s(const void* sbase, unsigned voff, unsigned lds_dst) { unsigned keep;
    asm volatile("s_mov_b32 %0, m0\n\ts_mov_b32 m0, %3\n\ts_nop 0\n\tglobal_load_lds_dwordx4 %2, %1\n\ts_mov_b32 m0, %0" : "=&s"(keep) : "s"(sbase), "v"(voff), "s"(lds_dst) : "memory"); }
template <class Epi, class Sched, bool ALIGN_EPI>
__device__ __forceinline__ void gemm_phase(LAS unsigned char* lds, const bf16_t* Aptr, const int lda, const int K, const Sched& S, const Epi& E, int tid) {
    asm volatile("" : "+v"(tid));
    const int wid = __builtin_amdgcn_readfirstlane(tid >> 6), lane = tid & 63, wr = wid >> 2, wc = wid & 3, fr = lane & 15, fq = lane >> 4;
    const int nt = K / BK;
    int RA[2]; unsigned CA2[2], voffB[2];
#pragma unroll
    for (int i = 0; i < 2; ++i) { int R, C; stage_rc(tid * 16 + i * 8192, R, C); const int Rb = Epi::PERM ? ((R & ~31) + perm32(R & 31)) : R;
        RA[i] = R; CA2[i] = (unsigned)C * 2u; voffB[i] = (unsigned)(Rb * K + C) * 2u; }
    const size_t kstep = (size_t)(BK * 2);
    const size_t hstep = (size_t)HALF * K * 2;
    const unsigned ldsb = (unsigned)(uintptr_t)lds + (unsigned)wid * 1024u;
    const int aoff = lds_byte(wr * 64 + fr, fq * 8), boff = lds_byte(wc * 32 + fr, fq * 8);
#define PG8_SA(b, h) (((b) * 2 + (h)) * HTB)
#define PG8_SB(b, h) ((4 + (b) * 2 + (h)) * HTB)
#define PG8_STAGE(bufoff, gbase, voff) do { _Pragma("unroll") for (int _i = 0; _i < 2; ++_i) \
        glds16_s((const void*)(gbase), (voff)[_i], ldsb + (unsigned)((bufoff) + _i * 8192)); } while (0)
#define PG8_LDA(dst, b, h) do { _Pragma("unroll") for (int m = 0; m < 4; ++m) _Pragma("unroll") for (int k = 0; k < 2; ++k) dst[m][k] = *(const LAS bf16x8*)(lds + PG8_SA(b, h) + aoff + m * 2048 + k * 1024); } while (0)
#define PG8_LDB(dst, b, h) do { _Pragma("unroll") for (int n = 0; n < 2; ++n) _Pragma("unroll") for (int k = 0; k < 2; ++k) dst[n][k] = *(const LAS bf16x8*)(lds + PG8_SB(b, h) + boff + n * 2048 + k * 1024); } while (0)
#define PG8_MMA(ai, bj, At, Bt) do { __builtin_amdgcn_s_setprio(1); _Pragma("unroll") for (int m = 0; m < 4; ++m) _Pragma("unroll") for (int n = 0; n < 2; ++n) _Pragma("unroll") for (int k = 0; k < 2; ++k) \
        acc[ai][bj][m][n] = __builtin_amdgcn_mfma_f32_16x16x32_bf16(Bt[n][k], At[m][k], acc[ai][bj][m][n], 0, 0, 0); __builtin_amdgcn_s_setprio(0); } while (0)
#define PG8_WAIT_V(n) asm volatile("s_waitcnt vmcnt(" #n ")" ::: "memory")
#define PG8_WAIT_L(n) asm volatile("s_waitcnt lgkmcnt(" #n ")" ::: "memory")
#define PG8_BAR __builtin_amdgcn_s_barrier()
#define PG8_SCHED __builtin_amdgcn_sched_barrier(0)
#define PG8_MKOFF(dst, u) do { _Pragma("unroll") for (int _h = 0; _h < 2; ++_h) _Pragma("unroll") for (int _i = 0; _i < 2; ++_i) \
        dst[_h][_i] = (unsigned)S.arow(u, _h * HALF + RA[_i]) * (unsigned)(lda * 2) + CA2[_i]; } while (0)
    Unit cur, nxt; int ui = 0;
    if (!S.next(0, cur)) return;
    constexpr bool SK = Sched::SPLITK;
    f32x4 acc[2][2][4][2];
#pragma unroll
    for (int a = 0; a < 2; ++a)
#pragma unroll
        for (int b = 0; b < 2; ++b)
#pragma unroll
            for (int m = 0; m < 4; ++m)
#pragma unroll
                for (int n = 0; n < 2; ++n) acc[a][b][m][n] = (f32x4){0.f, 0.f, 0.f, 0.f};
    bf16x8 At[4][2], B0[2][2], B1[2][2];
    constexpr bool GA = Sched::GATHER;
    unsigned ca[2][2], na[2][2];
    const char* const Ab = (const char*)Aptr;
    const size_t tstepA = (size_t)BM * lda * 2;
    const char* cAp = Ab;
    if constexpr (GA) { PG8_MKOFF(ca, cur); }
    else { cAp = Ab + (size_t)cur.pm * tstepA + (SK ? (size_t)cur.k0 * 2 : (size_t)0);
#pragma unroll
        for (int h = 0; h < 2; ++h)
#pragma unroll
            for (int i = 0; i < 2; ++i) { ca[h][i] = (unsigned)((h * HALF + RA[i]) * lda) * 2u + CA2[i]; na[h][i] = ca[h][i]; } }
    const char* cB = S.bptr(cur) + (SK ? (size_t)cur.k0 * 2 : (size_t)0);
    PG8_STAGE(PG8_SB(0, 0), cB, voffB); PG8_STAGE(PG8_SB(0, 1), cB + hstep, voffB); PG8_STAGE(PG8_SA(0, 0), cAp, ca[0]); PG8_STAGE(PG8_SA(0, 1), cAp, ca[1]);
    if (wr == 1) PG8_BAR;
    PG8_WAIT_V(2); PG8_BAR;
    PG8_STAGE(PG8_SB(1, 0), cB + kstep, voffB); PG8_STAGE(PG8_SA(1, 0), cAp + kstep, ca[0]); PG8_STAGE(PG8_SB(1, 1), cB + hstep + kstep, voffB);
    PG8_WAIT_V(6); PG8_BAR;
    for (;;) {
        const bool has_next = S.next(ui + 1, nxt);
        const char* nB = cB; const char* nAp = cAp;
        if (has_next) { nB = S.bptr(nxt) + (SK ? (size_t)nxt.k0 * 2 : (size_t)0); if constexpr (GA) { PG8_MKOFF(na, nxt); } else nAp = Ab + (size_t)nxt.pm * tstepA + (SK ? (size_t)nxt.k0 * 2 : (size_t)0); }
        else if constexpr (GA) {
#pragma unroll
            for (int h = 0; h < 2; ++h)
#pragma unroll
                for (int i = 0; i < 2; ++i) na[h][i] = ca[h][i]; }
        const int cnt_t = SK ? __builtin_amdgcn_readfirstlane(cur.nt) : nt;
        for (int t = 0; t < cnt_t; t += 2) {
            const bool last = (t == cnt_t - 2);
            const char* a1 = cAp + (size_t)(t + 1) * kstep;
            const char* a2 = last ? nAp : cAp + (size_t)(t + 2) * kstep; const char* b2 = last ? nB : cB + (size_t)(t + 2) * kstep;
            const char* a3 = a2 + kstep; const char* b3 = b2 + kstep;
            unsigned o2[2][2];
#pragma unroll
            for (int h = 0; h < 2; ++h)
#pragma unroll
                for (int i = 0; i < 2; ++i) o2[h][i] = (GA && last) ? na[h][i] : ca[h][i];
            PG8_LDB(B0, 0, 0); PG8_LDB(B1, 0, 1); PG8_SCHED; PG8_LDA(At, 0, 0); PG8_STAGE(PG8_SA(1, 1), a1, ca[1]);
            PG8_WAIT_V(8); PG8_WAIT_L(0); PG8_BAR; PG8_MMA(0, 0, At, B0); PG8_MMA(0, 1, At, B1); PG8_BAR; PG8_SCHED;
            PG8_LDA(At, 0, 1); PG8_STAGE(PG8_SB(0, 0), b2, voffB); PG8_STAGE(PG8_SB(0, 1), b2 + hstep, voffB); PG8_STAGE(PG8_SA(0, 0), a2, o2[0]);
            PG8_WAIT_V(8); PG8_WAIT_L(0); PG8_BAR; PG8_MMA(1, 0, At, B0); PG8_MMA(1, 1, At, B1); PG8_BAR; PG8_SCHED;
            PG8_LDB(B0, 1, 0); PG8_LDB(B1, 1, 1); PG8_SCHED; PG8_LDA(At, 1, 0); PG8_STAGE(PG8_SA(0, 1), a2, o2[1]);
            PG8_WAIT_V(8); PG8_WAIT_L(0); PG8_BAR; PG8_MMA(0, 0, At, B0); PG8_MMA(0, 1, At, B1); PG8_BAR; PG8_SCHED;
            PG8_LDA(At, 1, 1); PG8_STAGE(PG8_SB(1, 0), b3, voffB); PG8_STAGE(PG8_SB(1, 1), b3 + hstep, voffB); PG8_STAGE(PG8_SA(1, 0), a3, o2[0]);
            PG8_WAIT_V(8); PG8_WAIT_L(0); PG8_BAR; PG8_MMA(1, 0, At, B0); PG8_MMA(1, 1, At, B1); PG8_BAR; PG8_SCHED;
        }
        if constexpr (ALIGN_EPI) { if (wr == 0) PG8_BAR; }
        E(acc, cur, wr, wc, fr, fq);
        if (!has_next) break;
#pragma unroll
        for (int a = 0; a < 2; ++a)
#pragma unroll
            for (int b = 0; b < 2; ++b)
#pragma unroll
                for (int m = 0; m < 4; ++m)
#pragma unroll
                    for (int n = 0; n < 2; ++n) acc[a][b][m][n] = (f32x4){0.f, 0.f, 0.f, 0.f};
        cur = nxt; cB = nB; cAp = nAp; ++ui;
        if constexpr (GA) {
#pragma unroll
            for (int h = 0; h < 2; ++h)
#pragma unroll
                for (int i = 0; i < 2; ++i) ca[h][i] = na[h][i]; }
        if constexpr (ALIGN_EPI) { if (wr == 1) PG8_BAR; }
    }
    PG8_WAIT_V(0);
    if constexpr (!ALIGN_EPI) { if (wr == 0) PG8_BAR; }
    PG8_BAR;
#undef PG8_SA
#undef PG8_SB
#undef PG8_STAGE
#undef PG8_LDA
#undef PG8_LDB
#undef PG8_MMA
#undef PG8_WAIT_V
#undef PG8_WAIT_L
#undef PG8_BAR
#undef PG8_SCHED
#undef PG8_MKOFF
}
}

__device__ __forceinline__ void moe_down_fixup(const pg8::MoeDownSched& S, const pg8::EpiMoeDownB& E, int tid) {
    if (S.c >= S.nchunk) return;
    const int lu = S.c / pg8::KCH, kc = S.c - lu * pg8::KCH;
    if (tid == 0) {
        __builtin_amdgcn_fence(__ATOMIC_RELEASE, "agent"); asm volatile("s_waitcnt vmcnt(0)" ::: "memory");
        (void)__hip_atomic_fetch_add(E.cnt + lu, 1u, __ATOMIC_RELAXED, __HIP_MEMORY_SCOPE_AGENT);
        unsigned sp = 0;
        while (__hip_atomic_load(E.cnt + lu, __ATOMIC_RELAXED, __HIP_MEMORY_SCOPE_AGENT) < (unsigned)pg8::KCH) { __builtin_amdgcn_s_sleep(1); if (++sp > (1u << 22)) break; }
        __builtin_amdgcn_fence(__ATOMIC_ACQUIRE, "agent"); asm volatile("s_waitcnt vmcnt(0)" ::: "memory"); }
    __syncthreads();
    const int wid = tid >> 6, lane = tid & 63, wr = wid >> 2, wc = wid & 3, fr = lane & 15, fq = lane >> 4;
    const u32x4* p = (const u32x4*)E.part + (size_t)(lu * pg8::KCH) * (16 * 512) + tid;
    pg8::Unit u; S.map(S.nfullu + lu, u);
    const int row0 = u.pm * pg8::BM + wr * 64 + fr, col0 = u.pn * pg8::BM + wc * 32 + 8 * fq;
#pragma unroll 1
    for (int am = kc; am < 8; am += pg8::KCH) { const int ai = am >> 2, m = am & 3; f32x4 v[2][2];
#pragma unroll
        for (int bj = 0; bj < 2; ++bj) { const int idx = (ai * 2 + bj) * 4 + m; f32x4 a0 = {0.f, 0.f, 0.f, 0.f}, a1 = {0.f, 0.f, 0.f, 0.f};
#pragma unroll
            for (int q = 0; q < pg8::KCH; ++q) { const u32x4 w = p[(size_t)q * (16 * 512) + (size_t)idx * 512];
                a0[0] += __uint_as_float(w.x << 16); a0[1] += __uint_as_float(w.x & 0xffff0000u); a0[2] += __uint_as_float(w.y << 16); a0[3] += __uint_as_float(w.y & 0xffff0000u);
                a1[0] += __uint_as_float(w.z << 16); a1[1] += __uint_as_float(w.z & 0xffff0000u); a1[2] += __uint_as_float(w.w << 16); a1[3] += __uint_as_float(w.w & 0xffff0000u); }
            v[bj][0] = a0; v[bj][1] = a1; }
        const int slot = row0 + ai * pg8::HALF + m * 16; const int tok = E.slot_tok[slot]; const float g = E.slot_g[slot];
        if (tok >= 0) { const size_t off = (size_t)tok * DM + col0;
#pragma unroll
            for (int bj = 0; bj < 2; ++bj) { const u32x4 r = *(const u32x4*)(E.xs + off + bj * pg8::HALF); const f32x4 v0 = v[bj][0] * g, v1 = v[bj][1] * g;
                u32x4 w; w.x = cvt_pk_bf16(__uint_as_float(r.x << 16) + v0[0], __uint_as_float(r.x & 0xffff0000u) + v0[1]); w.y = cvt_pk_bf16(__uint_as_float(r.y << 16) + v0[2], __uint_as_float(r.y & 0xffff0000u) + v0[3]);
                w.z = cvt_pk_bf16(__uint_as_float(r.z << 16) + v1[0], __uint_as_float(r.z & 0xffff0000u) + v1[1]); w.w = cvt_pk_bf16(__uint_as_float(r.w << 16) + v1[2], __uint_as_float(r.w & 0xffff0000u) + v1[3]);
                *(u32x4*)(E.xd + off + bj * pg8::HALF) = w; } } }
}

namespace att {
constexpr int NW = 8, QBLK = 32, KVBLK = 64, QB = NW * QBLK;
constexpr int SHM_V = 16384, SHM_K = 16384, SHM_R = 8192;
constexpr int NBUF = 3;
constexpr int OFF_K = 0, OFF_R = OFF_K + NBUF * SHM_K, OFF_WS = OFF_R + NBUF * SHM_R, OFF_V = OFF_WS + NW * 64 * 4, LDS_BYTES = OFF_V + NBUF * SHM_V;
constexpr float THR_L2 = 11.5f;
#define KSWZ(row, colB) ((row) * 256 + ((colB) ^ (((row) & 7) << 4)))
#define RSWZ(row, colB) (((row) >> 1) * 256 + (((((row) & 1) << 7) | (colB)) ^ ((((row) >> 1) & 7) << 4)))
#define SBAR() __builtin_amdgcn_sched_barrier(0)
__device__ __forceinline__ int v_st(int k, int c) { const int kk = (k & ~0xC) | ((k & 4) << 1) | ((k & 8) >> 1); return ((kk >> 3) * 4 + (c >> 5)) * 512 + ((kk & 7) * 32 + (c & 31)) * 2; }
__device__ __forceinline__ int v_rd_base(int lane) { return ((lane & 3) << 3) | (((lane >> 2) & 3) << 6) | (((lane >> 4) & 1) << 5) | (((lane >> 5) & 1) << 8); }
constexpr int v_rd_off(int d0, int ks, int half) { return d0 * 512 + ks * 4096 + half * 2048; }
__device__ __forceinline__ int crow(int r, int hi) { return (r & 3) + 8 * (r >> 2) + 4 * hi; }
__device__ __forceinline__ void mask_tile(f32x16& p0, f32x16& p1, int dq) {
    const float NEG = -__builtin_inff();
#pragma unroll
    for (int r = 0; r < 16; ++r) {
        const int c = (r & 3) + 8 * (r >> 2);
        if (dq - c < 0) p0[r] = NEG;
        if (dq - c - 32 < 0) p1[r] = NEG;
    }
}
__device__ __forceinline__ void partialSM(f32x16& p0, f32x16& p1, float& m_reg, float& mn, float& alpha) {
    float pmax = p0[0];
#pragma unroll
    for (int r = 1; r < 16; ++r) pmax = fmaxf(pmax, p0[r]);
#pragma unroll
    for (int r = 0; r < 16; ++r) pmax = fmaxf(pmax, p1[r]);
    { auto rr = __builtin_amdgcn_permlane32_swap(__float_as_uint(pmax), __float_as_uint(pmax), false, false);
      pmax = fmaxf(__uint_as_float(rr[0]), __uint_as_float(rr[1])); }
    if (__builtin_expect(__all((pmax - m_reg) <= THR_L2), 1)) { mn = m_reg; alpha = 1.f; }
    else { mn = fmaxf(m_reg, pmax); alpha = __builtin_amdgcn_exp2f(m_reg - mn); m_reg = mn; }
#pragma unroll
    for (int r = 0; r < 16; ++r) p0[r] = p0[r] - mn;
#pragma unroll
    for (int r = 0; r < 16; ++r) p1[r] = p1[r] - mn;
#pragma unroll
    for (int r = 0; r < 16; ++r) p0[r] = __builtin_amdgcn_exp2f(p0[r]);
}
__device__ __forceinline__ void finishSM(f32x16& p0, f32x16& p1, float alpha, float& l_reg, bf16x8& pa0, bf16x8& pa1, bf16x8& pa2, bf16x8& pa3) {
#pragma unroll
    for (int r = 0; r < 16; ++r) p1[r] = __builtin_amdgcn_exp2f(p1[r]);
    float ps = 0;
#pragma unroll
    for (int r = 0; r < 16; ++r) ps += p0[r];
#pragma unroll
    for (int r = 0; r < 16; ++r) ps += p1[r];
    { auto rr = __builtin_amdgcn_permlane32_swap(__float_as_uint(ps), __float_as_uint(ps), false, false);
      ps = __uint_as_float(rr[0]) + __uint_as_float(rr[1]); }
    l_reg = l_reg * alpha + ps;
#define PK4(P, B_, OUT) do { unsigned a0 = cvt_pk_bf16(P[B_+0], P[B_+1]), a1 = cvt_pk_bf16(P[B_+2], P[B_+3]);                          \
        unsigned b0 = cvt_pk_bf16(P[B_+4], P[B_+5]), b1 = cvt_pk_bf16(P[B_+6], P[B_+7]);                                             \
        auto r0 = __builtin_amdgcn_permlane32_swap(a0, b0, false, false); auto r1 = __builtin_amdgcn_permlane32_swap(a1, b1, false, false); \
        u32x4 w = {r0[0], r1[0], r0[1], r1[1]}; OUT = *reinterpret_cast<bf16x8*>(&w); } while (0)
    PK4(p0, 0, pa0); PK4(p0, 8, pa1); PK4(p1, 0, pa2); PK4(p1, 8, pa3);
#undef PK4
}
__device__ __forceinline__ void qkt(f32x16& p0, f32x16& p1, const char* lbk, const char* lbrk, const bf16x8* qr) {
    p0 = f32x16{}; p1 = f32x16{};
    bf16x8 F0[4], F1[4];
#define KLD(F, g) do { if ((g) < 4) { F[0] = *reinterpret_cast<const bf16x8*>(lbk + (2 * (g)) * 1024); F[1] = *reinterpret_cast<const bf16x8*>(lbk + (2 * (g)) * 1024 + 8192); \
                                      F[2] = *reinterpret_cast<const bf16x8*>(lbk + (2 * (g) + 1) * 1024); F[3] = *reinterpret_cast<const bf16x8*>(lbk + (2 * (g) + 1) * 1024 + 8192); } \
                       else { F[0] = *reinterpret_cast<const bf16x8*>(lbrk + (2 * (g) - 8) * 1024); F[1] = *reinterpret_cast<const bf16x8*>(lbrk + (2 * (g) - 8) * 1024 + 4096); \
                              F[2] = *reinterpret_cast<const bf16x8*>(lbrk + (2 * (g) - 7) * 1024); F[3] = *reinterpret_cast<const bf16x8*>(lbrk + (2 * (g) - 7) * 1024 + 4096); } } while (0)
#define KMM(F, g) do { p0 = __builtin_amdgcn_mfma_f32_32x32x16_bf16(F[0], qr[2 * (g)], p0, 0, 0, 0); p1 = __builtin_amdgcn_mfma_f32_32x32x16_bf16(F[1], qr[2 * (g)], p1, 0, 0, 0); \
                       p0 = __builtin_amdgcn_mfma_f32_32x32x16_bf16(F[2], qr[2 * (g) + 1], p0, 0, 0, 0); p1 = __builtin_amdgcn_mfma_f32_32x32x16_bf16(F[3], qr[2 * (g) + 1], p1, 0, 0, 0); } while (0)
    KLD(F0, 0); KLD(F1, 1); SBAR();
    KMM(F0, 0); SBAR(); KLD(F0, 2); SBAR();
    KMM(F1, 1); SBAR(); KLD(F1, 3); SBAR();
    KMM(F0, 2); SBAR(); KLD(F0, 4); SBAR();
    KMM(F1, 3); SBAR(); KLD(F1, 5); SBAR();
    KMM(F0, 4); SBAR();
    KMM(F1, 5); SBAR();
#undef KLD
#undef KMM
}
__device__ __forceinline__ void pv_tile(f32x16* o, int vbt, bf16x8 pa0, bf16x8 pa1, bf16x8 pa2, bf16x8 pa3) {
#define TRRD(dst, off) asm volatile("ds_read_b64_tr_b16 %0, %1 offset:%2" : "=&v"(dst) : "v"(vbt), "i"(off) : "memory")
#define TRRD8(L, d0) do { constexpr int b_ = v_rd_off(d0, 0, 0); TRRD(L[0], b_); TRRD(L[1], b_ + 2048); TRRD(L[2], b_ + 4096); TRRD(L[3], b_ + 6144); TRRD(L[4], b_ + 8192); TRRD(L[5], b_ + 10240); TRRD(L[6], b_ + 12288); TRRD(L[7], b_ + 14336); } while (0)
#define PVMM(L, d0) do { \
        o[d0] = __builtin_amdgcn_mfma_f32_32x32x16_bf16(pa0, (bf16x8){L[0][0], L[0][1], L[0][2], L[0][3], L[1][0], L[1][1], L[1][2], L[1][3]}, o[d0], 0, 0, 0);   \
        o[d0] = __builtin_amdgcn_mfma_f32_32x32x16_bf16(pa1, (bf16x8){L[2][0], L[2][1], L[2][2], L[2][3], L[3][0], L[3][1], L[3][2], L[3][3]}, o[d0], 0, 0, 0);   \
        o[d0] = __builtin_amdgcn_mfma_f32_32x32x16_bf16(pa2, (bf16x8){L[4][0], L[4][1], L[4][2], L[4][3], L[5][0], L[5][1], L[5][2], L[5][3]}, o[d0], 0, 0, 0);   \
        o[d0] = __builtin_amdgcn_mfma_f32_32x32x16_bf16(pa3, (bf16x8){L[6][0], L[6][1], L[6][2], L[6][3], L[7][0], L[7][1], L[7][2], L[7][3]}, o[d0], 0, 0, 0); } while (0)
#define WAITL(n) asm volatile("s_waitcnt lgkmcnt(" #n ")" ::: "memory")
    s16x4 La[8], Lb[8];
    TRRD8(La, 0); TRRD8(Lb, 1);
    WAITL(8); SBAR(); PVMM(La, 0); SBAR(); TRRD8(La, 2);
    WAITL(8); SBAR(); PVMM(Lb, 1); SBAR(); TRRD8(Lb, 3);
    WAITL(8); SBAR(); PVMM(La, 2); SBAR();
    WAITL(0); SBAR(); PVMM(Lb, 3); SBAR();
#undef TRRD
#undef TRRD8
#undef PVMM
#undef WAITL
}

struct BlockRef { const bf16_t* Q; const bf16_t* Kl; const bf16_t* Kr; bf16_t* O; int P0; };
#define VMW() asm volatile("s_waitcnt vmcnt(0)" ::: "memory")
#define SLOAD(k0) do { const bf16_t* kp_ = cur.Kl + (size_t)((k0) + srow) * 128 + cc * 8; st_k0 = *(const bf16x8*)kp_; st_k1 = *(const bf16x8*)(kp_ + 64); \
                       st_r = *(const bf16x8*)(cur.Kr + (size_t)((k0) + srow) * 64 + cc * 8); } while (0)
#define SWRITE_K(bf) do { char* kd_ = lds + OFF_K + (bf) * SHM_K + kws; *(bf16x8*)kd_ = st_k0; *(bf16x8*)(kd_ + 4096) = st_k1; *(bf16x8*)(lds + OFF_R + (bf) * SHM_R + rws) = st_r; } while (0)
#define SWRITE_V(bf) do { char* vd_ = lds + OFF_V + (bf) * SHM_V + vst0; *(bf16x8*)vd_ = st_k0; *(bf16x8*)(vd_ + 1024) = st_k1; } while (0)
#define ABAR() asm volatile("s_waitcnt lgkmcnt(0)\n\ts_barrier" ::: "memory")
template <int VAR>
__device__ __forceinline__ void attn_block(const BlockRef& cur, char* lds, int tid) {
    asm volatile("" : "+v"(tid));
    const int wid = __builtin_amdgcn_readfirstlane(tid >> 6), lane = tid & 63, r32 = lane & 31, hi = lane >> 5, grp = wid >> 2;
    const int NT = (cur.P0 + QB - 1) / KVBLK + 1;
    const int qlo = cur.P0 + wid * QBLK, qm = qlo + r32 - 4 * hi;
    float* ws = (float*)(lds + OFF_WS) + wid * 64; float* li_l = ws, * al_l = ws + 32;
    float m_reg = -1e30f, l_reg = 0; f32x16 o[4] = {};
    const int srow = wid * 8 + (lane & 7), cc = lane >> 3;
    const int kws = (srow >> 5) * 8192 + (cc >> 1) * 1024 + ((cc & 1) * 32 + (srow & 31)) * 16, rws = (srow >> 5) * 4096 + (cc >> 1) * 1024 + ((cc & 1) * 32 + (srow & 31)) * 16, vst0 = v_st(srow, cc * 8);
    const int vb0 = (int)(uintptr_t)lds + OFF_V + v_rd_base(lane);
    const char* lb = lds + OFF_K + lane * 16;
    int lbr_i = (int)(uintptr_t)lds + OFF_R + lane * 16; asm volatile("" : "+v"(lbr_i));
    const char* lbr = (const char*)(const LAS char*)(uintptr_t)(unsigned)lbr_i;
    bf16x8 qr[12], st_k0, st_k1, st_r;
    { const bf16_t* qp = cur.Q + (size_t)(wid * QBLK + r32) * QW + hi * 8;
#pragma unroll
      for (int d0 = 0; d0 < 12; ++d0) qr[d0] = *(const bf16x8*)(qp + d0 * 16); }
#define RESC(a) do { if (__any((a) < 1.f)) { if (hi == 0) al_l[r32] = (a); asm volatile("s_waitcnt lgkmcnt(0)" ::: "memory");              \
                     _Pragma("unroll") for (int d_ = 0; d_ < 4; ++d_) _Pragma("unroll") for (int r = 0; r < 16; ++r) o[d_][r] *= al_l[crow(r, hi)]; } } while (0)
#define KBASE(t) ((t) * KVBLK)
#define MASKT(P0_, P1_, t) do { const int kb_ = KBASE(t); if (kb_ + KVBLK - 1 > qlo) mask_tile(P0_, P1_, qm - kb_); } while (0)
    f32x16 p0 = {}, p1 = {}; float mn, al = 1.f; bf16x8 pa0 = {}, pa1 = {}, pa2 = {}, pa3 = {};
    const int dist = 1 + grp;
    SLOAD(0); VMW(); SWRITE_K(0); SWRITE_V(0);
    if (grp) { SLOAD(KBASE(1)); VMW(); SWRITE_K(1); SWRITE_V(1); }
    SLOAD(KBASE(dist));
    ABAR();
    if (grp) ABAR();
    int bt = 0;
    for (int t = 0; t < NT; ++t) {
        if (VAR != 2) { SBAR(); qkt(p0, p1, lb + bt * SHM_K, lbr + bt * SHM_R, qr);
        if (t > 0) pv_tile(o, vb0 + (bt == 0 ? 2 : bt - 1) * SHM_V, pa0, pa1, pa2, pa3); }
        SBAR(); ABAR();
        if (VAR != 1) { MASKT(p0, p1, t); partialSM(p0, p1, m_reg, mn, al); finishSM(p0, p1, al, l_reg, pa0, pa1, pa2, pa3); RESC(al); }
        else { asm volatile("" : "+v"(p0), "+v"(p1), "+v"(pa0), "+v"(pa1), "+v"(pa2), "+v"(pa3)); }
        { const int td = t + dist; if (td < NT) { int wbi = bt + dist; wbi = wbi >= 3 ? wbi - 3 : wbi; VMW(); SWRITE_K(wbi); SWRITE_V(wbi); if (td + 1 < NT) SLOAD(KBASE(td + 1)); } }
        bt = bt == 2 ? 0 : bt + 1;
        SBAR(); ABAR();
    }
    pv_tile(o, vb0 + (bt == 0 ? 2 : bt - 1) * SHM_V, pa0, pa1, pa2, pa3);
    if (hi == 0) li_l[r32] = l_reg; asm volatile("s_waitcnt lgkmcnt(0)" ::: "memory");
    float rli[16];
#pragma unroll
    for (int r = 0; r < 16; ++r) rli[r] = __builtin_amdgcn_rcpf(li_l[crow(r, hi)]);
    bf16_t* Ow = cur.O + (size_t)(wid * QBLK) * DM;
#pragma unroll
    for (int r = 0; r < 16; ++r) { const int orow = crow(r, hi);
#pragma unroll
        for (int d0 = 0; d0 < 4; ++d0) { const float v = o[d0][r] * rli[r];
            const float vn = xlane1(v);
            if ((r32 & 1) == 0) *(unsigned*)(Ow + (size_t)orow * DM + d0 * 32 + r32) = cvt_pk_bf16(v, vn); } }
    if (!grp) ABAR();
    ABAR();
#undef RESC
#undef KBASE
#undef MASKT
}
#undef ABAR
#undef VMW
#undef SLOAD
#undef SWRITE_K
#undef SWRITE_V
}

constexpr int NWAVES = 8;
constexpr int RING_BYTES = 157696, MISC_OFF = RING_BYTES + 64, LDS_BYTES = 158720;
static_assert(att::LDS_BYTES <= RING_BYTES && pg8::STAGE_BYTES <= RING_BYTES, "phase scratch fits the ring region");
#define RLX_AGENT __ATOMIC_RELAXED, __HIP_MEMORY_SCOPE_AGENT

#define XB_TMO      128
#define XB_XCNT(j)  (256  + 64 * (j))
#define XB_XSUB(j)  (1280 + 64 * (j))
#define XB_XGEN(j)  (2304 + 64 * (j))
#define XB_TOP      3328
#define XB_TOPGEN   3392
#define XCD_BAR_WORDS 3456
#define XB_SPIN_CAP (1u << 18)
__device__ __forceinline__ unsigned xb_ld(unsigned* p)              { return __hip_atomic_load(p, __ATOMIC_RELAXED, __HIP_MEMORY_SCOPE_AGENT); }
__device__ __forceinline__ unsigned xb_add(unsigned* p, unsigned v) { return __hip_atomic_fetch_add(p, v, __ATOMIC_RELAXED, __HIP_MEMORY_SCOPE_AGENT); }
__device__ __forceinline__ unsigned xb_xcc_id() { return (unsigned)__builtin_amdgcn_s_getreg((3 << 11) | 20) & 0xFu; }
#define XB_SPIN(cond, bar) do { unsigned _sp = 0; while (cond) { __builtin_amdgcn_s_sleep(1); \
    if ((++_sp & 255u) == 0u) { if (xb_ld(&(bar)[XB_TMO])) break; if (_sp > XB_SPIN_CAP) { atomicAdd(&(bar)[XB_TMO], 1u); break; } } } } while (0)
struct XcdBarrier { unsigned* bar; unsigned x; volatile LAS unsigned* st; };
__device__ __forceinline__ XcdBarrier xcd_barrier_post(unsigned* bar, volatile LAS unsigned* st) {
    XcdBarrier b; b.bar = bar; b.x = xb_xcc_id(); b.st = st;
    if (threadIdx.x == 0) (void)xb_add(&bar[XB_XCNT(b.x)], 1u);
    return b;
}
__device__ __forceinline__ void xcd_barrier_complete(unsigned* bar, unsigned x, unsigned& nloc, unsigned& nx) {
    const unsigned G = gridDim.x * gridDim.y * gridDim.z;
    unsigned sum, cnt, mine, sp = 0u;
    for (;;) {
        sum = 0u; cnt = 0u; mine = 0u;
#pragma unroll
        for (unsigned j = 0; j < 16; ++j) { const unsigned c = xb_ld(&bar[XB_XCNT(j)]); sum += c; cnt += (c > 0u) ? 1u : 0u; mine = (j == x) ? c : mine; }
        if (sum == G) break;
        __builtin_amdgcn_s_sleep(1);
        if ((++sp & 255u) == 0u) { if (xb_ld(&bar[XB_TMO])) break; if (sp > XB_SPIN_CAP) { atomicAdd(&bar[XB_TMO], 1u); break; } }
    }
    nloc = mine > 0u ? mine : 1u; nx = cnt > 0u ? cnt : 1u;
}
__device__ __forceinline__ void xcd_barrier(const XcdBarrier& b, const bool leader  ) {
    asm volatile("s_waitcnt vmcnt(0)" ::: "memory");
    __syncthreads();
    if (leader) {
        unsigned* bar = b.bar;
        __builtin_amdgcn_s_waitcnt(0);
        unsigned nloc = b.st[0], nx = b.st[1];
        if (nloc == 0u) { xcd_barrier_complete(bar, b.x, nloc, nx); b.st[0] = nloc; b.st[1] = nx; }
        const unsigned old = xb_add(&bar[XB_XSUB(b.x)], 1u);
        const unsigned gen = old / nloc;
        if (old + 1u == (gen + 1u) * nloc) {
            __builtin_amdgcn_fence(__ATOMIC_RELEASE, "agent");
            asm volatile("s_waitcnt vmcnt(0)" ::: "memory");
            const unsigned og = xb_add(&bar[XB_TOP], 1u);
            const unsigned tg = og / nx;
            if (og + 1u == (tg + 1u) * nx) xb_add(&bar[XB_TOPGEN], 1u);
            else XB_SPIN(xb_ld(&bar[XB_TOPGEN]) == tg, bar);
            __builtin_amdgcn_fence(__ATOMIC_ACQUIRE, "agent");
            xb_add(&bar[XB_XGEN(b.x)], 1u);
            asm volatile("s_waitcnt vmcnt(0)" ::: "memory");
        } else {
            XB_SPIN(xb_ld(&bar[XB_XGEN(b.x)]) == gen, bar);
            __builtin_amdgcn_fence(__ATOMIC_ACQUIRE, "agent");
            asm volatile("s_waitcnt vmcnt(0)" ::: "memory");
        }
    }
    __syncthreads();
}

__device__ const double ROPE_INVF[32] = {1.0, 0.7498942093324559, 0.5623413251903491, 0.4216965034285822, 0.31622776601683794, 0.23713737056616552, 0.1778279410038923, 0.1333521432163324, 0.1,
    0.07498942093324558, 0.05623413251903491, 0.042169650342858224, 0.03162277660168379, 0.023713737056616554, 0.01778279410038923, 0.01333521432163324, 0.01, 0.007498942093324558,
    0.005623413251903491, 0.004216965034285823, 0.0031622776601683794, 0.0023713737056616554, 0.0017782794100389228, 0.001333521432163324, 0.001, 0.0007498942093324559, 0.0005623413251903491,
    0.00042169650342858224, 0.00031622776601683794, 0.00023713737056616554, 0.00017782794100389227, 0.0001333521432163324};
__device__ __forceinline__ void sincos_d(double a, float& s_out, float& c_out) {
    const double kq = __builtin_rint(a * 0.6366197723675814);
    double r = a - kq * 1.570796325802803; r -= kq * 9.920935796805404e-10;
    const double r2 = r * r;
    double sp = -1.0 / 1307674368000.0; sp = sp * r2 + 1.0 / 6227020800.0; sp = sp * r2 - 1.0 / 39916800.0; sp = sp * r2 + 1.0 / 362880.0; sp = sp * r2 - 1.0 / 5040.0; sp = sp * r2 + 1.0 / 120.0; sp = sp * r2 - 1.0 / 6.0; sp = sp * r2 + 1.0;
    const double sn = sp * r;
    double cp = 1.0 / 20922789888000.0; cp = cp * r2 - 1.0 / 87178291200.0; cp = cp * r2 + 1.0 / 479001600.0; cp = cp * r2 - 1.0 / 3628800.0; cp = cp * r2 + 1.0 / 40320.0; cp = cp * r2 - 1.0 / 720.0; cp = cp * r2 + 1.0 / 24.0; cp = cp * r2 - 0.5; cp = cp * r2 + 1.0;
    const int q = ((int)kq) & 3;
    const double s = (q == 0) ? sn : (q == 1) ? cp : (q == 2) ? -sn : -cp;
    const double c = (q == 0) ? cp : (q == 1) ? -sn : (q == 2) ? -cp : sn;
    s_out = (float)s; c_out = (float)c;
}
struct TrItem { const float* W; bf16_t* dst; int N, k0, n0, drow0, ldd, kofs; };
__device__ __forceinline__ void tr_load(const TrItem& t, float (&tv)[32], int lane) {
#pragma unroll
    for (int i = 0; i < 32; ++i) tv[i] = t.W[(size_t)(t.k0 + 2 * i + (lane >> 5)) * t.N + t.n0 + (lane & 31)];
}
__device__ __forceinline__ void tr_store(const TrItem& t, const float (&tv)[32], LAS float* scr, int lane) {
#pragma unroll
    for (int i = 0; i < 32; ++i) scr[(2 * i + (lane >> 5)) * 33 + (lane & 31)] = tv[i];
    LDS_WAIT(); asm volatile("" ::: "memory");
    const int c = lane & 7;
#pragma unroll
    for (int j = 0; j < 4; ++j) { const int n = (lane >> 3) + 8 * j; const LAS float* s = scr + (8 * c) * 33 + n;
        u32x4 o; o.x = cvt_pk_bf16(s[0 * 33], s[1 * 33]); o.y = cvt_pk_bf16(s[2 * 33], s[3 * 33]); o.z = cvt_pk_bf16(s[4 * 33], s[5 * 33]); o.w = cvt_pk_bf16(s[6 * 33], s[7 * 33]);
        *(u32x4*)(t.dst + (size_t)(t.drow0 + n) * t.ldd + t.kofs + 8 * c) = o; }
    LDS_WAIT(); asm volatile("" ::: "memory");
}
template <class Dec>
__device__ __forceinline__ void tr_run(const Dec& dec, int nit, int gw, int NGW, LAS float* scr, int lane) {
    float ta[32], tb[32]; TrItem A, B;
    int it = gw; if (it < nit) { A = dec(it); tr_load(A, ta, lane); }
    while (it < nit) {
        const int it1 = it + NGW; if (it1 < nit) { B = dec(it1); tr_load(B, tb, lane); }
        tr_store(A, ta, scr, lane);
        const int it2 = it1 + NGW; if (it2 < nit) { A = dec(it2); tr_load(A, ta, lane); }
        if (it1 < nit) tr_store(B, tb, scr, lane);
        it = it2;
    }
}

struct Args { const float* in[21]; float* out; unsigned char* ws; int ph_lo, ph_hi; };
typedef const Args __attribute__((address_space(4))) * KArgsP;
enum { I_X = 0, I_ATTN_NORM, I_W_IN, I_LB, I_OUT_NORM, I_Q_NORM, I_W_UQ, I_KV_NORM, I_W_UKV, I_POOL_W, I_POOL_SCALE, I_W_O, I_FFN_NORM, I_DG, I_DU, I_DD, I_ROUTER, I_MG, I_MU, I_MD, I_FINAL_NORM };
constexpr int NPH = 23;

constexpr int P0_I_WIN = 16 * 70, P0_I_WOP = 8 * 32, P0_I_DGU = 16 * 80, P0_I_DDN = 40 * 32, P0_NIT = 2 * P0_I_WIN + 2 * P0_I_WOP + 2 * P0_I_DGU + P0_I_DDN;
struct DenseDec { KArgsP ap_; unsigned char* ws;
    __device__ __forceinline__ TrItem operator()(int it) const { constexpr int I_WIN = P0_I_WIN, I_WOP = P0_I_WOP, I_DGU = P0_I_DGU; int r = it; TrItem t;
        if (r < 2 * I_WIN) { const int l = r / I_WIN; r -= l * I_WIN; const int kb = r / 70, nb = r % 70;
            t.W = ap_->in[I_W_IN] + (size_t)l * DM * DIN; t.N = DIN; t.k0 = kb * 64; t.n0 = nb * 32; t.dst = (bf16_t*)(ws + WS_WIN) + (size_t)l * DINP * DM; t.drow0 = nb * 32; t.ldd = DM; t.kofs = kb * 64; return t; }
        r -= 2 * I_WIN;
        if (r < 2 * I_WOP) { const int l = r / I_WOP; r -= l * I_WOP; const int kq = r / 32, nb = r % 32; const int kb = kq < 4 ? kq : kq + 8;
            t.W = ap_->in[I_W_O] + (size_t)l * DM * DM; t.N = DM; t.k0 = kb * 64; t.n0 = nb * 32; t.dst = (bf16_t*)(ws + WS_WO) + (size_t)l * DM * DM; t.drow0 = nb * 32; t.ldd = DM; t.kofs = kb * 64; return t; }
        r -= 2 * I_WOP;
        if (r < 2 * I_DGU) { const int up = r / I_DGU; r -= up * I_DGU; const int kb = r / 80, nb = r % 80; const int n0 = nb * 32;
            t.W = ap_->in[up ? I_DU : I_DG]; t.N = DFF; t.k0 = kb * 64; t.n0 = n0; t.dst = (bf16_t*)(ws + WS_WGU); t.drow0 = (n0 >> 7) * 256 + up * 128 + (n0 & 127); t.ldd = DM; t.kofs = kb * 64; return t; }
        r -= 2 * I_DGU;
        { const int kb = r / 32, nb = r % 32; t.W = ap_->in[I_DD]; t.N = DM; t.k0 = kb * 64; t.n0 = nb * 32; t.dst = (bf16_t*)(ws + WS_WD); t.drow0 = nb * 32; t.ldd = DFF; t.kofs = kb * 64; return t; } } };
constexpr int MOE_I_GU = 16 * 112, MOE_I_DN = 56 * 32, MOE_I_E = 2 * MOE_I_GU + MOE_I_DN;
struct MoeDec { const float* mg; const float* mu; const float* md; unsigned char* wsp;
    __device__ __forceinline__ TrItem operator()(int it) const { constexpr int I_GU = MOE_I_GU, I_E = MOE_I_E; const int e = it / I_E; int r = it % I_E; bf16_t* we = (bf16_t*)(wsp + WS_MOEW) + (size_t)e * MOEW_E; TrItem t;
        if (r < 2 * I_GU) { const int up = r / I_GU; r -= up * I_GU; const int kb = r / 112, nb = r % 112, n0 = nb * 32;
            t.W = (up ? mu : mg) + (size_t)e * DM * DFFE; t.N = DFFE; t.k0 = kb * 64; t.n0 = n0; t.dst = we; t.drow0 = (n0 >> 7) * 256 + up * 128 + (n0 & 127); t.ldd = DM; t.kofs = kb * 64; }
        else { r -= 2 * I_GU; const int kb = r / 32, nb = r % 32;
            t.W = md + (size_t)e * DFFE * DM; t.N = DM; t.k0 = kb * 64; t.n0 = nb * 32; t.dst = we + (size_t)2 * DFFE * DM; t.drow0 = nb * 32; t.ldd = DFFE; t.kofs = kb * 64; }
        return t; } };
struct P0StreamDec { DenseDec d; MoeDec m; __device__ __forceinline__ TrItem operator()(int it) const { if (it < P0_NIT) return d(it); return m(it - P0_NIT); } };
__device__ __forceinline__ void p0_stream(KArgsP ap_, LAS unsigned char* lds, int gw, int NGW, int wave, int lane) {
    LAS float* scr = (LAS float*)(lds + wave * 16384);
    P0StreamDec dec{DenseDec{ap_, ap_->ws}, MoeDec{ap_->in[I_MG], ap_->in[I_MU], ap_->in[I_MD], ap_->ws}};
    tr_run(dec, P0_NIT + NE * MOE_I_E, gw, NGW, scr, lane);
}

__device__ __forceinline__ void p0_prologue(KArgsP ap_, LAS unsigned char* lds, int gw, int NGW, int gt, int NGT, int wave, int lane, const int part) {
    unsigned char* ws = ap_->ws;
    LAS float* scr = (LAS float*)(lds + wave * 16384);
    for (int i = gt; i < 2 * 64 * DM / 8; i += NGT) { const int l = i / (64 * DM / 8), r = i % (64 * DM / 8);
        *(u32x4*)((bf16_t*)(ws + WS_WIN) + ((size_t)l * DINP + DIN) * DM + (size_t)r * 8) = (u32x4){0u, 0u, 0u, 0u}; }
    const float qscale = 0.07216878364870322f * 1.4426950408889634f;
    for (int i = gt; i < 2 * 4 * 16 * 256; i += NGT) { const int c = i & 255, jg = (i >> 8) & 15, h = (i >> 12) & 3, l = i >> 14, j0 = jg * 8;
        const float* wuq = ap_->in[I_W_UQ] + (size_t)l * 256 * QW + (size_t)c * QW + h * 192; const float* wk = ap_->in[I_W_UKV] + (size_t)l * 128 * 1024 + (size_t)j0 * 1024 + h * 256;
        float acc[8];
#pragma unroll
        for (int q = 0; q < 8; ++q) acc[q] = 0.f;
#pragma unroll 4
        for (int d = 0; d < 128; d += 4) { const f32x4 x = *(const f32x4*)(wuq + d);
#pragma unroll
            for (int q = 0; q < 8; ++q) { const f32x4 y = *(const f32x4*)(wk + (size_t)q * 1024 + d); acc[q] += (x[0] * y[0] + x[1] * y[1]) + (x[2] * y[2] + x[3] * y[3]); } }
        const float gsc = ap_->in[I_Q_NORM][l * 256 + c] * qscale;
#pragma unroll
        for (int q = 0; q < 8; ++q) ((bf16_t*)(ws + WS_WQ))[((size_t)l * QW + h * 192 + j0 + q) * 256 + c] = f2bf(acc[q] * gsc); }
    for (int i = gt; i < 2 * 4 * 64 * 256; i += NGT) { const int c = i & 255, jj = (i >> 8) & 63, h = (i >> 14) & 3, l = i >> 16;
        const float v = ap_->in[I_W_UQ][(size_t)l * 256 * QW + (size_t)c * QW + h * 192 + 128 + (jj >> 1) + 32 * (jj & 1)];
        ((bf16_t*)(ws + WS_WQ))[((size_t)l * QW + h * 192 + 128 + jj) * 256 + c] = f2bf(v * ap_->in[I_Q_NORM][l * 256 + c] * qscale); }
    for (int i = gt; i < 2 * DM * 64; i += NGT) { const int n = i & 1023, g = (i >> 10) & 63, l = i >> 16, kk0 = g * 8, h = kk0 >> 7, r0 = kk0 & 127;
        const float* wv = ap_->in[I_W_UKV] + (size_t)l * 128 * 1024 + (size_t)r0 * 1024 + h * 256 + 128; const float* wo = ap_->in[I_W_O] + (size_t)l * DM * DM + (size_t)(256 + h * 128) * DM + n;
        float acc[8];
#pragma unroll
        for (int j = 0; j < 8; ++j) acc[j] = 0.f;
#pragma unroll 4
        for (int e = 0; e < 128; e += 4) { const float w0 = wo[(size_t)e * DM], w1 = wo[(size_t)(e + 1) * DM], w2 = wo[(size_t)(e + 2) * DM], w3 = wo[(size_t)(e + 3) * DM];
#pragma unroll
            for (int j = 0; j < 8; ++j) { const f32x4 x = *(const f32x4*)(wv + (size_t)j * 1024 + e); acc[j] += (x[0] * w0 + x[1] * w1) + (x[2] * w2 + x[3] * w3); } }
        *(u32x4*)((bf16_t*)(ws + WS_WO) + (size_t)l * DM * DM + (size_t)n * DM + 256 + kk0) = (u32x4){cvt_pk_bf16(acc[0], acc[1]), cvt_pk_bf16(acc[2], acc[3]), cvt_pk_bf16(acc[4], acc[5]), cvt_pk_bf16(acc[6], acc[7])}; }
    for (int i = gt; i < SEQ * 32; i += NGT) { const int pos = i >> 5, f = i & 31; float s, c; sincos_d((double)pos * ROPE_INVF[f], s, c); ((float*)(ws + WS_COS))[i] = c; ((float*)(ws + WS_SIN))[i] = s; }
    for (int i = gt; i < 512; i += NGT) { const float x0 = ap_->in[I_LB][i], x1 = ap_->in[I_LB][512 + i]; ((float*)(ws + WS_LBS))[i] = 0.f; ((float*)(ws + WS_LBS))[512 + i] = 1.f / (1.f + expf(x0 - x1)); }
}
__device__ __forceinline__ void unpack4(const u32x2 w, f32x4& v) { v[0] = __uint_as_float(w.x << 16); v[1] = __uint_as_float(w.x & 0xffff0000u); v[2] = __uint_as_float(w.y << 16); v[3] = __uint_as_float(w.y & 0xffff0000u); }
template <bool XB16>
__device__ __forceinline__ void norm_to_bf16(const void* xs_, const bf16_t* dl, bf16_t* xd, const float* g, bf16_t* hn, int gw, int NGW, int lane) {
    f32x4 gv[4];
#pragma unroll
    for (int j = 0; j < 4; ++j) gv[j] = *(const f32x4*)(g + 4 * lane + 256 * j);
    for (int m0 = gw; m0 < T; m0 += 2 * NGW) {
        const int m1 = m0 + NGW < T ? m0 + NGW : m0; f32x4 v[2][4]; u32x2 xw[2][4], dw[2][4];
#pragma unroll
        for (int u = 0; u < 2; ++u) { const int m = u ? m1 : m0;
            if (XB16) { const u32x2* xr = (const u32x2*)((const bf16_t*)xs_ + (size_t)m * DM) + lane;
#pragma unroll
                for (int j = 0; j < 4; ++j) xw[u][j] = xr[64 * j]; }
            else { const f32x4* xr = (const f32x4*)((const float*)xs_ + (size_t)m * DM) + lane;
#pragma unroll
                for (int j = 0; j < 4; ++j) v[u][j] = xr[64 * j]; }
            if (dl) { const u32x2* dr = (const u32x2*)(dl + (size_t)m * DM) + lane;
#pragma unroll
                for (int j = 0; j < 4; ++j) dw[u][j] = dr[64 * j]; } }
#pragma unroll
        for (int u = 0; u < 2; ++u) { const int m = u ? m1 : m0; if (u && m1 == m0) break; float s = 0.f;
            if (XB16) {
#pragma unroll
                for (int j = 0; j < 4; ++j) unpack4(xw[u][j], v[u][j]); }
            if (dl) {
#pragma unroll
                for (int j = 0; j < 4; ++j) { f32x4 d; unpack4(dw[u][j], d); v[u][j] += d;
                    u32x2 w; w.x = cvt_pk_bf16(v[u][j][0], v[u][j][1]); w.y = cvt_pk_bf16(v[u][j][2], v[u][j][3]); *(u32x2*)(xd + (size_t)m * DM + 4 * lane + 256 * j) = w; } }
#pragma unroll
            for (int j = 0; j < 4; ++j) s += (v[u][j][0] * v[u][j][0] + v[u][j][1] * v[u][j][1]) + (v[u][j][2] * v[u][j][2] + v[u][j][3] * v[u][j][3]);
            const float rstd = 1.0f / sqrtf(wave_sum(s) * (1.f / DM) + EPS);
#pragma unroll
            for (int j = 0; j < 4; ++j) { const f32x4 o = v[u][j] * rstd * gv[j]; u32x2 w; w.x = cvt_pk_bf16(o[0], o[1]); w.y = cvt_pk_bf16(o[2], o[3]); *(u32x2*)(hn + (size_t)m * DM + 4 * lane + 256 * j) = w; } }
    }
}
__device__ __forceinline__ void norm_final(const bf16_t* x, float* out, const float* g, int gw, int NGW, int lane) {
    f32x4 gv[4];
#pragma unroll
    for (int j = 0; j < 4; ++j) gv[j] = *(const f32x4*)(g + 4 * lane + 256 * j);
    for (int m0 = gw; m0 < T; m0 += 2 * NGW) {
        const int m1 = m0 + NGW < T ? m0 + NGW : m0; u32x2 xw[2][4];
#pragma unroll
        for (int u = 0; u < 2; ++u) { const int m = u ? m1 : m0; const u32x2* xr = (const u32x2*)(x + (size_t)m * DM) + lane;
#pragma unroll
            for (int j = 0; j < 4; ++j) xw[u][j] = xr[64 * j]; }
#pragma unroll
        for (int u = 0; u < 2; ++u) { const int m = u ? m1 : m0; if (u && m1 == m0) break; float s = 0.f; f32x4 v[4];
#pragma unroll
            for (int j = 0; j < 4; ++j) { unpack4(xw[u][j], v[j]); s += (v[j][0] * v[j][0] + v[j][1] * v[j][1]) + (v[j][2] * v[j][2] + v[j][3] * v[j][3]); }
            const float rstd = 1.0f / sqrtf(wave_sum(s) * (1.f / DM) + EPS);
            f32x4* xw4 = (f32x4*)(out + (size_t)m * DM) + lane;
#pragma unroll
            for (int j = 0; j < 4; ++j) xw4[64 * j] = v[j] * rstd * gv[j]; }
    }
}
template <bool SLIM>
__device__ __forceinline__ void norm_router(bf16_t* x, const bf16_t* dl, const float* g, const float* router, bf16_t* hn, int* tok_e, float* tok_g, int* counts, LAS unsigned char* lds, int bx, int G, int tid, int wave, int lane) {
    LAS float* rl = (LAS float*)lds;
    LAS int* cl = (LAS int*)(lds + 32768);
    for (int i = tid; i < DM * NE; i += NWAVES * 64) rl[i] = router[i];
    f32x4 gv[4];
#pragma unroll
    for (int j = 0; j < 4; ++j) gv[j] = *(const f32x4*)(g + 4 * lane + 256 * j);
    for (int rg = bx; rg < T / 128; rg += G) {
        if (tid < 16) cl[tid] = 0;
        __syncthreads();
        u32x2 dwn[4], xwn[4];
        { const int m = rg * 128 + wave * 16; const u32x2* xr = (const u32x2*)(x + (size_t)m * DM) + lane; const u32x2* dr = (const u32x2*)(dl + (size_t)m * DM) + lane;
#pragma unroll
          for (int j = 0; j < 4; ++j) { if constexpr (!SLIM) dwn[j] = dr[64 * j]; xwn[j] = xr[64 * j]; } }
        for (int rr = 0; rr < 16; ++rr) { const int m = rg * 128 + wave * 16 + rr;
            u32x2* xr = (u32x2*)(x + (size_t)m * DM) + lane; f32x4 v[4]; u32x2 dw[4], xw[4]; float s = 0.f;
#pragma unroll
            for (int j = 0; j < 4; ++j) { dw[j] = dwn[j]; xw[j] = xwn[j]; }
            if (rr + 1 < 16) { const u32x2* xq = (const u32x2*)(x + (size_t)(m + 1) * DM) + lane; const u32x2* dq = (const u32x2*)(dl + (size_t)(m + 1) * DM) + lane;
#pragma unroll
                for (int j = 0; j < 4; ++j) { if constexpr (!SLIM) dwn[j] = dq[64 * j]; xwn[j] = xq[64 * j]; } }
#pragma unroll
            for (int j = 0; j < 4; ++j) { unpack4(xw[j], v[j]);
                if constexpr (!SLIM) { f32x4 d; unpack4(dw[j], d); v[j] += d; u32x2 w; w.x = cvt_pk_bf16(v[j][0], v[j][1]); w.y = cvt_pk_bf16(v[j][2], v[j][3]); xr[64 * j] = w; }
                s += (v[j][0] * v[j][0] + v[j][1] * v[j][1]) + (v[j][2] * v[j][2] + v[j][3] * v[j][3]); }
            const float rstd = 1.0f / sqrtf(wave_sum(s) * (1.f / DM) + EPS);
            float lg[NE];
#pragma unroll
            for (int e = 0; e < NE; ++e) lg[e] = 0.f;
#pragma unroll
            for (int j = 0; j < 4; ++j) { const f32x4 o = v[j] * rstd * gv[j]; if constexpr (!SLIM) { u32x2 w; w.x = cvt_pk_bf16(o[0], o[1]); w.y = cvt_pk_bf16(o[2], o[3]); *(u32x2*)(hn + (size_t)m * DM + 4 * lane + 256 * j) = w; }
#pragma unroll
                for (int i = 0; i < 4; ++i) { const LAS f32x4* rp = (const LAS f32x4*)(rl + (size_t)(4 * lane + 256 * j + i) * NE); const f32x4 r0 = rp[0], r1 = rp[1];
                    lg[0] += o[i] * r0[0]; lg[1] += o[i] * r0[1]; lg[2] += o[i] * r0[2]; lg[3] += o[i] * r0[3]; lg[4] += o[i] * r1[0]; lg[5] += o[i] * r1[1]; lg[6] += o[i] * r1[2]; lg[7] += o[i] * r1[3]; } }
#pragma unroll
            for (int e = 0; e < NE; ++e) lg[e] = wave_sum(lg[e]);
            int i1 = 0; float v1 = lg[0];
#pragma unroll
            for (int e = 1; e < NE; ++e) if (lg[e] > v1) { v1 = lg[e]; i1 = e; }
            int i2 = -1; float v2 = -3.0e38f;
#pragma unroll
            for (int e = 0; e < NE; ++e) if (e != i1 && lg[e] > v2) { v2 = lg[e]; i2 = e; }
            const float ex = expf(v2 - v1), g1 = 1.f / (1.f + ex), g2 = ex * g1;
            if (lane == 0) { tok_e[2 * m] = i1; tok_e[2 * m + 1] = i2; tok_g[2 * m] = g1; tok_g[2 * m + 1] = g2; atomicAdd((int*)&cl[i1], 1); atomicAdd((int*)&cl[8 + i2], 1); }
        }
        __syncthreads();
        if (tid < 16) counts[rg * 16 + tid] = cl[tid];
        __syncthreads();
    }
}
__device__ __forceinline__ void route_tables(const int* tok_e, const float* tok_g, const int* counts, int* slot_tok, float* slot_g, int* tile_e, LAS unsigned char* lds, int bx, int G, int tid) {
    LAS int* pre = (LAS int*)lds;
    LAS int* off = (LAS int*)(lds + 257 * 16 * 4);
    LAS int* el = off + 16;
    { LAS int* segt = el + 256;
      for (int i = tid; i < 256 * 16; i += NWAVES * 64) pre[i] = counts[i];
      __syncthreads();
      const int col = tid & 15, seg = (tid >> 4) & 15;
      if (tid < 256) { int run = 0; for (int k = 0; k < 16; ++k) { const int rg = seg * 16 + k; const int v = pre[rg * 16 + col]; pre[rg * 16 + col] = run; run += v; } segt[seg * 16 + col] = run; }
      __syncthreads();
      if (tid < 256) { int base = 0; for (int s2 = 0; s2 < seg; ++s2) base += segt[s2 * 16 + col];
          for (int k = 0; k < 16; ++k) pre[(seg * 16 + k) * 16 + col] += base;
          if (seg == 15) pre[256 * 16 + col] = base + segt[15 * 16 + col]; }
      __syncthreads(); }
    if (tid < 2) { int run = 0; for (int e = 0; e < NE; ++e) { off[tid * 8 + e] = run; run += (pre[256 * 16 + tid * 8 + e] + 255) & ~255; }
        if (bx == 0) { tile_e[tid * 256] = run >> 8; for (int e = 0; e < NE; ++e) { const int t0 = off[tid * 8 + e] >> 8, nt = (pre[256 * 16 + tid * 8 + e] + 255) >> 8; for (int t = 0; t < nt; ++t) tile_e[tid * 256 + 1 + t0 + t] = e; } } }
    __syncthreads();
    if (bx == 0) {
        for (int i = tid; i < 16 * 256; i += NWAVES * 64) { const int re = i >> 8, j = i & 255, r = re >> 3; const int tot = pre[256 * 16 + re], padn = ((tot + 255) & ~255) - tot;
            if (j < padn) { slot_tok[r * MOE_ROWS + off[re] + tot + j] = -1; slot_g[r * MOE_ROWS + off[re] + tot + j] = 0.f; } } }
    for (int rg = bx; rg < T / 128; rg += G) {
        if (tid < 256) { const int r = tid >> 7, j = tid & 127; el[r * 128 + j] = tok_e[2 * (rg * 128 + j) + r]; }
        __syncthreads();
        if (tid < 256) { const int r = tid >> 7, j = tid & 127, m = rg * 128 + j, e = el[r * 128 + j]; int loc = 0;
            for (int jj = 0; jj < j; ++jj) loc += (el[r * 128 + jj] == e) ? 1 : 0;
            const int slot = off[r * 8 + e] + pre[rg * 16 + r * 8 + e] + loc;
            slot_tok[r * MOE_ROWS + slot] = m; slot_g[r * MOE_ROWS + slot] = tok_g[2 * m + r]; }
        __syncthreads();
    }
}

__device__ __forceinline__ void prep_tokens(const bf16_t* proj, const float* kvg, const float* cosT, const float* sinT, float* rstdq, bf16_t* klat, bf16_t* krope, int gw, int NGW, int lane) {
    const float g0 = kvg[2 * lane], g1 = kvg[2 * lane + 1];
    constexpr int NT = 4;
    for (int mb = gw; mb < T; mb += NT * NGW) {
        u32x2 cq[NT]; unsigned ck[NT]; unsigned short xa[NT], xb[NT]; float cc[NT], sn[NT];
#pragma unroll
        for (int u = 0; u < NT; ++u) { const int m = mb + u * NGW < T ? mb + u * NGW : mb; const bf16_t* pr = proj + (size_t)m * DINP;
            cq[u] = *(const u32x2*)(pr + COL_CQ + 4 * lane); ck[u] = *(const unsigned*)(pr + COL_CKV + 2 * lane);
            const int pos = m & (SEQ - 1), l5 = lane & 31; xa[u] = pr[COL_KPE + l5]; xb[u] = pr[COL_KPE + 32 + l5]; cc[u] = cosT[pos * 32 + l5]; sn[u] = sinT[pos * 32 + l5]; }
#pragma unroll
        for (int u = 0; u < NT; ++u) { const int m = mb + u * NGW; if (m >= T) break;
            const float a0 = __uint_as_float(cq[u].x << 16), a1 = __uint_as_float(cq[u].x & 0xffff0000u), a2 = __uint_as_float(cq[u].y << 16), a3 = __uint_as_float(cq[u].y & 0xffff0000u);
            const float k0 = __uint_as_float(ck[u] << 16), k1 = __uint_as_float(ck[u] & 0xffff0000u);
            const float sq = wave_sum((a0 * a0 + a1 * a1) + (a2 * a2 + a3 * a3)), sk = wave_sum(k0 * k0 + k1 * k1);
            if (lane == 0) rstdq[m] = 1.0f / sqrtf(sq * (1.f / 256.f) + EPS);
            const float rk = 1.0f / sqrtf(sk * (1.f / 128.f) + EPS);
            *(unsigned*)(klat + (size_t)m * 128 + 2 * lane) = cvt_pk_bf16(k0 * rk * g0, k1 * rk * g1);
            if (lane < 32) { const float x1 = bf2f(xa[u]), x2 = bf2f(xb[u]);
                *(unsigned*)(krope + (size_t)m * 64 + 2 * lane) = cvt_pk_bf16(x1 * cc[u] - x2 * sn[u], x1 * sn[u] + x2 * cc[u]); } }
    }
}

__device__ __forceinline__ void pool_phase(const bf16_t* proj, const float* pw, const float* pscale, bf16_t* ocat, LAS unsigned char* lds, int bx, int G, int tid) {
    constexpr int PP = 264, WP = 72;
    LAS bf16_t* xs = (LAS bf16_t*)lds;
    LAS bf16_t* pl = (LAS bf16_t*)(lds + 40960);
    LAS bf16_t* wt = (LAS bf16_t*)(lds + 40960 + 64 * PP * 2);
    const int lane = tid & 63, wave = tid >> 6, r32 = lane & 31, hi = lane >> 5;
    for (int i = tid; i < 4 * 64 * 64; i += NWAVES * 64) { const int g = i >> 12, c = (i >> 6) & 63, d = i & 63; wt[(g * 64 + d) * WP + c] = f2bf(pw[i]); }
    const int ch = tid & 255, half = tid >> 8, gch = ch >> 6, w = 2 << gch;
    const int g = wave >> 1, tb = wave & 1;
    const float sc0 = pscale[g * 64 + r32], sc1 = pscale[g * 64 + 32 + r32];
    for (int tile = bx; tile < T / 64; tile += G) {
        const int tok0 = tile * 64, pos0 = tok0 & (SEQ - 1);
#pragma unroll
        for (int i = 0; i < 5; ++i) { const int idx = tid + i * 512, r = idx >> 5, c8 = (idx & 31) * 8; u32x4 v = {0u, 0u, 0u, 0u};
            if (pos0 - 16 + r >= 0) v = *(const u32x4*)(proj + (size_t)(tok0 - 16 + r) * DINP + COL_XP + c8);
            *(LAS u32x4*)(xs + r * 256 + c8) = v; }
        __syncthreads();
        { const int t0 = half * 32; float s = 0.f;
          for (int j = 1; j < w; ++j) s += bf2f(xs[(t0 + 16 - j) * 256 + ch]);
          for (int tt = 0; tt < 32; ++tt) { const int t = t0 + tt, r = t + 16; const float xv = bf2f(xs[r * 256 + ch]); s += xv;
              const int pc = pos0 + t + 1; const float cnt = (float)(pc < w ? pc : w);
              pl[t * PP + ch] = f2bf(s / cnt - xv);
              s -= bf2f(xs[(r - w + 1) * 256 + ch]); } }
        __syncthreads();
        { f32x16 acc0 = {}, acc1 = {};
#pragma unroll
          for (int ks = 0; ks < 4; ++ks) { const bf16x8 af = *(const LAS bf16x8*)(pl + (tb * 32 + r32) * PP + g * 64 + ks * 16 + 8 * hi);
              const bf16x8 b0 = *(const LAS bf16x8*)(wt + (g * 64 + r32) * WP + ks * 16 + 8 * hi), b1 = *(const LAS bf16x8*)(wt + (g * 64 + 32 + r32) * WP + ks * 16 + 8 * hi);
              acc0 = __builtin_amdgcn_mfma_f32_32x32x16_bf16(af, b0, acc0, 0, 0, 0); acc1 = __builtin_amdgcn_mfma_f32_32x32x16_bf16(af, b1, acc1, 0, 0, 0); }
          bf16_t* op = ocat + (size_t)(tok0 + tb * 32) * DM + 768 + g * 64 + r32;
#pragma unroll
          for (int i = 0; i < 16; ++i) { const int row = (i & 3) + 8 * (i >> 2) + 4 * hi; const float v0 = acc0[i] * sc0, v1 = acc1[i] * sc1;
              const float n0 = xlane1(v0), n1 = xlane1(v1);
              if ((r32 & 1) == 0) { *(unsigned*)(op + (size_t)row * DM) = cvt_pk_bf16(v0, n0); *(unsigned*)(op + (size_t)row * DM + 32) = cvt_pk_bf16(v1, n1); } } }
        __syncthreads();
    }
}

__device__ __forceinline__ void hg_load16(const bf16_t* p, bf16_t (&z)[16]) {
#pragma unroll
    for (int j = 0; j < 16; ++j) z[j] = p[(size_t)j * DINP];
}
__device__ __forceinline__ void hg_gates(const bf16_t (&zr)[16], const float lb, LAS float* qs, int k, int q, float (&bc)[16], float (&kk)[16], float& blast, float& bmid) {
    const float omlb = 1.f - lb;
    float run = 0.f;
#pragma unroll
    for (int j = 0; j < 16; ++j) { const float z = bf2f(zr[j]);
        const float e = fast_exp(fminf(-z, 80.f)), sg = __builtin_amdgcn_rcpf(1.f + e);
        const float f = lb + omlb * sg; run += __builtin_amdgcn_logf(fmaxf(f, 1e-20f)) * 0.6931471805599453f; bc[j] = run; kk[j] = omlb * e * sg; }
    qs[q * 128 + k] = run;
    __syncthreads();
    const float s0 = qs[k], s1 = qs[128 + k], s2 = qs[256 + k], s3 = qs[384 + k];
    const float base = q == 0 ? 0.f : q == 1 ? s0 : q == 2 ? s0 + s1 : s0 + s1 + s2;
#pragma unroll
    for (int j = 0; j < 16; ++j) bc[j] += base;
    blast = (s0 + s1) + (s2 + s3); bmid = s0 + s1;
}
__device__ __forceinline__ f32x16 mfma32(bf16x8 a, bf16x8 b, f32x16 c) { return __builtin_amdgcn_mfma_f32_32x32x16_bf16(a, b, c, 0, 0, 0); }
constexpr int HG_PK = 136, HG_PS = 72;
#define HG_UNIT(u, b_, h_, tok0_) const int b_ = (u) >> 10, h_ = ((u) >> 8) & 3, tok0_ = b_ * SEQ + ((u) & 255) * 64
__device__ __forceinline__ void hgrn_local(const bf16_t* proj, const float* lbs_l, bf16_t* ubuf, float* dvec, LAS unsigned char* lds, int bx, int G, int tid, int wave, int lane) {
    LAS float* qs = (LAS float*)lds; LAS bf16_t* Kt = (LAS bf16_t*)(lds + 2048); LAS bf16_t* Vt = (LAS bf16_t*)(lds + 2048 + 128 * HG_PS * 2);
    const int k = tid & 127, q = tid >> 7, r32 = lane & 31, hi = lane >> 5, vs = tid >> 3, v0 = (tid & 7) * 8;
    bf16_t zc[16]; bf16x8 vc;
    if (bx < NUNIT) { HG_UNIT(bx, b, h, tok0); hg_load16(proj + (size_t)(tok0 + q * 16) * DINP + COL_HF + h * 128 + k, zc); vc = *(const bf16x8*)(proj + (size_t)(tok0 + vs) * DINP + COL_HI + h * 64 + v0); }
    for (int u = bx; u < NUNIT; u += G) {
        HG_UNIT(u, b, h, tok0); (void)b; (void)tok0;
        const float lb = lbs_l[h * 128 + k];
        bf16_t zn[16]; bf16x8 vn;
        { const int un = (u + G < NUNIT) ? u + G : u; HG_UNIT(un, bn, hn, tokn); (void)bn;
          hg_load16(proj + (size_t)(tokn + q * 16) * DINP + COL_HF + hn * 128 + k, zn); vn = *(const bf16x8*)(proj + (size_t)(tokn + vs) * DINP + COL_HI + hn * 64 + v0); }
        float bc[16], kk[16], blast, bmid;
        hg_gates(zc, lb, qs, k, q, bc, kk, blast, bmid);
        { unsigned w[8];
#pragma unroll
          for (int j = 0; j < 8; ++j) w[j] = cvt_pk_bf16(kk[2 * j] * fast_exp(blast - bc[2 * j]), kk[2 * j + 1] * fast_exp(blast - bc[2 * j + 1]));
          *(LAS u32x4*)(Kt + k * HG_PS + q * 16) = (u32x4){w[0], w[1], w[2], w[3]}; *(LAS u32x4*)(Kt + k * HG_PS + q * 16 + 8) = (u32x4){w[4], w[5], w[6], w[7]}; }
#pragma unroll
        for (int j = 0; j < 8; ++j) Vt[(v0 + j) * HG_PS + vs] = (bf16_t)vc[j];
        if (q == 0) dvec[(size_t)u * 128 + k] = fast_exp(blast);
        __syncthreads();
        { const int vb = wave >> 2, kb = wave & 3; f32x16 acc = {};
#pragma unroll
          for (int ks = 0; ks < 4; ++ks) { const bf16x8 af = *(const LAS bf16x8*)(Vt + (vb * 32 + r32) * HG_PS + ks * 16 + 8 * hi), bfr = *(const LAS bf16x8*)(Kt + (kb * 32 + r32) * HG_PS + ks * 16 + 8 * hi);
              acc = mfma32(af, bfr, acc); }
          bf16_t* up = ubuf + ((size_t)u * 64 + vb * 32) * 128 + kb * 32 + r32;
#pragma unroll
          for (int i = 0; i < 16; ++i) { const float vn = xlane1(acc[i]); if ((r32 & 1) == 0) *(unsigned*)(up + (size_t)((i & 3) + 8 * (i >> 2) + 4 * hi) * 128) = cvt_pk_bf16(acc[i], vn); } }
#pragma unroll
        for (int j = 0; j < 16; ++j) zc[j] = zn[j];
        vc = vn;
        __syncthreads();
    }
}
__device__ __forceinline__ void hgrn_scan(bf16_t* ubuf, const float* dvec, int bx, int G, int tid) {
    for (int j = (G >= 256 ? bx - (G - 128) : bx); j < 128; j += G) {
        if (j < 0 || tid >= 256) continue;
        const int bh = j >> 4, e = (j & 15) * 512 + tid * 2, k = e & 127;
        unsigned* up = (unsigned*)(ubuf + (size_t)bh * 256 * 8192 + e); const f32x2* dp = (const f32x2*)(dvec + (size_t)bh * 256 * 128 + k);
        float S0 = 0.f, S1 = 0.f;
        for (int c = 0; c < NCHUNK; c += 64) { unsigned uv[64]; f32x2 dv[64];
#pragma unroll
            for (int i = 0; i < 64; ++i) { uv[i] = up[(size_t)(c + i) * 4096]; dv[i] = dp[(size_t)(c + i) * 64]; }
#pragma unroll
            for (int i = 0; i < 64; ++i) { up[(size_t)(c + i) * 4096] = cvt_pk_bf16(S0, S1); S0 = dv[i][0] * S0 + __uint_as_float(uv[i] << 16); S1 = dv[i][1] * S1 + __uint_as_float(uv[i] & 0xffff0000u); } }
    }
}
__device__ __forceinline__ void hgrn_out(const bf16_t* proj, const float* lbs_l, const bf16_t* ubuf, const float* onorm, bf16_t* ocat, LAS unsigned char* lds, int bx, int G, int tid, int wave, int lane) {
    LAS float* qs = (LAS float*)lds;
    LAS bf16_t* Qi = (LAS bf16_t*)(lds + 2048); LAS bf16_t* Qp = Qi + 64 * HG_PK; LAS bf16_t* Kp = Qp + 64 * HG_PK; LAS bf16_t* St = Kp + 64 * HG_PK;
    LAS bf16_t* Vt = St + 64 * HG_PK; LAS bf16_t* Aq = Vt + 64 * HG_PS; LAS float* Ol = (LAS float*)(Aq + 64 * HG_PS);
    const int k = tid & 127, q = tid >> 7, r32 = lane & 31, hi = lane >> 5, vs = tid >> 3, v0 = (tid & 7) * 8, k0 = (tid & 7) * 16;
    bf16_t zc[16], qc[16]; bf16x8 vc;
    if (bx < NUNIT) { HG_UNIT(bx, b, h, tok0); hg_load16(proj + (size_t)(tok0 + q * 16) * DINP + COL_HF + h * 128 + k, zc); hg_load16(proj + (size_t)(tok0 + q * 16) * DINP + COL_HQ + h * 128 + k, qc);
        vc = *(const bf16x8*)(proj + (size_t)(tok0 + vs) * DINP + COL_HI + h * 64 + v0); }
    for (int u = bx; u < NUNIT; u += G) {
        HG_UNIT(u, b, h, tok0); (void)b;
        const float lb = lbs_l[h * 128 + k];
        const bf16_t* sp = ubuf + ((size_t)u * 64 + vs) * 128 + k0;
        const u32x4 a0 = *(const u32x4*)sp, a1 = *(const u32x4*)(sp + 8);
        const bf16x8 gg = *(const bf16x8*)(proj + (size_t)(tok0 + vs) * DINP + COL_HG + h * 64 + v0);
        bf16_t zn[16], qn[16]; bf16x8 vn;
        { const int un = (u + G < NUNIT) ? u + G : u; HG_UNIT(un, bn, hn, tokn); (void)bn;
          hg_load16(proj + (size_t)(tokn + q * 16) * DINP + COL_HF + hn * 128 + k, zn); hg_load16(proj + (size_t)(tokn + q * 16) * DINP + COL_HQ + hn * 128 + k, qn);
          vn = *(const bf16x8*)(proj + (size_t)(tokn + vs) * DINP + COL_HI + hn * 64 + v0); }
        float bc[16], kk[16], blast, bmid;
        hg_gates(zc, lb, qs, k, q, bc, kk, blast, bmid);
        { const int odd = k & 1, kp = k & ~1;
#pragma unroll
          for (int jj = 0; jj < 8; ++jj) { float xi[2], xp[2], xk[2];
#pragma unroll
              for (int e = 0; e < 2; ++e) { const int j = 2 * jj + e; const float qr = bf2f(qc[j]); const float qf = qr * sigmoidf_(qr);
                  xi[e] = qf * fast_exp(bc[j]); xp[e] = qf * fast_exp(bc[j] - bmid); xk[e] = kk[j] * fast_exp(bmid - bc[j]); }
              const float gi = xlane1(odd ? xi[0] : xi[1]), gp = xlane1(odd ? xp[0] : xp[1]), gk = xlane1(odd ? xk[0] : xk[1]);
              const float mi = odd ? xi[1] : xi[0], mp = odd ? xp[1] : xp[0], mk = odd ? xk[1] : xk[0];
              const int t = q * 16 + 2 * jj + odd;
              *(LAS unsigned*)(Qi + t * HG_PK + kp) = odd ? cvt_pk_bf16(gi, mi) : cvt_pk_bf16(mi, gi);
              *(LAS unsigned*)(Qp + t * HG_PK + kp) = odd ? cvt_pk_bf16(gp, mp) : cvt_pk_bf16(mp, gp);
              *(LAS unsigned*)(Kp + t * HG_PK + kp) = odd ? cvt_pk_bf16(gk, mk) : cvt_pk_bf16(mk, gk); } }
        *(LAS u32x4*)(St + vs * HG_PK + k0) = a0;
        *(LAS u32x4*)(St + vs * HG_PK + k0 + 8) = a1;
#pragma unroll
        for (int j = 0; j < 8; ++j) Vt[(v0 + j) * HG_PS + vs] = (bf16_t)vc[j];
        __syncthreads();
        f32x16 oacc = {};
        const int tb = (wave >> 1) & 1, vb = wave & 1;
        if (wave < 4) {
#pragma unroll
            for (int kc = 0; kc < 8; ++kc) { const bf16x8 af = *(const LAS bf16x8*)(Qi + (tb * 32 + r32) * HG_PK + kc * 16 + 8 * hi), bfr = *(const LAS bf16x8*)(St + (vb * 32 + r32) * HG_PK + kc * 16 + 8 * hi);
                oacc = mfma32(af, bfr, oacc); }
        } else if (wave < 7) {
            const int tb2 = wave == 4 ? 0 : 1, sb = wave == 6 ? 1 : 0; f32x16 sacc = {};
#pragma unroll
            for (int kc = 0; kc < 8; ++kc) { const bf16x8 af = *(const LAS bf16x8*)(Qp + (tb2 * 32 + r32) * HG_PK + kc * 16 + 8 * hi), bfr = *(const LAS bf16x8*)(Kp + (sb * 32 + r32) * HG_PK + kc * 16 + 8 * hi);
                sacc = mfma32(af, bfr, sacc); }
#pragma unroll
            for (int i = 0; i < 16; ++i) { const int t = tb2 * 32 + (i & 3) + 8 * (i >> 2) + 4 * hi, s = sb * 32 + r32; Aq[t * HG_PS + s] = (s <= t) ? f2bf(sacc[i]) : (bf16_t)0; }
        }
        __syncthreads();
        if (wave < 4) {
            const int nks = tb == 0 ? 2 : 4;
            for (int ks = 0; ks < nks; ++ks) { const bf16x8 af = *(const LAS bf16x8*)(Aq + (tb * 32 + r32) * HG_PS + ks * 16 + 8 * hi), bfr = *(const LAS bf16x8*)(Vt + (vb * 32 + r32) * HG_PS + ks * 16 + 8 * hi);
                oacc = mfma32(af, bfr, oacc); }
#pragma unroll
            for (int i = 0; i < 16; ++i) Ol[(tb * 32 + (i & 3) + 8 * (i >> 2) + 4 * hi) * 68 + vb * 32 + r32] = oacc[i];
        }
        __syncthreads();
        { const int t = vs; const LAS f32x4* op = (const LAS f32x4*)(Ol + t * 68 + v0); const f32x4 o0 = op[0], o1 = op[1];
          float ss = (o0[0] * o0[0] + o0[1] * o0[1]) + (o0[2] * o0[2] + o0[3] * o0[3]) + (o1[0] * o1[0] + o1[1] * o1[1]) + (o1[2] * o1[2] + o1[3] * o1[3]);
          ss = sum8(ss);
          const float rstd = 1.0f / sqrtf(ss * (1.f / 64.f) + EPS);
          const f32x4 n0 = *(const f32x4*)(onorm + h * 64 + v0), n1 = *(const f32x4*)(onorm + h * 64 + v0 + 4);
          float r[8];
#pragma unroll
          for (int j = 0; j < 8; ++j) { const float gv = bf2f((bf16_t)gg[j]); const float ov = j < 4 ? o0[j] : o1[j - 4]; const float nv = j < 4 ? n0[j] : n1[j - 4]; r[j] = ov * rstd * nv * (gv * sigmoidf_(gv)); }
          *(u32x4*)(ocat + (size_t)(tok0 + t) * DM + h * 64 + v0) = (u32x4){cvt_pk_bf16(r[0], r[1]), cvt_pk_bf16(r[2], r[3]), cvt_pk_bf16(r[4], r[5]), cvt_pk_bf16(r[6], r[7])}; }
#pragma unroll
        for (int j = 0; j < 16; ++j) { zc[j] = zn[j]; qc[j] = qn[j]; }
        vc = vn;
        __syncthreads();
    }
}

typedef const Args __attribute__((address_space(4))) * KArgsPtr;
#ifndef ONLY_KIND
#define ONLY_KIND -1
#endif
#ifndef KIND_MASK
#define KIND_MASK 0xFFFFFFFFu
#endif
#define KIND(k) ((ONLY_KIND < 0 || ONLY_KIND == (k)) && ((KIND_MASK >> (k)) & 1u))
#define IN(k) (lo <= (k) && (k) < hi)
#ifndef REPEAT_KIND
#define REPEAT_KIND -1
#endif
#ifndef REPEAT_N
#define REPEAT_N 3
#endif
#define REP(k) for (int rep_ = 0; rep_ < ((REPEAT_KIND) == (k) ? REPEAT_N : 1); ++rep_)
#define SEAM(k) do { if (MK_ONE_LAUNCH && IN(k) && IN((k) + 1)) xcd_barrier(bar, (wave_s * 64 + (int)__builtin_amdgcn_mbcnt_hi(~0u, __builtin_amdgcn_mbcnt_lo(~0u, 0u))) == 0); } while (0)
#define PH_BEGIN() int tid = wave_s * 64 + (int)__builtin_amdgcn_mbcnt_hi(~0u, __builtin_amdgcn_mbcnt_lo(~0u, 0u)); asm volatile("" : "+v"(tid)); const int lane = tid & 63, wave = __builtin_amdgcn_readfirstlane(tid >> 6), gw = bx * NWAVES + wave, gt = bx * (NWAVES * 64) + tid; \
    (void)lane; (void)wave; (void)gw; (void)gt; KArgsPtr ap = (KArgsPtr)__builtin_amdgcn_kernarg_segment_ptr(); asm volatile("" : "+s"(ap)); unsigned char* const ws = ap->ws; (void)ws

template <int l>
__device__ __forceinline__ void layer_body(LAS unsigned char* L, unsigned char* lds, const int lo, const int hi, const XcdBarrier& bar, const int G, const int bx, const int NGW, const int NGT, const int wave_s) {
    constexpr int pb = l == 0 ? 1 : 10;
        if (KIND(1) && IN(l == 0 ? 0 : pb + 0)) REP(1) { PH_BEGIN(); if constexpr (l == 0) norm_to_bf16<false>(ap->in[I_X], nullptr, nullptr, ap->in[I_ATTN_NORM], (bf16_t*)(ws + WS_HN), gw, NGW, lane); }
        if constexpr (l == 0) SEAM(0);
        if (KIND(2) && IN(pb + 1)) REP(2) { PH_BEGIN(); pg8::DenseSched S; S.init(T, DINP, DM, (const bf16_t*)(ws + WS_WIN) + (size_t)l * DINP * DM, G, bx); pg8::EpiBf16 E{(bf16_t*)(ws + WS_PROJ), DINP};
            pg8::gemm_phase<pg8::EpiBf16, pg8::DenseSched, true>(L, (const bf16_t*)(ws + WS_HN), DM, DM, S, E, tid); }
        SEAM(pb + 1);
        if (KIND(3) && IN(pb + 2)) REP(3) {
            { PH_BEGIN(); prep_tokens((const bf16_t*)(ws + WS_PROJ), ap->in[I_KV_NORM] + l * 128, (const float*)(ws + WS_COS), (const float*)(ws + WS_SIN), (float*)(ws + WS_RSTDQ), (bf16_t*)(ws + WS_KLAT), (bf16_t*)(ws + WS_KROPE), gw, NGW, lane); }
            { PH_BEGIN(); pool_phase((const bf16_t*)(ws + WS_PROJ), ap->in[I_POOL_W] + (size_t)l * 4 * 64 * 64, ap->in[I_POOL_SCALE] + l * 256, (bf16_t*)(ws + WS_OCAT), L, bx, G, tid); }
            { PH_BEGIN(); hgrn_local((const bf16_t*)(ws + WS_PROJ), (const float*)(ws + WS_LBS) + l * 512, (bf16_t*)(ws + WS_UBUF), (float*)(ws + WS_DVEC), L, bx, G, tid, wave, lane); }
        }
        SEAM(pb + 2);
        if ((KIND(4) || KIND(16)) && IN(pb + 3)) {
            if (KIND(16)) { PH_BEGIN(); hgrn_scan((bf16_t*)(ws + WS_UBUF), (const float*)(ws + WS_DVEC), bx, G, tid); }
            if (KIND(4)) REP(4) { PH_BEGIN(); pg8::DenseSched S; S.init(T, QW, 256, (const bf16_t*)(ws + WS_WQ) + (size_t)l * QW * 256, G, bx);
                pg8::EpiQ E{(bf16_t*)(ws + WS_Q), (const float*)(ws + WS_RSTDQ), (const float*)(ws + WS_COS), (const float*)(ws + WS_SIN)};
                pg8::gemm_phase<pg8::EpiQ, pg8::DenseSched, true>(L, (const bf16_t*)(ws + WS_PROJ) + COL_CQ, DINP, 256, S, E, tid); }
        }
        SEAM(pb + 3);
        if ((KIND(5) || KIND(15)) && IN(pb + 4)) {
            if (KIND(15)) REP(15) { PH_BEGIN(); hgrn_out((const bf16_t*)(ws + WS_PROJ), (const float*)(ws + WS_LBS) + l * 512, (const bf16_t*)(ws + WS_UBUF), ap->in[I_OUT_NORM] + l * 256, (bf16_t*)(ws + WS_OCAT), L, bx, G, tid, wave, lane); }
            if (KIND(5)) REP(5) { PH_BEGIN();
                for (int item = bx; item < 8 * 32; item += G)
                    for (int ps = 0; ps < 2; ++ps) { const int b = item & 1, h = (item >> 1) & 3, x = item >> 3, qb = ps ? x : 63 - x; att::BlockRef r;
                        r.Q = (const bf16_t*)(ws + WS_Q) + ((size_t)b * SEQ + (size_t)qb * 256) * QW + h * 192; r.Kl = (const bf16_t*)(ws + WS_KLAT) + (size_t)b * SEQ * 128; r.Kr = (const bf16_t*)(ws + WS_KROPE) + (size_t)b * SEQ * 64;
                        r.O = (bf16_t*)(ws + WS_OCAT) + ((size_t)b * SEQ + (size_t)qb * 256) * DM + 256 + h * 128; r.P0 = qb * 256;
                        att::attn_block<0>(r, (char*)lds, tid); }
#if defined(PROBE_ATT_VAR)
                for (int item = bx; item < 8 * 32; item += G)
                    for (int ps = 0; ps < 2; ++ps) { const int bh = item >> 5, x = item & 31, qb = ps ? 63 - x : x, b = bh >> 2, h = bh & 3; att::BlockRef r;
                        r.Q = (const bf16_t*)(ws + WS_Q) + ((size_t)b * SEQ + (size_t)qb * 256) * QW + h * 192; r.Kl = (const bf16_t*)(ws + WS_KLAT) + (size_t)b * SEQ * 128; r.Kr = (const bf16_t*)(ws + WS_KROPE) + (size_t)b * SEQ * 64;
                        r.O = (bf16_t*)(ws + WS_UBUF) + ((size_t)b * SEQ + (size_t)qb * 256) * DM + 256 + h * 128; r.P0 = qb * 256;
                        att::attn_block<PROBE_ATT_VAR>(r, (char*)lds, tid); }
#endif
            }
        }
        SEAM(pb + 4);
        if constexpr (l == 0) {
            if (KIND(6) && IN(pb + 5)) { PH_BEGIN();
                pg8::EpiRmsRes<true> E{(const void*)ap->in[I_X], (bf16_t*)ap->out, (bf16_t*)(ws + WS_HN), ap->in[I_FFN_NORM], (float*)((char*)ap->out + (size_t)T * DM * 2), (unsigned*)(ws + WS_CTL + CW_FUSE_BYTES) + 8192, L + pg8::STAGE_BYTES};
                { pg8::SliceSched S; S.init(T, DM, DM, (const bf16_t*)(ws + WS_WO), G, bx, 0); pg8::gemm_phase<pg8::EpiRmsRes<true>, pg8::SliceSched, true>(L, (const bf16_t*)(ws + WS_OCAT), DM, DM, S, E, tid); }
                __syncthreads();
                { pg8::SliceSched S; S.init(T, DM, DM, (const bf16_t*)(ws + WS_WO), G, bx, 1); pg8::gemm_phase<pg8::EpiRmsRes<true>, pg8::SliceSched, true>(L, (const bf16_t*)(ws + WS_OCAT), DM, DM, S, E, tid); } }
        } else {
            if (KIND(6) && IN(pb + 5)) { PH_BEGIN();
                pg8::EpiRmsRes<false> E{(const void*)ap->out, (bf16_t*)ap->out, (bf16_t*)(ws + WS_HN), ap->in[I_FFN_NORM] + DM, (float*)((char*)ap->out + (size_t)T * DM * 2), (unsigned*)(ws + WS_CTL + CW_FUSE_BYTES) + 16384, L + pg8::STAGE_BYTES};
                { pg8::SliceSched S; S.init(T, DM, DM, (const bf16_t*)(ws + WS_WO) + (size_t)DM * DM, G, bx, 0); pg8::gemm_phase<pg8::EpiRmsRes<false>, pg8::SliceSched, true>(L, (const bf16_t*)(ws + WS_OCAT), DM, DM, S, E, tid); }
                __syncthreads();
                { pg8::SliceSched S; S.init(T, DM, DM, (const bf16_t*)(ws + WS_WO) + (size_t)DM * DM, G, bx, 1); pg8::gemm_phase<pg8::EpiRmsRes<false>, pg8::SliceSched, true>(L, (const bf16_t*)(ws + WS_OCAT), DM, DM, S, E, tid); } } }
        if (false) { PH_BEGIN(); pg8::DenseSched S; S.init(T, DM, DM, (const bf16_t*)(ws + WS_WO) + (size_t)l * DM * DM, G, bx); pg8::EpiBf16 E{(bf16_t*)(ws + WS_HN), DM};
            pg8::gemm_phase<pg8::EpiBf16, pg8::DenseSched, true>(L, (const bf16_t*)(ws + WS_OCAT), DM, DM, S, E, tid); }
        SEAM(pb + 5);
        if constexpr (l == 0) {
            if (KIND(8) && IN(8)) REP(8) { PH_BEGIN(); pg8::DenseSched S; S.init(T, 2 * DFF, DM, (const bf16_t*)(ws + WS_WGU), G, bx); pg8::EpiSwiGLU E{(bf16_t*)(ws + WS_ACTD), DFF};
                pg8::gemm_phase<pg8::EpiSwiGLU, pg8::DenseSched, true>(L, (const bf16_t*)(ws + WS_HN), DM, DM, S, E, tid); }
            SEAM(8);
            if (KIND(9) && IN(9)) { PH_BEGIN();
                pg8::EpiRmsRes<false> E{(const void*)ap->out, (bf16_t*)ap->out, (bf16_t*)(ws + WS_HN), ap->in[I_ATTN_NORM] + DM, (float*)((char*)ap->out + (size_t)T * DM * 2), (unsigned*)(ws + WS_CTL + CW_FUSE_BYTES), L + pg8::STAGE_BYTES};
                { pg8::SliceSched S; S.init(T, DM, DFF, (const bf16_t*)(ws + WS_WD), G, bx, 0); pg8::gemm_phase<pg8::EpiRmsRes<false>, pg8::SliceSched, true>(L, (const bf16_t*)(ws + WS_ACTD), DFF, DFF, S, E, tid); }
                __syncthreads();
                { pg8::SliceSched S; S.init(T, DM, DFF, (const bf16_t*)(ws + WS_WD), G, bx, 1); pg8::gemm_phase<pg8::EpiRmsRes<false>, pg8::SliceSched, true>(L, (const bf16_t*)(ws + WS_ACTD), DFF, DFF, S, E, tid); } }
            SEAM(9);
        } else {
            if (KIND(10) && IN(16)) REP(10) {
                { PH_BEGIN(); norm_router<true>((bf16_t*)ap->out, (const bf16_t*)(ws + WS_HN), ap->in[I_FFN_NORM] + DM, ap->in[I_ROUTER], (bf16_t*)(ws + WS_HN), (int*)(ws + WS_TOKE), (float*)(ws + WS_TOKG), (int*)(ws + WS_CNT), L, bx, G, tid, wave, lane); }
                __syncthreads(); }
            SEAM(16);
            if (KIND(11) && IN(17)) REP(11) { PH_BEGIN(); route_tables((const int*)(ws + WS_TOKE), (const float*)(ws + WS_TOKG), (const int*)(ws + WS_CNT), (int*)(ws + WS_SLOTTOK), (float*)(ws + WS_SLOTG), (int*)(ws + WS_TILEE), L, bx, G, tid); }
            SEAM(17);
            for (int r = 0; r < 2; ++r) {
                if (KIND(12) && IN(18 + 2 * r)) REP(12) { PH_BEGIN(); pg8::MoeSched<true> S; S.init(2 * DFFE, DM, (const bf16_t*)(ws + WS_MOEW), MOEW_E, (const int*)(ws + WS_TILEE) + r * 256, (const int*)(ws + WS_SLOTTOK) + r * MOE_ROWS, G, bx);
                    pg8::EpiSwiGLU E{(bf16_t*)(ws + WS_ACTM), DFFE};
                    pg8::gemm_phase<pg8::EpiSwiGLU, pg8::MoeSched<true>, true>(L, (const bf16_t*)(ws + WS_HN), DM, DM, S, E, tid); }
                SEAM(18 + 2 * r);
                if (KIND(13) && IN(19 + 2 * r)) REP(13) { PH_BEGIN(); pg8::MoeDownSched S; S.init(DM, DFFE, (const bf16_t*)(ws + WS_MOEW) + (size_t)2 * DFFE * DM, MOEW_E, (const int*)(ws + WS_TILEE) + r * 256, G, bx);
                    pg8::EpiMoeDownB E{(const bf16_t*)ap->out, r == 0 ? (bf16_t*)ap->out : (bf16_t*)(ws + WS_HN), (const int*)(ws + WS_SLOTTOK) + r * MOE_ROWS, (const float*)(ws + WS_SLOTG) + r * MOE_ROWS,
                                       (f32x4*)((char*)ap->out + (size_t)T * DM * 2), (unsigned*)(ws + WS_CTL + CW_SPLIT_BYTES) + r * 64};
                    pg8::gemm_phase<pg8::EpiMoeDownB, pg8::MoeDownSched, true>(L, (const bf16_t*)(ws + WS_ACTM), DFFE, DFFE, S, E, tid);
                    moe_down_fixup(S, E, tid); }
                SEAM(19 + 2 * r);
            }
        }
}

__global__ void __launch_bounds__(NWAVES * 64, 2) trunk_fwd(Args args_unused) {
    extern __shared__ __attribute__((aligned(16))) unsigned char lds[];
    LAS unsigned char* L = (LAS unsigned char*)lds;
    const int G = gridDim.x, bx = blockIdx.x, NGW = G * NWAVES, NGT = G * NWAVES * 64;
    const int wave_s = __builtin_amdgcn_readfirstlane((int)threadIdx.x >> 6);
    for (int u = threadIdx.x; u < (LDS_BYTES - RING_BYTES) / 4; u += NWAVES * 64) ((LAS unsigned*)(L + RING_BYTES))[u] = 0u;
    __syncthreads();
    int lo, hi; XcdBarrier bar;
    { KArgsPtr ap0 = (KArgsPtr)__builtin_amdgcn_kernarg_segment_ptr(); lo = ap0->ph_lo; hi = ap0->ph_hi;
      bar.bar = (unsigned*)(ap0->ws + WS_CTL) + CW_BAR; bar.x = 0; bar.st = nullptr;
      if (MK_ONE_LAUNCH) bar = xcd_barrier_post((unsigned*)(ap0->ws + WS_CTL) + CW_BAR, (volatile LAS unsigned*)(L + MISC_OFF) + 8); }
    if (KIND(0) && IN(0)) REP(0) { PH_BEGIN();
        if (wave < 4) p0_stream(ap, L, bx * 4 + wave, G * 4, wave, lane);
        else p0_prologue(ap, L, 0, 1, bx * 256 + (tid - 256), G * 256, wave, lane, 1); }

    layer_body<0>(L, lds, lo, hi, bar, G, bx, NGW, NGT, wave_s);
    layer_body<1>(L, lds, lo, hi, bar, G, bx, NGW, NGT, wave_s);
    if (KIND(14) && IN(22)) REP(14) { PH_BEGIN(); norm_final((const bf16_t*)(ws + WS_HN), ap->out, ap->in[I_FINAL_NORM], gw, NGW, lane); }
#undef IN
#undef SEAM
}

extern "C" void kernel_launch(void* const* d_in, const int* in_sizes, int n_in, void* d_out, int out_size, void* d_ws, size_t ws_size, hipStream_t stream) {
    static int grid = 0;
    if (grid == 0) {
        if (n_in != 21 || in_sizes[0] != T * DM || out_size != T * DM || ws_size < WS_END) {
            fprintf(stderr, "kernel_launch: unexpected shapes (n_in %d, in0 %d, out %d, ws %zu, need %zu); nothing launched\n", n_in, n_in > 0 ? in_sizes[0] : -1, out_size, ws_size, (size_t)WS_END); grid = -1; return; }
        int dev = 0, cus = 0, per_cu = 0;
        if (hipGetDevice(&dev) != hipSuccess || hipDeviceGetAttribute(&cus, hipDeviceAttributeMultiprocessorCount, dev) != hipSuccess) { grid = -1; return; }
        if (hipFuncSetAttribute((const void*)trunk_fwd, hipFuncAttributeMaxDynamicSharedMemorySize, LDS_BYTES) != hipSuccess) { fprintf(stderr, "kernel_launch: hipFuncSetAttribute failed\n"); grid = -1; return; }
        if (hipOccupancyMaxActiveBlocksPerMultiprocessor(&per_cu, (const void*)trunk_fwd, NWAVES * 64, LDS_BYTES) != hipSuccess || per_cu < 1)
            fprintf(stderr, "kernel_launch: note: occupancy query reports %d workgroups per CU\n", per_cu);
        (void)hipGetLastError();
        grid = cus;
    }
    if (grid < 0) return;
    (void)hipMemsetAsync((char*)d_ws + WS_CTL, 0, CTL_ZERO_BYTES, stream);
    Args a{};
    for (int i = 0; i < 21; ++i) a.in[i] = (const float*)d_in[i];
    a.out = (float*)d_out; a.ws = (unsigned char*)d_ws;
#if MK_ONE_LAUNCH
    a.ph_lo = 0; a.ph_hi = NPH;
    hipLaunchKernelGGL(trunk_fwd, dim3(grid), dim3(NWAVES * 64), LDS_BYTES, stream, a);
#else
    for (int p = 0; p < NPH; ++p) { a.ph_lo = p; a.ph_hi = p + 1; hipLaunchKernelGGL(trunk_fwd, dim3(grid), dim3(NWAVES * 64), LDS_BYTES, stream, a); }
#endif
}
```
